# Optimizing an MI355X kernel written in HIP

```python
import jax
import jax.numpy as jnp
from jax import lax
import numpy as np

D_MODEL = 1024
BATCH = 2
SEQ = 8192
DEPTH = 2

HEAD_DIM = 64
N_GROUPS_A = 8
N_HEADS_B = 8
N_HEADS_C = 16
WIDTH_A = N_GROUPS_A * HEAD_DIM
WIDTH_B = N_HEADS_B * HEAD_DIM
WIDTH_C = N_HEADS_C * HEAD_DIM
SGU_CHUNK = 128
MOBA_BLOCK = 256
MOBA_TOPK = 3
IDX_HEADS = 8
IDX_DIM = 64
DSA_TOPK = 256
ROPE_THETA = 500000.0
ROPE_DIM = HEAD_DIM // 4
D_FF = ((8 * D_MODEL + 3 * 256 - 1) // (3 * 256)) * 256
PLE_DIM = 256
Q_BLOCK = 128
EPS = 1e-6
NEG = -1e30
N_EVEN = (DEPTH + 1) // 2
N_ODD = DEPTH // 2
IN_EVEN = 2 * WIDTH_A + 3 * WIDTH_B
IN_ODD = 3 * WIDTH_C + IDX_HEADS * IDX_DIM + IDX_DIM + IDX_HEADS

kernel_name = 'hybrid_sgu_moba_dsa_trunk'


def rmsnorm(x, g):
    xf = x.astype(jnp.float32)
    y = xf * lax.rsqrt(jnp.mean(xf * xf, axis=-1, keepdims=True) + EPS)
    return (y * g.astype(jnp.float32)).astype(x.dtype)


def layernorm(x, g, b):
    xf = x.astype(jnp.float32)
    mu = jnp.mean(xf, axis=-1, keepdims=True)
    xc = xf - mu
    var = jnp.mean(xc * xc, axis=-1, keepdims=True)
    y = xc * lax.rsqrt(var + EPS) * g.astype(jnp.float32) + b.astype(jnp.float32)
    return y.astype(x.dtype)


def rope_tables(positions):
    inv_freq = ROPE_THETA ** (-jnp.arange(0, ROPE_DIM, 2, dtype=jnp.float32) / ROPE_DIM)
    ang = positions.astype(jnp.float32)[..., None] * inv_freq
    return jnp.cos(ang), jnp.sin(ang)


def partial_rope(x, cos, sin):
    half = ROPE_DIM // 2
    c = cos[:, :, None, :]
    s = sin[:, :, None, :]
    xf = x.astype(jnp.float32)
    x1 = xf[..., :half]
    x2 = xf[..., half:ROPE_DIM]
    out = jnp.concatenate([x1 * c - x2 * s, x2 * c + x1 * s, xf[..., ROPE_DIM:]], axis=-1)
    return out.astype(x.dtype)


def spatial_gating(u, v, ln_g, ln_b, w_s, b_s):
    B, S, _ = u.shape
    nc = S // SGU_CHUNK
    vg = v.reshape(B, S, N_GROUPS_A, HEAD_DIM)
    vg = layernorm(vg, ln_g.reshape(N_GROUPS_A, HEAD_DIM), ln_b.reshape(N_GROUPS_A, HEAD_DIM))
    vg = vg.reshape(B, nc, SGU_CHUNK, N_GROUPS_A, HEAD_DIM)
    causal = jnp.tril(jnp.ones((SGU_CHUNK, SGU_CHUNK), dtype=bool))
    w = jnp.where(causal[None], w_s, 0.0).astype(vg.dtype)
    mixed = jnp.einsum('gts,bcsgd->bctgd', w, vg) + b_s.T[None, None, :, :, None].astype(vg.dtype)
    return u * mixed.reshape(B, S, WIDTH_A)


def moba_attention(q, k, v):
    B, S, H, Dh = q.shape
    nb = -(-S // MOBA_BLOCK)
    pad = nb * MOBA_BLOCK - S
    kp = jnp.pad(k, ((0, 0), (0, pad), (0, 0), (0, 0)))
    vp = jnp.pad(v, ((0, 0), (0, pad), (0, 0), (0, 0)))
    kbh = kp.reshape(B, nb, MOBA_BLOCK, H, Dh).transpose(0, 3, 1, 2, 4)
    vbh = vp.reshape(B, nb, MOBA_BLOCK, H, Dh).transpose(0, 3, 1, 2, 4)
    k_mean = jnp.mean(kbh.astype(jnp.float32), axis=3)
    q_blk = jnp.arange(S) // MOBA_BLOCK
    gate = jnp.einsum('bshd,bhnd->bhsn', q.astype(jnp.float32), k_mean)
    past = jnp.arange(nb)[None, :] < q_blk[:, None]
    gate = jnp.where(past[None, None], gate, NEG)
    kk = min(MOBA_TOPK, nb)
    _, sel = lax.top_k(gate, kk)
    sel_valid = sel < q_blk[None, None, :, None]
    scale = Dh ** -0.5
    b_i = jnp.arange(B)[:, None, None, None]
    h_i = jnp.arange(H)[None, :, None, None]

    def one_block(ci):
        start = ci * Q_BLOCK
        qpos = start + jnp.arange(Q_BLOCK)
        qc = lax.dynamic_slice_in_dim(q, start, Q_BLOCK, axis=1)
        selc = lax.dynamic_slice_in_dim(sel, start, Q_BLOCK, axis=2)
        validc = lax.dynamic_slice_in_dim(sel_valid, start, Q_BLOCK, axis=2)
        kg = kbh[b_i, h_i, selc]
        vg = vbh[b_i, h_i, selc]
        s_sel = jnp.einsum('bqhd,bhqkmd->bhqkm', qc, kg, preferred_element_type=jnp.float32) * scale
        s_sel = jnp.where(validc[..., None], s_sel, NEG)
        blk = start // MOBA_BLOCK
        k_own = lax.dynamic_slice_in_dim(kp, blk * MOBA_BLOCK, MOBA_BLOCK, axis=1)
        v_own = lax.dynamic_slice_in_dim(vp, blk * MOBA_BLOCK, MOBA_BLOCK, axis=1)
        kpos = blk * MOBA_BLOCK + jnp.arange(MOBA_BLOCK)
        s_own = jnp.einsum('bqhd,bmhd->bhqm', qc, k_own, preferred_element_type=jnp.float32) * scale
        s_own = jnp.where((kpos[None, :] <= qpos[:, None])[None, None], s_own, NEG)
        s_all = jnp.concatenate([s_sel.reshape(B, H, Q_BLOCK, kk * MOBA_BLOCK), s_own], axis=-1)
        pr = jax.nn.softmax(s_all, axis=-1)
        p_sel = pr[..., :kk * MOBA_BLOCK].reshape(B, H, Q_BLOCK, kk, MOBA_BLOCK).astype(vg.dtype)
        p_own = pr[..., kk * MOBA_BLOCK:].astype(v_own.dtype)
        o = (jnp.einsum('bhqkm,bhqkmd->bqhd', p_sel, vg, preferred_element_type=jnp.float32)
             + jnp.einsum('bhqm,bmhd->bqhd', p_own, v_own, preferred_element_type=jnp.float32))
        return o.astype(q.dtype)

    out = lax.map(one_block, jnp.arange(S // Q_BLOCK))
    return jnp.moveaxis(out, 0, 1).reshape(B, S, H, Dh)


def dsa_attention(q, k, v, q_idx, k_idx, w_idx):
    B, S, H, Dh = q.shape
    n_sel = min(DSA_TOPK, S // 4)
    scale = Dh ** -0.5
    b_i = jnp.arange(B)[:, None, None]
    kpos = jnp.arange(S)

    def one_block(ci):
        start = ci * Q_BLOCK
        qpos = start + jnp.arange(Q_BLOCK)
        qi = lax.dynamic_slice_in_dim(q_idx, start, Q_BLOCK, axis=1)
        wi = lax.dynamic_slice_in_dim(w_idx, start, Q_BLOCK, axis=1).astype(jnp.float32)
        logits = jnp.einsum('bqid,bsd->bqis', qi, k_idx, preferred_element_type=jnp.float32)
        score = jnp.einsum('bqis,bqi->bqs', jax.nn.relu(logits), wi)
        score = jnp.where(kpos[None, None, :] <= qpos[None, :, None], score, NEG)
        _, idx = lax.top_k(score, n_sel)
        valid = idx <= qpos[None, :, None]
        kg = k[b_i, idx]
        vg = v[b_i, idx]
        qc = lax.dynamic_slice_in_dim(q, start, Q_BLOCK, axis=1)
        s = jnp.einsum('bqhd,bqnhd->bhqn', qc, kg, preferred_element_type=jnp.float32) * scale
        s = jnp.where(valid[:, None], s, NEG)
        pr = jax.nn.softmax(s, axis=-1)
        o = jnp.einsum('bhqn,bqnhd->bqhd', pr.astype(vg.dtype), vg, preferred_element_type=jnp.float32)
        return o.astype(q.dtype)

    out = lax.map(one_block, jnp.arange(S // Q_BLOCK))
    return jnp.moveaxis(out, 0, 1).reshape(B, S, H, Dh)


def setup_inputs(seed: int = 0) -> dict:
    key = jax.random.key(seed)
    ks = jax.random.split(key, 24)
    f32 = jnp.float32

    def dense(k, shape, fan_in):
        return jax.random.normal(k, shape, f32) * (fan_in ** -0.5)

    def gain(k, shape):
        return 1.0 + 0.02 * jax.random.normal(k, shape, f32)

    def small(k, shape):
        return 0.02 * jax.random.normal(k, shape, f32)

    x = jax.random.normal(ks[0], (BATCH, SEQ, D_MODEL), f32)
    p = jax.random.normal(ks[1], (DEPTH, BATCH, SEQ, PLE_DIM), f32)
    offset = jax.random.randint(ks[2], (BATCH, 1), 0, 4096, dtype=jnp.int32)
    positions = offset + jnp.arange(SEQ, dtype=jnp.int32)[None, :]
    return {
        'x': x,
        'p': p,
        'positions': positions,
        'g_mix': gain(ks[3], (DEPTH, D_MODEL)),
        'w_in_even': dense(ks[4], (N_EVEN, D_MODEL, IN_EVEN), D_MODEL),
        'a_ln_g': gain(ks[5], (N_EVEN, WIDTH_A)),
        'a_ln_b': small(ks[6], (N_EVEN, WIDTH_A)),
        'a_w_s': dense(ks[7], (N_EVEN, N_GROUPS_A, SGU_CHUNK, SGU_CHUNK), SGU_CHUNK),
        'a_b_s': 1.0 + 0.1 * jax.random.normal(ks[8], (N_EVEN, N_GROUPS_A, SGU_CHUNK), f32),
        'w_out_even': dense(ks[9], (N_EVEN, WIDTH_A + WIDTH_B, D_MODEL), WIDTH_A + WIDTH_B),
        'w_in_odd': dense(ks[10], (N_ODD, D_MODEL, IN_ODD), D_MODEL),
        'c_kidx_ln_g': gain(ks[11], (N_ODD, IDX_DIM)),
        'c_kidx_ln_b': small(ks[12], (N_ODD, IDX_DIM)),
        'w_out_odd': dense(ks[13], (N_ODD, WIDTH_C, D_MODEL), WIDTH_C),
        'g_ffn': gain(ks[14], (DEPTH, D_MODEL)),
        'w_ffn_gate': dense(ks[15], (DEPTH, D_MODEL, D_FF), D_MODEL),
        'w_ffn_up': dense(ks[16], (DEPTH, D_MODEL, D_FF), D_MODEL),
        'w_ffn_down': dense(ks[17], (DEPTH, D_FF, D_MODEL), D_FF),
        'g_ple': gain(ks[18], (DEPTH, D_MODEL)),
        'w_ple_proj': dense(ks[19], (DEPTH, PLE_DIM, D_MODEL), PLE_DIM),
        'w_ple_gate': dense(ks[20], (DEPTH, D_MODEL, D_MODEL), D_MODEL),
        'g_final': gain(ks[21], (D_MODEL,)),
    }


def reference(x, p, positions, g_mix, w_in_even, a_ln_g, a_ln_b, a_w_s, a_b_s, w_out_even,
              w_in_odd, c_kidx_ln_g, c_kidx_ln_b, w_out_odd, g_ffn, w_ffn_gate, w_ffn_up,
              w_ffn_down, g_ple, w_ple_proj, w_ple_gate, g_final):
    B, S, _ = x.shape
    cos, sin = rope_tables(positions)
    h = x
    for i in range(DEPTH):
        j = i // 2
        xn = rmsnorm(h, g_mix[i])
        if i % 2 == 0:
            z = xn @ w_in_even[j]
            u_a = jax.nn.gelu(z[..., :WIDTH_A], approximate=False)
            v_a = jax.nn.gelu(z[..., WIDTH_A:2 * WIDTH_A], approximate=False)
            o = 2 * WIDTH_A
            q_b = z[..., o:o + WIDTH_B].reshape(B, S, N_HEADS_B, HEAD_DIM)
            k_b = z[..., o + WIDTH_B:o + 2 * WIDTH_B].reshape(B, S, N_HEADS_B, HEAD_DIM)
            v_b = z[..., o + 2 * WIDTH_B:o + 3 * WIDTH_B].reshape(B, S, N_HEADS_B, HEAD_DIM)
            y_a = spatial_gating(u_a, v_a, a_ln_g[j], a_ln_b[j], a_w_s[j], a_b_s[j])
            y_b = moba_attention(partial_rope(q_b, cos, sin), partial_rope(k_b, cos, sin), v_b)
            mix = jnp.concatenate([y_a, y_b.reshape(B, S, WIDTH_B)], axis=-1) @ w_out_even[j]
        else:
            z = xn @ w_in_odd[j]
            q_c = z[..., :WIDTH_C].reshape(B, S, N_HEADS_C, HEAD_DIM)
            k_c = z[..., WIDTH_C:2 * WIDTH_C].reshape(B, S, N_HEADS_C, HEAD_DIM)
            v_c = z[..., 2 * WIDTH_C:3 * WIDTH_C].reshape(B, S, N_HEADS_C, HEAD_DIM)
            o = 3 * WIDTH_C
            q_i = z[..., o:o + IDX_HEADS * IDX_DIM].reshape(B, S, IDX_HEADS, IDX_DIM)
            o = o + IDX_HEADS * IDX_DIM
            k_i = layernorm(z[..., o:o + IDX_DIM], c_kidx_ln_g[j], c_kidx_ln_b[j])
            w_i = z[..., o + IDX_DIM:o + IDX_DIM + IDX_HEADS] * ((IDX_HEADS ** -0.5) * (IDX_DIM ** -0.5))
            q_i = partial_rope(q_i, cos, sin)
            k_i = partial_rope(k_i[:, :, None, :], cos, sin)[:, :, 0, :]
            y_c = dsa_attention(partial_rope(q_c, cos, sin), partial_rope(k_c, cos, sin), v_c,
                                q_i, k_i, w_i)
            mix = y_c.reshape(B, S, WIDTH_C) @ w_out_odd[j]
        h = h + mix
        xn = rmsnorm(h, g_ffn[i])
        h = h + (jax.nn.silu(xn @ w_ffn_gate[i]) * (xn @ w_ffn_up[i])) @ w_ffn_down[i]
        gate = jax.nn.sigmoid(rmsnorm(h, g_ple[i]) @ w_ple_gate[i])
        h = h + (p[i] @ w_ple_proj[i]) * gate
    return rmsnorm(h, g_final)
```

```cpp
#include <hip/hip_runtime.h>
#include <cstdio>
#include <cstdint>
namespace pg8 {
#define PG8_LAS __attribute__((address_space(3)))
typedef unsigned short bf16_t;
typedef short bf16x8 __attribute__((ext_vector_type(8)));
typedef float f32x4 __attribute__((ext_vector_type(4)));
typedef unsigned u32x4 __attribute__((ext_vector_type(4)));
constexpr int BM = 256, BK = 64, HALF = 128, HTB = HALF * BK * 2  , STAGE_BYTES = 8 * HTB, NXCD = 8, WGM = 8;

__host__ __device__ __forceinline__ int lds_byte(int r, int c) { const int st = (r >> 4) * 2 + (c >> 5), rr = r & 15, cc = c & 31, ob = rr * 64 + cc * 2; return st * 1024 + (ob ^ (((ob >> 9) & 1) << 5)); }
__host__ __device__ __forceinline__ void stage_rc(int b, int& R, int& C) { const int st = b / 1024, sb = b % 1024, swz = sb ^ (((sb >> 9) & 1) << 5); R = (st >> 1) * 16 + swz / 64; C = (st & 1) * 32 + (swz % 64) / 2; }
__host__ __device__ __forceinline__ int perm32(int rho) { const int n = rho >> 4, i = rho & 15; return 8 * (i >> 2) + 4 * n + (i & 3); }

struct Unit { int pm, pn; };
struct Gemm { const bf16_t* A; const bf16_t* Bt; int M, N, K; };

struct StaticOrder {
    int nM, nN, nwg, G, c;
    __host__ __device__ void init(int M, int N, int G_, int c_) { nM = M / BM; nN = N / BM; nwg = nM * nN; G = G_; c = c_; }
    __host__ __device__ bool next(int i, Unit& u) const {
        const long L = (long)i * G + c; if (L >= nwg) return false;
        int wgid = (int)L; { const int q = nwg / NXCD, r = nwg % NXCD, xcd = wgid % NXCD, off = wgid / NXCD; wgid = (xcd < r ? xcd * (q + 1) : r * (q + 1) + (xcd - r) * q) + off; }
        const int nig = WGM * nN, gid = wgid / nig, fm = gid * WGM, gsz = (nM - fm) < WGM ? (nM - fm) : WGM;
        u.pm = fm + ((wgid % nig) % gsz); u.pn = (wgid % nig) / gsz; return true;
    }
    __device__ __forceinline__ void a_ready(const Unit&) const {}
    __device__ __forceinline__ void done(const Unit&) const {}
};
__device__ __forceinline__ unsigned cvt_pk_bf16(float lo, float hi) { unsigned r; asm volatile("v_cvt_pk_bf16_f32 %0, %1, %2" : "=v"(r) : "v"(lo), "v"(hi)); return r; }
typedef float f32x2 __attribute__((ext_vector_type(2)));
__device__ __forceinline__ f32x2 gelu_pk(f32x2 v) {
    const f32x2 av = __builtin_elementwise_abs(v), d = av * 0.2316418882f + 1.0f;
    f32x2 t; t.x = __builtin_amdgcn_rcpf(d.x); t.y = __builtin_amdgcn_rcpf(d.y);
    f32x2 q = t * 0.5307027145f + (-0.7265760135f); q = q * t + 0.7107068705f; q = q * t + (-0.142248368f); q = q * t + 0.127414796f; q = q * t;
    const f32x2 s = (v * v) * (-0.72134752044f);
    f32x2 e; e.x = __builtin_amdgcn_exp2f(s.x); e.y = __builtin_amdgcn_exp2f(s.y);
    const f32x2 m = v * (q * e), r = v - m;
    f32x2 o; o.x = v.x < 0.f ? m.x : r.x; o.y = v.y < 0.f ? m.y : r.y; return o;
}
template <class Epi, class Sched, bool ALIGN_EPI = false, bool SP2 = false>
__device__ __forceinline__ void gemm_phase(PG8_LAS unsigned char* lds, const Gemm g, const Sched& S, const Epi& E) {
    int tid_l = threadIdx.x; asm volatile("" : "+v"(tid_l)); const int tid = tid_l, wid = __builtin_amdgcn_readfirstlane(tid >> 6), lane = tid & 63, wr = wid >> 2, wc = wid & 3, fr = lane & 15, fq = lane >> 4;
    const int K = g.K, nt = K / BK;
    unsigned voffA[2], voffB[2];
#pragma unroll
    for (int i = 0; i < 2; ++i) { int R, C; stage_rc(tid * 16 + i * 8192, R, C); const int Rb = Epi::PERM ? ((R & ~31) + perm32(R & 31)) : R;
        voffA[i] = (unsigned)(R * K + C) * 2u; voffB[i] = (unsigned)(Rb * K + C) * 2u; }
    const size_t kstep = (size_t)(BK * 2);
    const size_t hstep = (size_t)HALF * K * 2;
    const size_t tstep = 2 * hstep;
    const unsigned ldsw = (unsigned)wid * 1024u;
    const int aoff = lds_byte(wr * 64 + fr, fq * 8), boff = lds_byte(wc * 32 + fr, fq * 8);
#define PG8_SA(b, h) (((b) * 2 + (h)) * HTB)
#define PG8_SB(b, h) ((4 + (b) * 2 + (h)) * HTB)
#define PG8_STAGE(bufoff, gbase, voff) do { _Pragma("unroll") for (int _i = 0; _i < 2; ++_i) \
        __builtin_amdgcn_global_load_lds((const unsigned*)((const char*)(gbase) + (voff)[_i]), (PG8_LAS unsigned*)(lds + (bufoff) + ldsw + _i * 8192), 16, 0, 0); } while (0)
#define PG8_LDA(dst, b, h) do { _Pragma("unroll") for (int m = 0; m < 4; ++m) _Pragma("unroll") for (int k = 0; k < 2; ++k) dst[m][k] = *(const PG8_LAS bf16x8*)(lds + PG8_SA(b, h) + aoff + m * 2048 + k * 1024); } while (0)
#define PG8_LDB(dst, b, h) do { _Pragma("unroll") for (int n = 0; n < 2; ++n) _Pragma("unroll") for (int k = 0; k < 2; ++k) dst[n][k] = *(const PG8_LAS bf16x8*)(lds + PG8_SB(b, h) + boff + n * 2048 + k * 1024); } while (0)
#define PG8_MMA(ai, bj, At, Bt) do { __builtin_amdgcn_s_setprio(1); _Pragma("unroll") for (int m = 0; m < 4; ++m) _Pragma("unroll") for (int n = 0; n < 2; ++n) _Pragma("unroll") for (int k = 0; k < 2; ++k) \
        acc[ai][bj][m][n] = __builtin_amdgcn_mfma_f32_16x16x32_bf16(Bt[n][k], At[m][k], acc[ai][bj][m][n], 0, 0, 0); __builtin_amdgcn_s_setprio(0); } while (0)
#define PG8_WAIT_V(n) asm volatile("s_waitcnt vmcnt(" #n ")" ::: "memory")
#define PG8_WAIT_L(n) asm volatile("s_waitcnt lgkmcnt(" #n ")" ::: "memory")
#define PG8_BAR __builtin_amdgcn_s_barrier()
#define PG8_SCHED __builtin_amdgcn_sched_barrier(0)
    Unit cur, nxt; int ui = 0;
    if (!S.next(0, cur)) return;
    f32x4 acc[2][2][4][2];
#pragma unroll
    for (int a = 0; a < 2; ++a)
#pragma unroll
        for (int b = 0; b < 2; ++b)
#pragma unroll
            for (int m = 0; m < 4; ++m)
#pragma unroll
                for (int n = 0; n < 2; ++n) acc[a][b][m][n] = (f32x4){0.f, 0.f, 0.f, 0.f};
    bf16x8 At[4][2], B0[2][2], B1[2][2];
    const char* cA = (const char*)g.A + (size_t)cur.pm * tstep; const char* cB = (const char*)g.Bt + (size_t)cur.pn * tstep;
    S.a_ready(cur);
    if constexpr (SP2) {
        PG8_STAGE(PG8_SB(0, 0), cB, voffB); PG8_STAGE(PG8_SB(0, 1), cB + hstep, voffB); PG8_STAGE(PG8_SA(0, 0), cA, voffA); PG8_STAGE(PG8_SA(0, 1), cA + hstep, voffA);
        if (wr == 1) PG8_BAR;
        PG8_WAIT_V(2); PG8_BAR;
        PG8_STAGE(PG8_SB(1, 0), cB + kstep, voffB); PG8_STAGE(PG8_SA(1, 0), cA + kstep, voffA); PG8_STAGE(PG8_SB(1, 1), cB + hstep + kstep, voffB);
        PG8_WAIT_V(6); PG8_BAR;
    } else {
        PG8_STAGE(PG8_SB(0, 0), cB, voffB); PG8_STAGE(PG8_SA(0, 0), cA, voffA); PG8_STAGE(PG8_SB(0, 1), cB + hstep, voffB); PG8_STAGE(PG8_SA(0, 1), cA + hstep, voffA);
        if (wr == 1) PG8_BAR;
        PG8_WAIT_V(4); PG8_BAR;
        PG8_STAGE(PG8_SB(1, 0), cB + kstep, voffB); PG8_STAGE(PG8_SA(1, 0), cA + kstep, voffA); PG8_STAGE(PG8_SB(1, 1), cB + hstep + kstep, voffB);
        PG8_WAIT_V(6); PG8_BAR;
    }
    for (;;) {
        const bool has_next = S.next(ui + 1, nxt);
        const char* nA = has_next ? (const char*)g.A + (size_t)nxt.pm * tstep : cA; const char* nB = has_next ? (const char*)g.Bt + (size_t)nxt.pn * tstep : cB;
        for (int t = 0; t < nt; t += 2) {
            const bool last = (t == nt - 2);
            const char* a1 = cA + (size_t)(t + 1) * kstep;
            const char* a2 = last ? nA : cA + (size_t)(t + 2) * kstep; const char* b2 = last ? nB : cB + (size_t)(t + 2) * kstep;
            const char* a3 = a2 + kstep; const char* b3 = b2 + kstep;
            if (last && has_next) S.a_ready(nxt);
            if constexpr (SP2) {
            PG8_LDB(B0, 0, 0); PG8_LDB(B1, 0, 1); PG8_SCHED; PG8_LDA(At, 0, 0); PG8_STAGE(PG8_SA(1, 1), a1 + hstep, voffA);
            PG8_WAIT_V(8); PG8_WAIT_L(0); PG8_BAR; PG8_MMA(0, 0, At, B0); PG8_MMA(0, 1, At, B1); PG8_BAR; PG8_SCHED;
            PG8_LDA(At, 0, 1); PG8_STAGE(PG8_SB(0, 0), b2, voffB); PG8_STAGE(PG8_SB(0, 1), b2 + hstep, voffB); PG8_STAGE(PG8_SA(0, 0), a2, voffA);
            PG8_WAIT_V(8); PG8_WAIT_L(0); PG8_BAR; PG8_MMA(1, 0, At, B0); PG8_MMA(1, 1, At, B1); PG8_BAR; PG8_SCHED;
            PG8_LDB(B0, 1, 0); PG8_LDB(B1, 1, 1); PG8_SCHED; PG8_LDA(At, 1, 0); PG8_STAGE(PG8_SA(0, 1), a2 + hstep, voffA);
            PG8_WAIT_V(8); PG8_WAIT_L(0); PG8_BAR; PG8_MMA(0, 0, At, B0); PG8_MMA(0, 1, At, B1); PG8_BAR; PG8_SCHED;
            PG8_LDA(At, 1, 1); PG8_STAGE(PG8_SB(1, 0), b3, voffB); PG8_STAGE(PG8_SB(1, 1), b3 + hstep, voffB); PG8_STAGE(PG8_SA(1, 0), a3, voffA);
            PG8_WAIT_V(8); PG8_WAIT_L(0); PG8_BAR; PG8_MMA(1, 0, At, B0); PG8_MMA(1, 1, At, B1); PG8_BAR; PG8_SCHED;
            } else {
            PG8_LDB(B0, 0, 0); PG8_SCHED; PG8_LDA(At, 0, 0); PG8_STAGE(PG8_SA(1, 1), a1 + hstep, voffA);
            PG8_WAIT_L(8); PG8_BAR; PG8_WAIT_L(0); PG8_MMA(0, 0, At, B0); PG8_BAR; PG8_SCHED;
            PG8_LDB(B1, 0, 1); PG8_STAGE(PG8_SB(0, 0), b2, voffB);
            PG8_BAR; PG8_WAIT_L(0); PG8_MMA(0, 1, At, B1); PG8_BAR;
            PG8_LDA(At, 0, 1); PG8_STAGE(PG8_SA(0, 0), a2, voffA);
            PG8_BAR; PG8_WAIT_L(0); PG8_MMA(1, 0, At, B0); PG8_BAR; PG8_SCHED;
            PG8_STAGE(PG8_SB(0, 1), b2 + hstep, voffB);
            PG8_WAIT_V(6); PG8_BAR; PG8_MMA(1, 1, At, B1); PG8_BAR;
            PG8_LDB(B0, 1, 0); PG8_SCHED; PG8_LDA(At, 1, 0); PG8_STAGE(PG8_SA(0, 1), a2 + hstep, voffA);
            PG8_WAIT_L(8); PG8_BAR; PG8_WAIT_L(0); PG8_MMA(0, 0, At, B0); PG8_BAR; PG8_SCHED;
            PG8_LDB(B1, 1, 1); PG8_STAGE(PG8_SB(1, 0), b3, voffB);
            PG8_BAR; PG8_WAIT_L(0); PG8_MMA(0, 1, At, B1); PG8_BAR;
            PG8_LDA(At, 1, 1); PG8_STAGE(PG8_SA(1, 0), a3, voffA);
            PG8_BAR; PG8_WAIT_L(0); PG8_MMA(1, 0, At, B0); PG8_BAR; PG8_SCHED;
            PG8_STAGE(PG8_SB(1, 1), b3 + hstep, voffB);
            PG8_WAIT_V(6); PG8_BAR; PG8_MMA(1, 1, At, B1); PG8_BAR;
            }
        }
        if constexpr (ALIGN_EPI) { if (wr == 0) PG8_BAR; }
        if constexpr (!Epi::AFTER_DRAIN) { E(acc, cur, wr, wc, fr, fq); S.done(cur); }
        if (!has_next) break;
#pragma unroll
        for (int a = 0; a < 2; ++a)
#pragma unroll
            for (int b = 0; b < 2; ++b)
#pragma unroll
                for (int m = 0; m < 4; ++m)
#pragma unroll
                    for (int n = 0; n < 2; ++n) acc[a][b][m][n] = (f32x4){0.f, 0.f, 0.f, 0.f};
        cur = nxt; cA = nA; cB = nB; ++ui;
        if constexpr (ALIGN_EPI) { if (wr == 1) PG8_BAR; }
    }
    PG8_WAIT_V(0);
    if constexpr (!ALIGN_EPI) { if (wr == 0) PG8_BAR; }
    PG8_BAR;
    if constexpr (Epi::AFTER_DRAIN) { E.fused(acc, cur, wr, wc, fr, fq, lds, wid, lane); S.done(cur); }
#undef PG8_SA
#undef PG8_SB
#undef PG8_STAGE
#undef PG8_LDA
#undef PG8_LDB
#undef PG8_MMA
#undef PG8_WAIT_V
#undef PG8_WAIT_L
#undef PG8_BAR
#undef PG8_SCHED
}
}
#ifndef PG8_SP2
#define PG8_SP2 true
#endif
#ifndef PG8_ALIGN
#define PG8_ALIGN false
#endif
#include <hip/hip_bf16.h>
#include <cmath>
namespace attn_body {
using bf16=__hip_bfloat16;
using bf16x8=__attribute__((ext_vector_type(8)))short;
using s16x4=__attribute__((ext_vector_type(4)))short;
using f32x16=__attribute__((ext_vector_type(16)))float;
using u32x4=__attribute__((ext_vector_type(4)))unsigned;
constexpr int SEQ=8192,D=64;
constexpr int NW=8,QBLK=32,QB=QBLK*NW,KVBLK=64,NQB=SEQ/QB;
constexpr int ATTN_UNIT_ROWS=QB;
__device__ __forceinline__ int crow(int r,int hi){return (r&3)+8*(r>>2)+4*hi;}
#define SBAR() __builtin_amdgcn_sched_barrier(0)
__device__ __forceinline__ void cmask(f32x16&p0,f32x16&p1,int jb,int qrel,int hi){
  const float NEG=-INFINITY; int kb=64*jb+4*hi;
  #pragma unroll
  for(int r=0;r<16;++r){int kv=kb+(r&3)+8*(r>>2); if(kv>qrel)p0[r]=NEG; if(kv+32>qrel)p1[r]=NEG;}
}

constexpr int SEL_OFF=86016;
template<int MODE,bool BAND> __device__ __forceinline__ void apply_mask(f32x16&p0,f32x16&p1,int t,int NT,int qrel,int hi,unsigned selmask,unsigned long long mw,float mhat){
  const float NEG=-INFINITY;
  if(MODE==0){
    const int jb=t-(NT-4);
    if(BAND&&jb>=0){ const int dq=qrel-64*jb; mw=(dq>=63)?~0ull:((dq<0)?0ull:((2ull<<dq)-1ull)); }
    else mw=(((selmask>>(t>>2))&1u)!=0u)?~0ull:0ull;
  }
  {
    const unsigned lo=((unsigned)mw)>>(4*hi), hw=((unsigned)(mw>>32))>>(4*hi);
    #pragma unroll
    for(int r=0;r<16;++r){ const int bt=(r&3)+8*(r>>2); p0[r]=((lo>>bt)&1u)?(p0[r]-mhat):NEG; p1[r]=((hw>>bt)&1u)?(p1[r]-mhat):NEG; }
  }
}
constexpr int NSLOT=3, SLOTB=8192;
constexpr int LDS_K=0, LDS_V=NSLOT*SLOTB, LDS_WS=2*NSLOT*SLOTB, LDS_OST=LDS_WS+NW*64*4, LDS_BYTES=LDS_OST+NW*4096;
constexpr float C2=0.125f*1.4426950408889634f;
__device__ __forceinline__ void glds16(const void*gsrc,unsigned lds_dst){unsigned keep;
  asm volatile("s_mov_b32 %0, m0\n\ts_mov_b32 m0, %2\n\ts_nop 0\n\tglobal_load_lds_dwordx4 %1, off\n\ts_mov_b32 m0, %0":"=&s"(keep):"v"(gsrc),"s"(lds_dst):"memory");}
__device__ __forceinline__ float max3f(float a,float b,float c){float r;asm("v_max3_f32 %0, %1, %2, %3":"=v"(r):"v"(a),"v"(b),"v"(c));return r;}
__device__ __forceinline__ float max2f(float a,float b){float r;asm("v_max_f32_e32 %0, %1, %2":"=v"(r):"v"(a),"v"(b));return r;}
__device__ __forceinline__ float fadd_s(float a,float b){float r;asm("v_add_f32_e32 %0, %1, %2":"=v"(r):"v"(a),"v"(b));return r;}
__device__ __forceinline__ float fsub_s(float a,float b){float r;asm("v_sub_f32_e32 %0, %1, %2":"=v"(r):"v"(a),"v"(b));return r;}
typedef float f32x2_t __attribute__((ext_vector_type(2))); typedef __bf16 bf16x2_t __attribute__((ext_vector_type(2)));
__device__ __forceinline__ unsigned cvtpk_s(float lo,float hi){f32x2_t v={lo,hi};bf16x2_t b=__builtin_convertvector(v,bf16x2_t);return __builtin_bit_cast(unsigned,b);}
#define WAIT_BAR(N) asm volatile("s_waitcnt vmcnt(" #N ") lgkmcnt(0)\n\ts_barrier":::"memory")

__device__ __forceinline__ void qkt(f32x16&p0,f32x16&p1,const char*Kslot,const bf16x8*qr,const f32x16&negm,int r32,int hi){
  const char*kb=Kslot+hi*1024+r32*16;
  #pragma unroll
  for(int d0=0;d0<4;++d0){
    const bf16x8 b0=*reinterpret_cast<const bf16x8*>(kb+d0*2048);
    const bf16x8 b1=*reinterpret_cast<const bf16x8*>(kb+d0*2048+512);
    if(d0==0){p0=__builtin_amdgcn_mfma_f32_32x32x16_bf16(b0,qr[0],negm,0,0,0);p1=__builtin_amdgcn_mfma_f32_32x32x16_bf16(b1,qr[0],negm,0,0,0);}
    else{p0=__builtin_amdgcn_mfma_f32_32x32x16_bf16(b0,qr[d0],p0,0,0,0);p1=__builtin_amdgcn_mfma_f32_32x32x16_bf16(b1,qr[d0],p1,0,0,0);}}
}
typedef __attribute__((address_space(3))) const char* lds_cptr;
typedef short v4i16_t __attribute__((ext_vector_type(4)));
__device__ __forceinline__ void kload8(bf16x8*kf,lds_cptr kp){
  kf[0]=*(const __attribute__((address_space(3))) bf16x8*)(kp);      kf[1]=*(const __attribute__((address_space(3))) bf16x8*)(kp+512);
  kf[2]=*(const __attribute__((address_space(3))) bf16x8*)(kp+2048); kf[3]=*(const __attribute__((address_space(3))) bf16x8*)(kp+2560);
  kf[4]=*(const __attribute__((address_space(3))) bf16x8*)(kp+4096); kf[5]=*(const __attribute__((address_space(3))) bf16x8*)(kp+4608);
  kf[6]=*(const __attribute__((address_space(3))) bf16x8*)(kp+6144); kf[7]=*(const __attribute__((address_space(3))) bf16x8*)(kp+6656);
}
__device__ __forceinline__ void kload2(bf16x8*kf,lds_cptr kp,int j){ kf[2*j]=*(const __attribute__((address_space(3))) bf16x8*)(kp+j*2048); kf[2*j+1]=*(const __attribute__((address_space(3))) bf16x8*)(kp+j*2048+512); }
__device__ __forceinline__ s16x4 vtr(lds_cptr p){ return __builtin_bit_cast(s16x4,__builtin_amdgcn_ds_read_tr16_b64_v4i16((__attribute__((address_space(3))) v4i16_t*)p)); }
__device__ __forceinline__ float rowmax(const f32x16&p0,const f32x16&p1){
  float a=max3f(p0[0],p0[1],p1[0]),b=max3f(p0[2],p0[3],p1[1]);a=max3f(a,p1[2],p1[3]);
  #pragma unroll
  for(int r=4;r<16;r+=4){a=max3f(a,p0[r],p0[r+1]);b=max3f(b,p0[r+2],p0[r+3]);a=max3f(a,p1[r],p1[r+1]);b=max3f(b,p1[r+2],p1[r+3]);}
  const float m=max2f(a,b);
  auto rr=__builtin_amdgcn_permlane32_swap(__float_as_uint(m),__float_as_uint(m),false,false);
  return max2f(__uint_as_float(rr[0]),__uint_as_float(rr[1]));
}
__device__ __forceinline__ void pv(f32x16*o,int vb,bf16x8 pa0,bf16x8 pa1,bf16x8 pa2,bf16x8 pa3){
  #pragma unroll
  for(int d0=0;d0<2;++d0){s16x4 lo[4],hi[4];
    #pragma unroll
    for(int ks=0;ks<4;++ks){
      asm volatile("ds_read_b64_tr_b16 %0,%1 offset:%c2":"=&v"(lo[ks]):"v"(vb),"i"(d0*4096+ks*1024):"memory");
      asm volatile("ds_read_b64_tr_b16 %0,%1 offset:%c2":"=&v"(hi[ks]):"v"(vb),"i"(d0*4096+ks*1024+512):"memory");}
    asm volatile("s_waitcnt lgkmcnt(0)":::"memory");SBAR();
    #define PK(k) (bf16x8){lo[k][0],lo[k][1],lo[k][2],lo[k][3],hi[k][0],hi[k][1],hi[k][2],hi[k][3]}
    o[d0]=__builtin_amdgcn_mfma_f32_32x32x16_bf16(pa0,PK(0),o[d0],0,0,0);
    o[d0]=__builtin_amdgcn_mfma_f32_32x32x16_bf16(pa1,PK(1),o[d0],0,0,0);
    o[d0]=__builtin_amdgcn_mfma_f32_32x32x16_bf16(pa2,PK(2),o[d0],0,0,0);
    o[d0]=__builtin_amdgcn_mfma_f32_32x32x16_bf16(pa3,PK(3),o[d0],0,0,0);
    #undef PK
  }
}

#ifndef ATTN_STORE16
#define ATTN_STORE16(p,v) (*(u32x4*)(p)=(v))
#endif
template<int MODE,int THRL,int QP,int KP> __device__ __forceinline__ void attn_unit(int qb,const bf16*Qh,const bf16*__restrict__ Kh,const bf16*__restrict__ Vh,bf16*Oh,const bf16*__restrict__ kmh,const bf16*__restrict__ kml,const unsigned long long*__restrict__ maskb,char*shm){
  int tid_l=threadIdx.x; asm volatile("":"+v"(tid_l)); const int tid=tid_l,lane=tid&63,r32=lane&31,hi=lane>>5; const int wid=__builtin_amdgcn_readfirstlane(tid>>6);
  const int q0=qb*QB;
  const bf16*Qw=Qh+(long)(q0+wid*QBLK)*QP;
  const unsigned lds0=(unsigned)(uintptr_t)shm;
  float*wsf=(float*)(shm+LDS_WS)+wid*64;
  const bf16*ksrc=Kh+(long)lane*KP+wid*8;
  const bf16*vsrc=Vh+(long)(16*(wid&3)+(lane>>2))*KP+(wid>>2)*32+(lane&3)*8;
  const unsigned kdst=lds0+LDS_K+wid*1024, vdst=lds0+LDS_V+wid*1024;
  #define DMA_K(t,slot) glds16(ksrc+(long)(t)*KVBLK*KP,(unsigned)__builtin_amdgcn_readfirstlane(kdst+(slot)))
  #define DMA_V(t,slot) glds16(vsrc+(long)(t)*KVBLK*KP,(unsigned)__builtin_amdgcn_readfirstlane(vdst+(slot)))
  const int vb0=(int)(lds0+LDS_V)+((lane>>4)&1)*32+(lane&3)*8+(4*hi+((lane&15)>>2))*64;
  const char*Kbase=shm+LDS_K; bf16x8 kf[8];
  const lds_cptr shm3=(lds_cptr)shm; const lds_cptr kp0=shm3+LDS_K+hi*1024+r32*16; const lds_cptr vp0=shm3+LDS_V+((lane>>4)&1)*32+(lane&3)*8+(4*hi+((lane&15)>>2))*64;
  const int NT=(q0+QB)/KVBLK;
  DMA_K(0,0);DMA_V(0,0);DMA_K(1,SLOTB);
  bf16x8 qr[4];
  #pragma unroll
  for(int d0=0;d0<4;++d0)qr[d0]=*reinterpret_cast<const bf16x8*>(&Qw[(long)r32*QP+d0*16+hi*8]);
  unsigned selmask=0u; unsigned long long mw0=0ull,mw_c=0ull,mw_n=0ull; const unsigned long long*mq=maskb;
  if(MODE==1){ mq=maskb+(long)(q0+wid*QBLK+r32)*128; mw0=mq[0]; mw_c=mq[1]; }
  if(MODE==0){ selmask=((const unsigned*)(shm+SEL_OFF))[wid*QBLK+r32]; }
  float mhat=0.f,l_reg=0.f;f32x16 o[2];o[0]=f32x16{};o[1]=f32x16{};const f32x16 zero16=f32x16{};
  const int qrel=wid*QBLK+r32;
  #define CMASK(P0,P1,t) apply_mask<MODE,true>(P0,P1,(t),NT,qrel,hi,selmask,mw_c,mhat)
  bool resc=false;
  #define START(P0,P1) do{ const float rm=rowmax(P0,P1); resc=false; \
    { const float dl=(rm>-1e30f)?rm:0.f; mhat=fadd_s(mhat,dl); \
      _Pragma("unroll") for(int r=0;r<16;++r){P0[r]=fsub_s(P0[r],dl);P1[r]=fsub_s(P1[r],dl);} \
      } \
    _Pragma("unroll") for(int r=0;r<16;++r)P0[r]=__builtin_amdgcn_exp2f(P0[r]); }while(0)
  #define RESC() do{ if(resc){ asm volatile("s_waitcnt lgkmcnt(0)":::"memory"); \
      _Pragma("unroll") for(int d_=0;d_<2;++d_) _Pragma("unroll") for(int r=0;r<16;++r)o[d_][r]*=wsf[crow(r,hi)]; } }while(0)
  f32x16 pA0,pA1,pB0,pB1;
  int sl_prev=0,sl_cur=0,sl_next=SLOTB;
  #define ROT() do{sl_prev=sl_cur;sl_cur=sl_next;sl_next=(sl_next==(NSLOT-1)*SLOTB)?0:sl_next+SLOTB;}while(0)
  DMA_K(2,2*SLOTB);
  WAIT_BAR(3);
  qkt(pA0,pA1,Kbase,qr,zero16,r32,hi);asm volatile("s_nop 15\n\ts_nop 7":"+v"(pA0),"+v"(pA1));apply_mask<MODE,true>(pA0,pA1,0,NT,qrel,hi,selmask,mw0,0.f);
  START(pA0,pA1);
  _Pragma("unroll") for(int r=0;r<16;++r)pA1[r]=__builtin_amdgcn_exp2f(pA1[r]);
  WAIT_BAR(0);
  DMA_K(3,0);DMA_V(1,SLOTB);
  ROT();
  kload8(kf,kp0+sl_cur);
  WAIT_BAR(2);
  s16x4 vlo[8],vhi[8]; u32x4 pw0,pw1,pw2,pw3;
  #define PKW(P,B) cvtpk_s(P[B],P[B+1])
  #define PAF(k) __builtin_bit_cast(bf16x8,pw##k)
  #define VFR(i) (bf16x8){vlo[i][0],vlo[i][1],vlo[i][2],vlo[i][3],vhi[i][0],vhi[i][1],vhi[i][2],vhi[i][3]}
  #define PIN(x) asm volatile("":"+v"(x))
  #define MX3(a,b,c) __builtin_fmaxf(__builtin_fmaxf((a),(b)),(c))
  #define GAPA(MF,A0,A1,A2,A3,W0,W1,PW) do{ MF; sacc+=A0; sacc+=A1; sacc+=A2; sacc+=A3; PIN(sacc); W0; W1; PIN(PW); SBAR(); }while(0)
  #define EX(v) __builtin_amdgcn_exp2f(v)
  #define GAPB(MF,X,B) do{ MF; X[B]=EX(X[B]); X[B+1]=EX(X[B+1]); X[B+2]=EX(X[B+2]); X[B+3]=EX(X[B+3]); PIN(X); SBAR(); }while(0)
  #define VRD(i) do{ vlo[i]=vtr(vp_+(((i)>>2)*4096+((i)&3)*1024)); vhi[i]=vtr(vp_+(((i)>>2)*4096+((i)&3)*1024+512)); }while(0)
  #define KRD(G,j) do{ if(G){ kload2(kf,kp0+sl_next,j); SBAR(); } }while(0)
  #define STEP(C0,C1,P0,P1,t,GK,GV,GL) do{ SBAR(); if(MODE==1){ mw_n=((t)+1<NT)?mq[(t)+1]:0ull; } \
    const lds_cptr vp_=vp0+sl_prev; \
    VRD(0); SBAR(); float sacc=(P0[0]+P0[1]); \
    GAPA(C0=__builtin_amdgcn_mfma_f32_32x32x16_bf16(kf[0],qr[0],zero16,0,0,0), P0[2],P0[3],P0[4],P0[5],     pw0[0]=PKW(P0,0), pw0[1]=PKW(P0,2), pw0); \
    VRD(4); SBAR(); GAPA(C1=__builtin_amdgcn_mfma_f32_32x32x16_bf16(kf[1],qr[0],zero16,0,0,0), P0[6],P0[7],P0[8],P0[9],     pw0[2]=PKW(P0,4), pw0[3]=PKW(P0,6), pw0); \
    VRD(1); SBAR(); GAPA(C0=__builtin_amdgcn_mfma_f32_32x32x16_bf16(kf[2],qr[1],C0,0,0,0),   P0[10],P0[11],P0[12],P0[13], pw1[0]=PKW(P0,8), pw1[1]=PKW(P0,10), pw1); \
    VRD(5); SBAR(); GAPA(C1=__builtin_amdgcn_mfma_f32_32x32x16_bf16(kf[3],qr[1],C1,0,0,0),   P0[14],P0[15],P1[0],P1[1],   pw1[2]=PKW(P0,12),pw1[3]=PKW(P0,14), pw1); \
    VRD(2); SBAR(); GAPA(C0=__builtin_amdgcn_mfma_f32_32x32x16_bf16(kf[4],qr[2],C0,0,0,0),   P1[2],P1[3],P1[4],P1[5],     pw2[0]=PKW(P1,0), pw2[1]=PKW(P1,2), pw2); \
    VRD(6); SBAR(); GAPA(C1=__builtin_amdgcn_mfma_f32_32x32x16_bf16(kf[5],qr[2],C1,0,0,0),   P1[6],P1[7],P1[8],P1[9],     pw2[2]=PKW(P1,4), pw2[3]=PKW(P1,6), pw2); \
    VRD(3); SBAR(); GAPA(C0=__builtin_amdgcn_mfma_f32_32x32x16_bf16(kf[6],qr[3],C0,0,0,0),   P1[10],P1[11],P1[12],P1[13], pw3[0]=PKW(P1,8), pw3[1]=PKW(P1,10), pw3); \
    VRD(7); SBAR(); GAPA(C1=__builtin_amdgcn_mfma_f32_32x32x16_bf16(kf[7],qr[3],C1,0,0,0),   P1[14],P1[15],0.f,0.f,       pw3[2]=PKW(P1,12),pw3[3]=PKW(P1,14), pw3); \
    l_reg+=sacc; \
    CMASK(C0,C1,t); if(MODE==1){ mw_c=mw_n; } \
    if(GK){DMA_K((t)+3,sl_cur);} if(GV){DMA_V((t)+1,sl_next);} \
    { float a=MX3(C0[0],C0[1],C1[0]),b=MX3(C0[2],C0[3],C1[1]); a=MX3(a,C1[2],C1[3]); \
      _Pragma("unroll") for(int r=4;r<16;r+=4){a=MX3(a,C0[r],C0[r+1]);b=MX3(b,C0[r+2],C0[r+3]);a=MX3(a,C1[r],C1[r+1]);b=MX3(b,C1[r+2],C1[r+3]);} \
      float rm=__builtin_fmaxf(a,b); { auto rr=__builtin_amdgcn_permlane32_swap(__float_as_uint(rm),__float_as_uint(rm),false,false); rm=__builtin_fmaxf(__uint_as_float(rr[0]),__uint_as_float(rr[1])); } \
      resc=false; \
      if(__builtin_expect(__any(rm>(float)THRL),0)){ const float dl=__builtin_fmaxf(rm,0.f); mhat+=dl; \
        _Pragma("unroll") for(int r=0;r<16;++r){C0[r]-=dl;C1[r]-=dl;} \
        const float f=__builtin_amdgcn_exp2f(-dl); l_reg*=f; if(hi==0)wsf[r32]=f; resc=true; } } \
    SBAR(); \
    GAPB(o[0]=__builtin_amdgcn_mfma_f32_32x32x16_bf16(PAF(0),VFR(0),o[0],0,0,0), C0,0); \
    GAPB(o[1]=__builtin_amdgcn_mfma_f32_32x32x16_bf16(PAF(0),VFR(4),o[1],0,0,0), C0,4); \
    KRD(GL,0); GAPB(o[0]=__builtin_amdgcn_mfma_f32_32x32x16_bf16(PAF(1),VFR(1),o[0],0,0,0), C0,8); \
    KRD(GL,1); GAPB(o[1]=__builtin_amdgcn_mfma_f32_32x32x16_bf16(PAF(1),VFR(5),o[1],0,0,0), C0,12); \
    KRD(GL,2); GAPB(o[0]=__builtin_amdgcn_mfma_f32_32x32x16_bf16(PAF(2),VFR(2),o[0],0,0,0), C1,0); \
    KRD(GL,3); GAPB(o[1]=__builtin_amdgcn_mfma_f32_32x32x16_bf16(PAF(2),VFR(6),o[1],0,0,0), C1,4); \
    GAPB(o[0]=__builtin_amdgcn_mfma_f32_32x32x16_bf16(PAF(3),VFR(3),o[0],0,0,0), C1,8); \
    GAPB(o[1]=__builtin_amdgcn_mfma_f32_32x32x16_bf16(PAF(3),VFR(7),o[1],0,0,0), C1,12); \
    }while(0)
  int t=1;
  #undef CMASK
  #define CMASK(P0,P1,t) apply_mask<MODE,false>(P0,P1,(t),NT,qrel,hi,selmask,mw_c,mhat)
  for(;t+5<NT;t+=2){
    STEP(pB0,pB1,pA0,pA1,t,true,true,true);     WAIT_BAR(2); RESC(); ROT();
    STEP(pA0,pA1,pB0,pB1,t+1,true,true,true);   WAIT_BAR(2); RESC(); ROT();
  }
  #undef CMASK
  #define CMASK(P0,P1,t) apply_mask<MODE,true>(P0,P1,(t),NT,qrel,hi,selmask,mw_c,mhat)
  #define ENDW(tt) do{ if((tt)+3<NT){WAIT_BAR(2);} else if((tt)+2<NT){WAIT_BAR(1);} else {WAIT_BAR(0);} }while(0)
  for(;t+1<NT;t+=2){
    STEP(pB0,pB1,pA0,pA1,t,(t+3<NT),(t+1<NT),(t+1<NT));       ENDW(t);   RESC(); ROT();
    STEP(pA0,pA1,pB0,pB1,t+1,(t+4<NT),(t+2<NT),(t+2<NT));     ENDW(t+1); RESC(); ROT();
  }
  STEP(pB0,pB1,pA0,pA1,NT-1,false,false,false); RESC();
  { float sacc=pB0[0]+pB0[1]; _Pragma("unroll") for(int r=2;r<16;++r)sacc+=pB0[r]; _Pragma("unroll") for(int r=0;r<16;++r)sacc+=pB1[r]; l_reg+=sacc;
    pw0=(u32x4){PKW(pB0,0),PKW(pB0,2),PKW(pB0,4),PKW(pB0,6)};pw1=(u32x4){PKW(pB0,8),PKW(pB0,10),PKW(pB0,12),PKW(pB0,14)};pw2=(u32x4){PKW(pB1,0),PKW(pB1,2),PKW(pB1,4),PKW(pB1,6)};pw3=(u32x4){PKW(pB1,8),PKW(pB1,10),PKW(pB1,12),PKW(pB1,14)};
    SBAR(); pv(o,vb0+sl_cur,PAF(0),PAF(1),PAF(2),PAF(3)); }
  #undef PKW
  #undef PAF
  #undef VFR
  #undef PIN
  #undef MX3
  #undef GAPA
  #undef GAPB
  #undef EX
  #undef VRD
  #undef KRD
  #undef STEP
  #undef ENDW
  {auto rr=__builtin_amdgcn_permlane32_swap(__float_as_uint(l_reg),__float_as_uint(l_reg),false,false);l_reg=__uint_as_float(rr[0])+__uint_as_float(rr[1]);}
  if(hi==0)wsf[32+r32]=l_reg;asm volatile("s_waitcnt lgkmcnt(0)":::"memory");
  float rli[16];
  #pragma unroll
  for(int r=0;r<16;++r)rli[r]=__builtin_amdgcn_rcpf(wsf[32+crow(r,hi)]);
  bf16*Ow=Oh+(long)(q0+wid*QBLK)*QP;
  { bf16*stg=(bf16*)(shm+LDS_OST)+wid*2048;
    #pragma unroll
    for(int r=0;r<16;++r){const int orow=crow(r,hi);
      #pragma unroll
      for(int d0=0;d0<2;++d0)stg[orow*64+d0*32+r32]=__float2bfloat16(o[d0][r]*rli[r]);}
    asm volatile("s_waitcnt lgkmcnt(0)":::"memory");
    #pragma unroll
    for(int i=0;i<4;++i){const int row=i*8+(lane>>3),ch=lane&7; const u32x4 v=*(const u32x4*)(stg+row*64+ch*8); ATTN_STORE16(Ow+(long)row*QP+ch*8,v);} }
  asm volatile("s_waitcnt lgkmcnt(0)\n\ts_barrier":::"memory");
  #undef DMA_K
  #undef DMA_V
  #undef CMASK
  #undef START
  #undef RESC
  #undef ROT
}
constexpr int ATTN_LDS_BYTES=LDS_BYTES;

static_assert(SEL_OFF>=LDS_BYTES,"selection words above the attention body's own LDS use");
template<int QP> __device__ __forceinline__ void moba_gates(int qb,const bf16*Qh,const bf16*__restrict__ kmh,const bf16*__restrict__ kml,char*shm){
  int tid_l=threadIdx.x; asm volatile("":"+v"(tid_l)); const int tid=tid_l,lane=tid&63,r32=lane&31,hi=lane>>5; const int wid=__builtin_amdgcn_readfirstlane(tid>>6);
  const int q0=qb*QB; const bf16*Qw=Qh+(long)(q0+wid*QBLK)*QP;
  bf16x8 qr[4];
  #pragma unroll
  for(int d0=0;d0<4;++d0)qr[d0]=*reinterpret_cast<const bf16x8*>(&Qw[(long)r32*QP+d0*16+hi*8]);
  unsigned selmask=0u;
  {
    f32x16 g=f32x16{};
    #pragma unroll
    for(int d0=0;d0<4;++d0){
      const bf16x8 ah=*reinterpret_cast<const bf16x8*>(&kmh[r32*64+d0*16+hi*8]);
      const bf16x8 al=*reinterpret_cast<const bf16x8*>(&kml[r32*64+d0*16+hi*8]);
      g=__builtin_amdgcn_mfma_f32_32x32x16_bf16(ah,qr[d0],g,0,0,0);
      g=__builtin_amdgcn_mfma_f32_32x32x16_bf16(al,qr[d0],g,0,0,0);}
    float v1=-INFINITY,v2=-INFINITY,v3=-INFINITY; int i1=64,i2=64,i3=64;
    #define TOP3_INS(vv,ii) do{ const float v_=(vv); const int i_=(ii); \
      const bool b1=(v_>v1)||(v_==v1&&i_<i1), b2=(v_>v2)||(v_==v2&&i_<i2), b3=(v_>v3)||(v_==v3&&i_<i3); \
      if(b1){v3=v2;i3=i2;v2=v1;i2=i1;v1=v_;i1=i_;} else if(b2){v3=v2;i3=i2;v2=v_;i2=i_;} else if(b3){v3=v_;i3=i_;} }while(0)
    #pragma unroll
    for(int r=0;r<16;++r){ const int j=crow(r,hi); const float gv=(j<qb)?g[r]:-INFINITY; TOP3_INS(gv,(j<qb)?j:64); }
    { const float pv1=__shfl_xor(v1,32),pv2=__shfl_xor(v2,32),pv3=__shfl_xor(v3,32); const int pi1=__shfl_xor(i1,32),pi2=__shfl_xor(i2,32),pi3=__shfl_xor(i3,32);
      TOP3_INS(pv1,pi1); TOP3_INS(pv2,pi2); TOP3_INS(pv3,pi3); }
    #undef TOP3_INS
    if(i1<32)selmask|=1u<<i1; if(i2<32)selmask|=1u<<i2; if(i3<32)selmask|=1u<<i3;
  }
  if(hi==0)((unsigned*)(shm+SEL_OFF))[wid*QBLK+r32]=selmask;
}
#undef SBAR
#undef WAIT_BAR
}
#define GAS __attribute__((address_space(1)))
#define LAS __attribute__((address_space(3)))
typedef unsigned short bf16;
typedef unsigned v4u __attribute__((ext_vector_type(4)));
typedef float f32x4 __attribute__((ext_vector_type(4)));
typedef short bf16x8 __attribute__((ext_vector_type(8)));
typedef GAS unsigned gu32;
typedef GAS unsigned long long gu64;
#define RLX_AGENT __ATOMIC_RELAXED, __HIP_MEMORY_SCOPE_AGENT
#define LDS_WAIT() asm volatile("s_waitcnt lgkmcnt(0)" ::: "memory")
#define VM_WAIT() asm volatile("s_waitcnt vmcnt(0)" ::: "memory")
__device__ __forceinline__ unsigned long long rt() { return __builtin_amdgcn_s_memrealtime(); }
__device__ __forceinline__ unsigned f2bf(float f) { unsigned u = __builtin_bit_cast(unsigned, f); return (u + 0x7fffu + ((u >> 16) & 1u)) >> 16; }
__device__ __forceinline__ unsigned pk2(float lo, float hi) { return f2bf(lo) | (f2bf(hi) << 16); }

#define XB_TMO      128
#define XB_XCNT(j)  (256  + 64 * (j))
#define XB_XSUB(j)  (1280 + 64 * (j))
#define XB_XGEN(j)  (2304 + 64 * (j))
#define XB_TOP      3328
#define XB_TOPGEN   3392
#define XCD_BAR_WORDS 3456
#define XB_SPIN_CAP (1u << 18)

__device__ __forceinline__ unsigned xb_ld(unsigned* p)              { return __hip_atomic_load(p, __ATOMIC_RELAXED, __HIP_MEMORY_SCOPE_AGENT); }
__device__ __forceinline__ unsigned xb_add(unsigned* p, unsigned v) { return __hip_atomic_fetch_add(p, v, __ATOMIC_RELAXED, __HIP_MEMORY_SCOPE_AGENT); }
__device__ __forceinline__ unsigned xb_xcc_id() { return (unsigned)__builtin_amdgcn_s_getreg((3 << 11) | 20) & 0xFu; }
#define XB_SPIN(cond, bar) do { unsigned _sp = 0; while (cond) { __builtin_amdgcn_s_sleep(1); \
    if ((++_sp & 255u) == 0u) { if (xb_ld(&(bar)[XB_TMO])) break; if (_sp > XB_SPIN_CAP) { atomicAdd(&(bar)[XB_TMO], 1u); break; } } } } while (0)

struct XcdBarrier {
    unsigned* bar; unsigned x;
    volatile LAS unsigned* st;
};

__device__ __forceinline__ XcdBarrier xcd_barrier_post(unsigned* bar, volatile LAS unsigned* st) {
    XcdBarrier b; b.bar = bar; b.x = xb_xcc_id(); b.st = st;
    if (threadIdx.x == 0) (void)xb_add(&bar[XB_XCNT(b.x)], 1u);
    return b;
}
__device__ __forceinline__ void xcd_barrier_complete(unsigned* bar, unsigned x, unsigned& nloc, unsigned& nx) {
    const unsigned G = gridDim.x * gridDim.y * gridDim.z;
    unsigned sum, cnt, mine, sp = 0u;
    for (;;) {
        sum = 0u; cnt = 0u; mine = 0u;
#pragma unroll
        for (unsigned j = 0; j < 16; ++j) { const unsigned c = xb_ld(&bar[XB_XCNT(j)]); sum += c; cnt += (c > 0u) ? 1u : 0u; mine = (j == x) ? c : mine; }
        if (sum == G) break;
        __builtin_amdgcn_s_sleep(1);
        if ((++sp & 255u) == 0u) { if (xb_ld(&bar[XB_TMO])) break; if (sp > XB_SPIN_CAP) { atomicAdd(&bar[XB_TMO], 1u); break; } }
    }
    nloc = mine > 0u ? mine : 1u; nx = cnt > 0u ? cnt : 1u;
}

__device__ __forceinline__ void xcd_barrier(const XcdBarrier& b) {
    asm volatile("s_waitcnt vmcnt(0)" ::: "memory");
    __syncthreads();
    if (threadIdx.x == 0) {
        unsigned* bar = b.bar;
        __builtin_amdgcn_s_waitcnt(0);
        unsigned nloc = b.st[0], nx = b.st[1];
        if (nloc == 0u) { xcd_barrier_complete(bar, b.x, nloc, nx); b.st[0] = nloc; b.st[1] = nx; }
        const unsigned old = xb_add(&bar[XB_XSUB(b.x)], 1u);
        const unsigned gen = old / nloc;
        if (old + 1u == (gen + 1u) * nloc) {
            __builtin_amdgcn_fence(__ATOMIC_RELEASE, "agent");
            asm volatile("s_waitcnt vmcnt(0)" ::: "memory");
            const unsigned og = xb_add(&bar[XB_TOP], 1u);
            const unsigned tg = og / nx;
            if (og + 1u == (tg + 1u) * nx) xb_add(&bar[XB_TOPGEN], 1u);
            else XB_SPIN(xb_ld(&bar[XB_TOPGEN]) == tg, bar);
            __builtin_amdgcn_fence(__ATOMIC_ACQUIRE, "agent");
            xb_add(&bar[XB_XGEN(b.x)], 1u);
            asm volatile("s_waitcnt vmcnt(0)" ::: "memory");
        } else {
            XB_SPIN(xb_ld(&bar[XB_XGEN(b.x)]) == gen, bar);
            __builtin_amdgcn_fence(__ATOMIC_ACQUIRE, "agent");
            asm volatile("s_waitcnt vmcnt(0)" ::: "memory");
        }
    }
    __syncthreads();
}

constexpr int NWAVES = 8;
constexpr int SEQ = 8192, DMODEL = 1024, MROWS = 16384, DFF = 2816;
constexpr float RMS_EPS = 1e-6f;
constexpr float QC2 = 0.125f * 1.4426950408889634f;
constexpr size_t MiB = 1u << 20;
constexpr size_t WS_CTL = 0, CTL_ZERO_BYTES = 1 * MiB;
constexpr size_t WS_W_IN0 = 1 * MiB, WS_W_OUT0 = 6 * MiB, WS_W_GU0 = 8 * MiB, WS_W_DN0 = 19 * MiB, WS_W_PG0 = 25 * MiB, WS_W_PP0 = 27 * MiB;
constexpr size_t WS_W_IN1 = 28 * MiB, WS_W_OUT1 = 36 * MiB, WS_W_GU1 = 38 * MiB, WS_W_DN1 = 49 * MiB, WS_W_PG1 = 55 * MiB, WS_W_PP1 = 57 * MiB;
constexpr size_t WS_ROPE = 58 * MiB;
constexpr size_t WS_ROWSS = 59 * MiB;
constexpr size_t WS_KMH = 60 * MiB, WS_KML = 60 * MiB + 64 * 1024, WS_WI = 60 * MiB + 512 * 1024;
constexpr size_t WS_KIRAW = 61 * MiB, WS_KI = 65 * MiB;
constexpr size_t WS_HB = 68 * MiB, WS_PB = 100 * MiB, WS_MASK = 116 * MiB, WS_R = 132 * MiB;
constexpr size_t WS_QO = WS_R, WS_VA = WS_R + 32 * MiB, WS_KB0 = WS_R + 48 * MiB, WS_VB0 = WS_R + 64 * MiB;
constexpr size_t WS_KC = WS_R + 32 * MiB, WS_VC = WS_R + 64 * MiB, WS_QI = WS_R + 96 * MiB;
constexpr size_t WS_HID = WS_R,
#ifdef PROBE_G_ELSEWHERE
 WS_G = 100 * MiB,
#else
 WS_G = WS_R,
#endif
 WS_END = 256 * MiB;
static_assert(WS_QI + 16 * MiB <= WS_END && WS_HID + (size_t)MROWS * DFF * 2 <= WS_END, "ws map");
constexpr int CW_BAR = 4096;
constexpr int PHASE_LDS = 147456, LDSCTL_OFF = PHASE_LDS, LDS_BYTES = PHASE_LDS + 1024;

#ifndef PHMASK
#define PHMASK 0xffffffffu
#endif
#define RUNPH(k) (((PHMASK) >> (k)) & 1u)
struct Args { const float* in[22]; float* out; unsigned char* ws; float f0, f1, f2, f3, f4, f5, f6, f7; };
typedef const __attribute__((address_space(4))) Args* KArgs;

namespace epi {
using pg8::f32x4; using pg8::f32x2; using pg8::Unit; using pg8::bf16_t;
typedef unsigned u32x2 __attribute__((ext_vector_type(2)));
typedef __bf16 bf16x2_t __attribute__((ext_vector_type(2)));
__device__ __forceinline__ unsigned cvtpk(float lo, float hi) { const f32x2 v = {lo, hi}; const bf16x2_t b = __builtin_convertvector(v, bf16x2_t); return __builtin_bit_cast(unsigned, b); }
__device__ __forceinline__ void st4(bf16_t* p, f32x4 v) { u32x2 w; w.x = cvtpk(v[0], v[1]); w.y = cvtpk(v[2], v[3]); *(u32x2*)p = w; }
__device__ __forceinline__ f32x4 ld4(const bf16_t* p) { const u32x2 w = *(const u32x2*)p; f32x4 v; v[0] = __uint_as_float(w.x << 16); v[1] = __uint_as_float(w.x & 0xffff0000u); v[2] = __uint_as_float(w.y << 16); v[3] = __uint_as_float(w.y & 0xffff0000u); return v; }
__device__ __forceinline__ f32x4 gelu4(f32x4 v) { const f32x2 a = pg8::gelu_pk((f32x2){v[0], v[1]}), b = pg8::gelu_pk((f32x2){v[2], v[3]}); return (f32x4){a.x, a.y, b.x, b.y}; }
__device__ __forceinline__ float sigm(float x) { return __builtin_amdgcn_rcpf(1.f + __builtin_amdgcn_exp2f(-1.4426950408889634f * x)); }
__device__ __forceinline__ float sum_fq(float s) {
    auto a = __builtin_amdgcn_permlane16_swap(__float_as_uint(s), __float_as_uint(s), false, false); s = __uint_as_float(a[0]) + __uint_as_float(a[1]);
    auto b = __builtin_amdgcn_permlane32_swap(__float_as_uint(s), __float_as_uint(s), false, false); return __uint_as_float(b[0]) + __uint_as_float(b[1]);
}
__device__ __forceinline__ float xor32(float v, int fq) {
    auto b = __builtin_amdgcn_permlane32_swap(__float_as_uint(v), __float_as_uint(v), false, false); return __uint_as_float(fq < 2 ? b[1] : b[0]);
}
__device__ __forceinline__ void row_rstd(const float* rowss, int row0, int ai, int fq, float (&rs)[4]) {
#pragma unroll
    for (int m = 0; m < 4; ++m) { const int row = row0 + ai * 128 + m * 16; const f32x4 v = *(const f32x4*)(rowss + (size_t)row * 16 + 4 * fq);
        const float s = sum_fq((v[0] + v[1]) + (v[2] + v[3])); rs[m] = 1.0f / sqrtf(s * (1.f / 1024.f) + RMS_EPS); }
}
#define EPI_FENCE() asm volatile("" ::: "memory")
__device__ __forceinline__ f32x4 rope4(f32x4 v, const float* cs, const float* sn, int row, int fq) {
    const f32x4 c = *(const f32x4*)(cs + (size_t)row * 8 + 4 * (fq & 1)), s = *(const f32x4*)(sn + (size_t)row * 8 + 4 * (fq & 1));
    f32x4 p; p[0] = xor32(v[0], fq); p[1] = xor32(v[1], fq); p[2] = xor32(v[2], fq); p[3] = xor32(v[3], fq);
    f32x4 o;
#pragma unroll
    for (int j = 0; j < 4; ++j) o[j] = (fq < 2) ? (v[j] * c[j] - p[j] * s[j]) : (v[j] * c[j] + p[j] * s[j]);
    return o;
}
struct EpiInEven {
    static constexpr bool PERM = false, AFTER_DRAIN = false;
    const float* rowss; const float* cs; const float* sn; bf16_t *UQ, *VA, *KB, *VB;
    __device__ __forceinline__ void operator()(const f32x4 (&acc)[2][2][4][2], const Unit& u, int wr, int wc, int fr, int fq) const {
        const int row0 = u.pm * 256 + wr * 64 + fr;
        const int sec = u.pn >> 1, cb = (u.pn & 1) * 256 + wc * 32 + 4 * fq; const bool ropew = (wc & 1) == 0;
#pragma unroll
        for (int ai = 0; ai < 2; ++ai) { float rs[4]; row_rstd(rowss, row0, ai, fq, rs);
#pragma unroll
            for (int m = 0; m < 4; ++m) { const int row = row0 + ai * 128 + m * 16; const float r_ = rs[m];
#pragma unroll
                for (int bj = 0; bj < 2; ++bj)
#pragma unroll
                    for (int n = 0; n < 2; ++n) { const int c = cb + bj * 128 + n * 16; f32x4 v = acc[ai][bj][m][n] * r_;
                        if (sec == 0) { st4(UQ + (size_t)row * 1024 + c, gelu4(v)); }
                        else if (sec == 1) { st4(VA + (size_t)row * 512 + c, gelu4(v)); }
                        else if (sec == 2) { if (n == 0 && ropew) v = rope4(v, cs, sn, row, fq); st4(UQ + (size_t)row * 1024 + 512 + c, v * QC2); }
                        else if (sec == 3) { if (n == 0 && ropew) v = rope4(v, cs, sn, row, fq); st4(KB + (size_t)row * 512 + c, v); }
                        else { st4(VB + (size_t)row * 512 + c, v); } }
                EPI_FENCE(); } }
    }
};
struct EpiResid {
    static constexpr bool PERM = false, AFTER_DRAIN = false;
    const float* base; float* out; bf16_t* hb; float* rowss;
    __device__ __forceinline__ void operator()(const f32x4 (&acc)[2][2][4][2], const Unit& u, int wr, int wc, int fr, int fq) const {
        const int row0 = u.pm * 256 + wr * 64 + fr, cb = u.pn * 256 + wc * 32 + 4 * fq;
#pragma unroll
        for (int ai = 0; ai < 2; ++ai)
#pragma unroll
            for (int m = 0; m < 4; ++m) { const int row = row0 + ai * 128 + m * 16; float ss = 0.f;
#pragma unroll
                for (int bj = 0; bj < 2; ++bj)
#pragma unroll
                    for (int n = 0; n < 2; ++n) { const size_t off = (size_t)row * 1024 + cb + bj * 128 + n * 16; const f32x4 h = *(const f32x4*)(base + off) + acc[ai][bj][m][n];
                        *(f32x4*)(out + off) = h; st4(hb + off, h); ss += (h[0] * h[0] + h[1] * h[1]) + (h[2] * h[2] + h[3] * h[3]); }
                ss = sum_fq(ss);
                if (fq == 0) rowss[(size_t)row * 16 + u.pn * 4 + wc] = ss;
                EPI_FENCE(); }
    }
};
struct EpiSwiglu {
    static constexpr bool PERM = false, AFTER_DRAIN = false;
    const float* rowss; bf16_t* HID;
    __device__ __forceinline__ void operator()(const f32x4 (&acc)[2][2][4][2], const Unit& u, int wr, int wc, int fr, int fq) const {
        const int row0 = u.pm * 256 + wr * 64 + fr;
        const int cb = u.pn * 128 + wc * 32 + 4 * fq;
#pragma unroll
        for (int ai = 0; ai < 2; ++ai) { float rs[4]; row_rstd(rowss, row0, ai, fq, rs);
#pragma unroll
            for (int m = 0; m < 4; ++m) { const int row = row0 + ai * 128 + m * 16; const float r_ = rs[m];
#pragma unroll
                for (int n = 0; n < 2; ++n) { const f32x4 g = acc[ai][0][m][n] * r_, up = acc[ai][1][m][n] * r_; f32x4 o;
#pragma unroll
                    for (int j = 0; j < 4; ++j) o[j] = g[j] * up[j] * sigm(g[j]);
                    st4(HID + (size_t)row * DFF + cb + n * 16, o); }
                EPI_FENCE(); } }
    }
};
struct EpiPleGate {
    static constexpr bool PERM = false, AFTER_DRAIN = false;
    const float* rowss; bf16_t* G;
    __device__ __forceinline__ void operator()(const f32x4 (&acc)[2][2][4][2], const Unit& u, int wr, int wc, int fr, int fq) const {
        const int row0 = u.pm * 256 + wr * 64 + fr;
        const int cb = u.pn * 256 + wc * 32 + 4 * fq;
#pragma unroll
        for (int ai = 0; ai < 2; ++ai) { float rs[4];
#ifdef PROBE_NORSTD
 rs[0] = rs[1] = rs[2] = rs[3] = 0.03f;
#else
 row_rstd(rowss, row0, ai, fq, rs);
#endif

#pragma unroll
            for (int m = 0; m < 4; ++m) { const int row = row0 + ai * 128 + m * 16; const float r_ = rs[m];
#pragma unroll
                for (int bj = 0; bj < 2; ++bj)
#pragma unroll
                    for (int n = 0; n < 2; ++n) {
#ifdef PROBE_ACC1
 const f32x4 v = (f32x4){r_, r_, r_, r_};
#else
 const f32x4 v = acc[ai][bj][m][n] * r_;
#endif
 f32x4 o;
#pragma unroll
                        for (int j = 0; j < 4; ++j) o[j] = sigm(v[j]);
                        st4(G + (size_t)row * 1024 + cb + bj * 128 + n * 16, o); }
                EPI_FENCE(); } }
    }
};
struct EpiPleProj {
    static constexpr bool PERM = false, AFTER_DRAIN = false;
    const float* base; float* out; bf16_t* hb; float* rowss; const bf16_t* G;
    __device__ __forceinline__ void operator()(const f32x4 (&acc)[2][2][4][2], const Unit& u, int wr, int wc, int fr, int fq) const {
        const int row0 = u.pm * 256 + wr * 64 + fr, cb = u.pn * 256 + wc * 32 + 4 * fq;
#pragma unroll
        for (int ai = 0; ai < 2; ++ai)
#pragma unroll
            for (int m = 0; m < 4; ++m) { const int row = row0 + ai * 128 + m * 16; float ss = 0.f;
#pragma unroll
                for (int bj = 0; bj < 2; ++bj)
#pragma unroll
                    for (int n = 0; n < 2; ++n) { const size_t off = (size_t)row * 1024 + cb + bj * 128 + n * 16; const f32x4 h = *(const f32x4*)(base + off) + acc[ai][bj][m][n] * ld4(G + off);
                        *(f32x4*)(out + off) = h; st4(hb + off, h); ss += (h[0] * h[0] + h[1] * h[1]) + (h[2] * h[2] + h[3] * h[3]); }
                ss = sum_fq(ss);
                if (fq == 0) rowss[(size_t)row * 16 + u.pn * 4 + wc] = ss;
                EPI_FENCE(); }
    }
};
struct EpiInOdd {
    static constexpr bool PERM = false, AFTER_DRAIN = false;
    const float* rowss; const float* cs; const float* sn; bf16_t *QO, *KC, *VC, *QI; float* KIRAW; float* WI;
    __device__ __forceinline__ void operator()(const f32x4 (&acc)[2][2][4][2], const Unit& u, int wr, int wc, int fr, int fq) const {
        const int row0 = u.pm * 256 + wr * 64 + fr;
        const int pn = u.pn, cl = wc * 32 + 4 * fq; const bool ropew = (wc & 1) == 0;
#pragma unroll
        for (int ai = 0; ai < 2; ++ai) { float rs[4]; row_rstd(rowss, row0, ai, fq, rs);
#pragma unroll
            for (int m = 0; m < 4; ++m) { const int row = row0 + ai * 128 + m * 16; const float r_ = rs[m];
#pragma unroll
                for (int bj = 0; bj < 2; ++bj)
#pragma unroll
                    for (int n = 0; n < 2; ++n) { const int c = cl + bj * 128 + n * 16; f32x4 v = acc[ai][bj][m][n] * r_;
                        if (pn < 4) { if (n == 0 && ropew) v = rope4(v, cs, sn, row, fq); st4(QO + (size_t)row * 1024 + pn * 256 + c, v * QC2); }
                        else if (pn < 8) { if (n == 0 && ropew) v = rope4(v, cs, sn, row, fq); st4(KC + (size_t)row * 1024 + (pn - 4) * 256 + c, v); }
                        else if (pn < 12) { st4(VC + (size_t)row * 1024 + (pn - 8) * 256 + c, v); }
                        else if (pn < 14) { if (n == 0 && ropew) v = rope4(v, cs, sn, row, fq); st4(QI + (size_t)row * 512 + (pn - 12) * 256 + c, v); }
                        else { if (c < 64) *(f32x4*)(KIRAW + (size_t)row * 64 + c) = v;
                               else if (c < 72) *(f32x4*)(WI + (size_t)row * 8 + (c - 64)) = v * 0.04419417382415922f; } }
                EPI_FENCE(); } }
    }
};
}

__device__ __forceinline__ float wave_sum(float v) {
#pragma unroll
    for (int o = 1; o < 64; o <<= 1) v += __shfl_xor(v, o);
    return v;
}
template <int MODE>
__device__ __forceinline__ void xpose_item(const float* __restrict__ W, int K, int N, const float* __restrict__ g, bf16* __restrict__ WT, int off, LAS float* scr, int item, int lane) {
    const int nblk = (N + 31) / 32, kb = item / nblk, nb = item % nblk, k0 = 64 * kb, n0 = 32 * nb;
    const int nn = n0 + (lane & 31); const bool ok = nn < N;
#pragma unroll 8
    for (int i = 0; i < 32; ++i) { const int kk = 2 * i + (lane >> 5); float v = ok ? W[(size_t)(k0 + kk) * N + nn] : 0.f; if (g) v *= g[k0 + kk]; scr[kk * 33 + (lane & 31)] = v; }
    LDS_WAIT(); asm volatile("" ::: "memory");
    const int c = lane & 7;
#pragma unroll
    for (int j = 0; j < 4; ++j) { const int n = (lane >> 3) + 8 * j; const LAS float* s = scr + (8 * c) * 33 + n;
        v4u o; o.x = pk2(s[0 * 33], s[1 * 33]); o.y = pk2(s[2 * 33], s[3 * 33]); o.z = pk2(s[4 * 33], s[5 * 33]); o.w = pk2(s[6 * 33], s[7 * 33]);
        const int ng = n0 + n;
        if (ng < N) { const int dr = (MODE == 0) ? (ng + off) : ((ng >> 7) * 256 + (ng & 127) + off); *(v4u*)(WT + (size_t)dr * K + k0 + 8 * c) = o; } }
    LDS_WAIT(); asm volatile("" ::: "memory");
}
__device__ __forceinline__ float bf2f(bf16 b) { return __uint_as_float(((unsigned)b) << 16); }

__device__ __forceinline__ void p0_prologue(KArgs ap, unsigned char* ws, LAS unsigned char* lds, int vcu, int G, int wave, int lane, int tid) {
    LAS float* scr = (LAS float*)(lds + wave * 16384);
    const int gw = vcu * NWAVES + wave, NGW = G * NWAVES, gt = vcu * (NWAVES * 64) + tid, NGT = G * NWAVES * 64;
    const float *g_mix = ap->in[3], *w_in_even = ap->in[4], *w_out_even = ap->in[9], *w_in_odd = ap->in[10], *w_out_odd = ap->in[13], *g_ffn = ap->in[14], *w_gate = ap->in[15], *w_up = ap->in[16],
                *w_down = ap->in[17], *g_ple = ap->in[18], *w_pproj = ap->in[19], *w_pgate = ap->in[20];
    constexpr int I_IN0 = 16 * 80, I_SQ = 16 * 32, I_GU = 16 * 88, I_DN = 44 * 32, I_PP = 4 * 32, I_IN1 = 16 * 115;
    constexpr int NITEMS = I_IN0 + I_SQ + 2 * I_GU + I_DN + I_SQ + I_PP + I_IN1 + I_SQ + 2 * I_GU + I_DN + I_SQ + I_PP;
#define XP(MODE, Wp, K_, N_, gp, OFFB, off_, NI) { if (r < (NI)) { xpose_item<MODE>((Wp), (K_), (N_), (gp), (bf16*)(ws + (OFFB)), (off_), scr, r, lane); continue; } r -= (NI); }
    for (int it = gw; it < NITEMS; it += NGW) {
        int r = it;
        XP(0, w_in_even, 1024, 2560, g_mix, WS_W_IN0, 0, I_IN0)
        XP(0, w_out_even, 1024, 1024, (const float*)nullptr, WS_W_OUT0, 0, I_SQ)
        XP(1, w_gate, 1024, DFF, g_ffn, WS_W_GU0, 0, I_GU)
        XP(1, w_up, 1024, DFF, g_ffn, WS_W_GU0, 128, I_GU)
        XP(0, w_down, DFF, 1024, (const float*)nullptr, WS_W_DN0, 0, I_DN)
        XP(0, w_pgate, 1024, 1024, g_ple, WS_W_PG0, 0, I_SQ)
        XP(0, w_pproj, 256, 1024, (const float*)nullptr, WS_W_PP0, 0, I_PP)
        XP(0, w_in_odd, 1024, 3656, g_mix + 1024, WS_W_IN1, 0, I_IN1)
        XP(0, w_out_odd, 1024, 1024, (const float*)nullptr, WS_W_OUT1, 0, I_SQ)
        XP(1, w_gate + (size_t)1024 * DFF, 1024, DFF, g_ffn + 1024, WS_W_GU1, 0, I_GU)
        XP(1, w_up + (size_t)1024 * DFF, 1024, DFF, g_ffn + 1024, WS_W_GU1, 128, I_GU)
        XP(0, w_down + (size_t)DFF * 1024, DFF, 1024, (const float*)nullptr, WS_W_DN1, 0, I_DN)
        XP(0, w_pgate + (size_t)1024 * 1024, 1024, 1024, g_ple + 1024, WS_W_PG1, 0, I_SQ)
        XP(0, w_pproj + (size_t)256 * 1024, 256, 1024, (const float*)nullptr, WS_W_PP1, 0, I_PP)
    }
#undef XP
    { v4u* z = (v4u*)(ws + WS_W_IN1 + (size_t)3656 * 1024 * 2); const int nz = (3840 - 3656) * 1024 * 2 / 16;
      for (int i = gt; i < nz; i += NGT) z[i] = (v4u){0u, 0u, 0u, 0u}; }
    { const float* x = ap->in[0]; bf16* hb = (bf16*)(ws + WS_HB); float* rowss = (float*)(ws + WS_ROWSS);
      for (int row = gw; row < MROWS; row += NGW) {
          const f32x4* xr = (const f32x4*)(x + (size_t)row * 1024) + lane; unsigned long long* o8 = (unsigned long long*)(hb + (size_t)row * 1024) + lane; float ss = 0.f;
#pragma unroll
          for (int j = 0; j < 4; ++j) { const f32x4 v = xr[64 * j]; ss += (v[0] * v[0] + v[1] * v[1]) + (v[2] * v[2] + v[3] * v[3]);
              o8[64 * j] = (unsigned long long)pk2(v[0], v[1]) | ((unsigned long long)pk2(v[2], v[3]) << 32); }
          ss = wave_sum(ss);
          if (lane < 16) rowss[(size_t)row * 16 + lane] = (lane == 0) ? ss : 0.f; } }
    { const f32x4* p4 = (const f32x4*)ap->in[1]; unsigned long long* o8 = (unsigned long long*)(ws + WS_PB); const int n4 = 2 * MROWS * 256 / 4;
      for (int i = gt; i < n4; i += NGT) { const f32x4 v = p4[i]; o8[i] = (unsigned long long)pk2(v[0], v[1]) | ((unsigned long long)pk2(v[2], v[3]) << 32); } }
    { const int* pos = (const int*)ap->in[2]; float* cs = (float*)(ws + WS_ROPE); float* sn = cs + MROWS * 8;
      for (int e = gt; e < MROWS * 8; e += NGT) { const int row = e >> 3, i = e & 7;
          const float f = (i == 0) ? ap->f0 : (i == 1) ? ap->f1 : (i == 2) ? ap->f2 : (i == 3) ? ap->f3 : (i == 4) ? ap->f4 : (i == 5) ? ap->f5 : (i == 6) ? ap->f6 : ap->f7;
          const float ang = (float)pos[row] * f; const double rev = (double)ang * 0.15915494309189533577; const float fr = (float)(rev - floor(rev));
          cs[e] = __builtin_amdgcn_cosf(fr); sn[e] = __builtin_amdgcn_sinf(fr); } }
}

__device__ __forceinline__ void kmean_unit(unsigned char* ws, int u, int lane) {
    const int bh = u >> 5, blk = u & 31; const bf16* kb = (const bf16*)(ws + WS_KB0) + ((size_t)(bh >> 3) * SEQ + blk * 256) * 512 + (bh & 7) * 64 + lane;
    float s0 = 0.f, s1 = 0.f, s2 = 0.f, s3 = 0.f;
#pragma unroll 4
    for (int r = 0; r < 256; r += 4) { s0 += bf2f(kb[(size_t)(r + 0) * 512]); s1 += bf2f(kb[(size_t)(r + 1) * 512]); s2 += bf2f(kb[(size_t)(r + 2) * 512]); s3 += bf2f(kb[(size_t)(r + 3) * 512]); }
    const float mean = ((s0 + s1) + (s2 + s3)) * (1.f / 256.f); const unsigned h = f2bf(mean); const float res = mean - __uint_as_float(h << 16);
    ((bf16*)(ws + WS_KMH))[u * 64 + lane] = (bf16)h; ((bf16*)(ws + WS_KML))[u * 64 + lane] = (bf16)f2bf(res);
}
__device__ __forceinline__ void sgu_unit(KArgs ap, unsigned char* ws, LAS unsigned char* lds, int cu, int g, int wave, int lane, int tid) {
    constexpr int LTS = 136;
    LAS bf16* LT = (LAS bf16*)lds;
    const float *ln_g = ap->in[5], *ln_b = ap->in[6], *w_s = ap->in[7], *b_s = ap->in[8];
    bf16* UQ = (bf16*)(ws + WS_QO); const bf16* VA = (const bf16*)(ws + WS_VA);
    const int row0 = cu * 128;
    { const int s = tid >> 2, qd = tid & 3; const bf16* vp = VA + (size_t)(row0 + s) * 512 + g * 64 + qd * 16;
      const v4u w0 = *(const v4u*)vp, w1 = *(const v4u*)(vp + 8); float xv[16];
      xv[0] = __uint_as_float(w0.x << 16); xv[1] = __uint_as_float(w0.x & 0xffff0000u); xv[2] = __uint_as_float(w0.y << 16); xv[3] = __uint_as_float(w0.y & 0xffff0000u);
      xv[4] = __uint_as_float(w0.z << 16); xv[5] = __uint_as_float(w0.z & 0xffff0000u); xv[6] = __uint_as_float(w0.w << 16); xv[7] = __uint_as_float(w0.w & 0xffff0000u);
      xv[8] = __uint_as_float(w1.x << 16); xv[9] = __uint_as_float(w1.x & 0xffff0000u); xv[10] = __uint_as_float(w1.y << 16); xv[11] = __uint_as_float(w1.y & 0xffff0000u);
      xv[12] = __uint_as_float(w1.z << 16); xv[13] = __uint_as_float(w1.z & 0xffff0000u); xv[14] = __uint_as_float(w1.w << 16); xv[15] = __uint_as_float(w1.w & 0xffff0000u);
      float sm = 0.f;
#pragma unroll
      for (int e = 0; e < 16; ++e) sm += xv[e];
      sm += __shfl_xor(sm, 1); sm += __shfl_xor(sm, 2); const float mean = sm * (1.f / 64.f); float sq = 0.f;
#pragma unroll
      for (int e = 0; e < 16; ++e) { xv[e] -= mean; sq += xv[e] * xv[e]; }
      sq += __shfl_xor(sq, 1); sq += __shfl_xor(sq, 2); const float rstd = 1.0f / sqrtf(sq * (1.f / 64.f) + RMS_EPS);
#pragma unroll
      for (int e = 0; e < 16; ++e) { const int d = qd * 16 + e; const float y = xv[e] * rstd * ln_g[g * 64 + d] + ln_b[g * 64 + d]; LT[d * LTS + s] = (bf16)f2bf(y); } }
    __syncthreads();
    { const int r = lane & 15, kq = lane >> 4, t = 16 * wave + r; const int nks = (16 * wave + 16 + 31) >> 5;
      f32x4 acc[4];
#pragma unroll
      for (int ct = 0; ct < 4; ++ct) acc[ct] = (f32x4){0.f, 0.f, 0.f, 0.f};
      const float* wrow = w_s + ((size_t)g * 128 + t) * 128;
      for (int ks = 0; ks < nks; ++ks) { const int s0 = 32 * ks + 8 * kq; const f32x4 wa = *(const f32x4*)(wrow + s0), wb = *(const f32x4*)(wrow + s0 + 4);
          v4u af; af.x = pk2(s0 + 0 <= t ? wa[0] : 0.f, s0 + 1 <= t ? wa[1] : 0.f); af.y = pk2(s0 + 2 <= t ? wa[2] : 0.f, s0 + 3 <= t ? wa[3] : 0.f);
          af.z = pk2(s0 + 4 <= t ? wb[0] : 0.f, s0 + 5 <= t ? wb[1] : 0.f); af.w = pk2(s0 + 6 <= t ? wb[2] : 0.f, s0 + 7 <= t ? wb[3] : 0.f);
          const bf16x8 afr = __builtin_bit_cast(bf16x8, af);
#pragma unroll
          for (int ct = 0; ct < 4; ++ct) { const bf16x8 bfr = *(const LAS bf16x8*)(LT + (16 * ct + r) * LTS + s0); acc[ct] = __builtin_amdgcn_mfma_f32_16x16x32_bf16(afr, bfr, acc[ct], 0, 0, 0); } }
#pragma unroll
      for (int ct = 0; ct < 4; ++ct)
#pragma unroll
          for (int rg = 0; rg < 4; ++rg) { const int tt = 16 * wave + 4 * kq + rg, d = 16 * ct + r; const float mixed = acc[ct][rg] + b_s[g * 128 + tt];
              bf16* up = UQ + (size_t)(row0 + tt) * 1024 + g * 64 + d; *up = (bf16)f2bf(bf2f(*up) * mixed); } }
    __syncthreads();
}

__device__ __forceinline__ void kidx_rows(KArgs ap, unsigned char* ws, int gw, int NGW, int lane) {
    const float* kr = (const float*)(ws + WS_KIRAW); bf16* ki = (bf16*)(ws + WS_KI); const float* cs = (const float*)(ws + WS_ROPE); const float* sn = cs + MROWS * 8;
    const float gg = ap->in[11][lane], bb = ap->in[12][lane];
    for (int row = gw; row < MROWS; row += NGW) {
        const float x = kr[(size_t)row * 64 + lane]; const float mean = wave_sum(x) * (1.f / 64.f); const float xc = x - mean; const float var = wave_sum(xc * xc) * (1.f / 64.f);
        float y = xc * (1.0f / sqrtf(var + RMS_EPS)) * gg + bb; const float pr = __shfl_xor(y, 8);
        if (lane < 16) { const float c = cs[(size_t)row * 8 + (lane & 7)], s = sn[(size_t)row * 8 + (lane & 7)]; y = (lane < 8) ? (y * c - pr * s) : (y * c + pr * s); }
        ki[(size_t)row * 64 + lane] = (bf16)f2bf(y); }
}

typedef float f32x16 __attribute__((ext_vector_type(16)));
__device__ __forceinline__ unsigned f2key16(float s) {
    const _Float16 h = (_Float16)(s + 0.0f); const unsigned b = (unsigned)__builtin_bit_cast(unsigned short, h);
    return (b & 0x8000u) ? ((~b) & 0xffffu) : (b | 0x8000u);
}
__device__ __forceinline__ void hist_find(const LAS unsigned* hrow, int lane, unsigned need, unsigned& bin, unsigned& above) {
    const v4u h = *(const LAS v4u*)(hrow + 4 * lane); const unsigned c = h.x + h.y + h.z + h.w; unsigned suf = c;
#pragma unroll
    for (int o = 1; o < 64; o <<= 1) { const unsigned t = __shfl_down(suf, o); suf += (lane + o < 64) ? t : 0u; }
    const unsigned ab = suf - c; const bool here = (ab < need) && (suf >= need);
    unsigned b_ = 0, a_ = 0;
    { unsigned x = ab; if (x + h.w >= need) { b_ = 4 * lane + 3; a_ = x; } else { x += h.w; if (x + h.z >= need) { b_ = 4 * lane + 2; a_ = x; } else { x += h.z; if (x + h.y >= need) { b_ = 4 * lane + 1; a_ = x; } else { x += h.y; b_ = 4 * lane; a_ = x; } } } }
    const unsigned long long bm = __ballot(here); const int src = bm ? (int)__builtin_ctzll(bm) : 0;
    bin = (unsigned)__shfl((int)b_, src); above = (unsigned)__shfl((int)a_, src);
}
__device__ __forceinline__ void dsa_index_unit(unsigned char* ws, LAS unsigned char* lds, int b, int q0, int wave, int lane, int tid) {
    LAS unsigned short* SC = (LAS unsigned short*)lds; LAS unsigned* HIST = (LAS unsigned*)(lds + 131072);
    const bf16* QI = (const bf16*)(ws + WS_QI); const bf16* KI = (const bf16*)(ws + WS_KI); const float* WI = (const float*)(ws + WS_WI);
    unsigned long long* MASK = (unsigned long long*)(ws + WS_MASK);
    const int r32 = lane & 31, hi = lane >> 5; const size_t rowb = (size_t)b * SEQ;
    for (int i = tid; i < 2048; i += NWAVES * 64) HIST[i] = 0u;
    bf16x8 af[2][4]; float sg[2][16];
#pragma unroll
    for (int rt = 0; rt < 2; ++rt) { const size_t qrow = rowb + q0 + 4 * rt + (r32 >> 3); const int ih = r32 & 7; const float w = WI[qrow * 8 + ih];
#pragma unroll
        for (int ks = 0; ks < 4; ++ks) { const v4u q4 = *(const v4u*)(QI + qrow * 512 + ih * 64 + 16 * ks + 8 * hi); v4u o;
            o.x = pk2(__uint_as_float(q4.x << 16) * w, __uint_as_float(q4.x & 0xffff0000u) * w); o.y = pk2(__uint_as_float(q4.y << 16) * w, __uint_as_float(q4.y & 0xffff0000u) * w);
            o.z = pk2(__uint_as_float(q4.z << 16) * w, __uint_as_float(q4.z & 0xffff0000u) * w); o.w = pk2(__uint_as_float(q4.w << 16) * w, __uint_as_float(q4.w & 0xffff0000u) * w);
            af[rt][ks] = __builtin_bit_cast(bf16x8, o); }
#pragma unroll
        for (int r = 0; r < 16; ++r) { const float w2 = WI[(rowb + q0 + 4 * rt + (r >> 2)) * 8 + (r & 3) + 4 * hi]; sg[rt][r] = (w2 >= 0.f) ? INFINITY : -INFINITY; } }
    __syncthreads();
    const int nkt = (q0 + 8 + 31) >> 5;
    for (int kt = wave; kt < nkt; kt += NWAVES) {
        const int key = kt * 32 + r32; const bf16* kp = KI + (rowb + key) * 64 + 8 * hi;
        bf16x8 bfr[4];
#pragma unroll
        for (int ks = 0; ks < 4; ++ks) bfr[ks] = *(const bf16x8*)(kp + 16 * ks);
        f32x16 d0 = f32x16{}, d1 = f32x16{};
#pragma unroll
        for (int ks = 0; ks < 4; ++ks) { d0 = __builtin_amdgcn_mfma_f32_32x32x16_bf16(af[0][ks], bfr[ks], d0, 0, 0, 0); d1 = __builtin_amdgcn_mfma_f32_32x32x16_bf16(af[1][ks], bfr[ks], d1, 0, 0, 0); }
#pragma unroll
        for (int qi = 0; qi < 8; ++qi) { const int rt = qi >> 2, ql = qi & 3; float s = 0.f;
#pragma unroll
            for (int e = 0; e < 4; ++e) { const float l = rt ? d1[4 * ql + e] : d0[4 * ql + e]; s += __builtin_amdgcn_fmed3f(l, 0.f, sg[rt][4 * ql + e]); }
            s += __shfl_xor(s, 32);
            const unsigned k16 = (key <= q0 + qi) ? f2key16(s) : 0u;
            if ((qi & 1) == hi) { SC[qi * 8192 + key] = (unsigned short)k16; __hip_atomic_fetch_add(HIST + qi * 256 + (k16 >> 8), 1u, __ATOMIC_RELAXED, __HIP_MEMORY_SCOPE_WORKGROUP); } }
    }
    __syncthreads();
    { const int qi = wave, qpos = q0 + qi, nk = nkt * 32; const LAS unsigned short* row = SC + qi * 8192; LAS unsigned* hrow = HIST + qi * 256;
      unsigned thr = 0u, ties = 0u;
      if (qpos + 1 > 256) {
          unsigned b1, ab1; hist_find(hrow, lane, 256u, b1, ab1); const unsigned need2 = 256u - ab1;
          LDS_WAIT();
          *(LAS v4u*)(hrow + 4 * lane) = (v4u){0u, 0u, 0u, 0u};
          LDS_WAIT();
          for (int k = 8 * lane; k < nk; k += 512) { const v4u v = *(const LAS v4u*)(row + k);
#pragma unroll
              for (int e = 0; e < 4; ++e) { const unsigned w = (e == 0) ? v.x : (e == 1) ? v.y : (e == 2) ? v.z : v.w; const unsigned k0 = w & 0xffffu, k1 = w >> 16;
                  if ((k0 >> 8) == b1) __hip_atomic_fetch_add(hrow + (k0 & 255u), 1u, __ATOMIC_RELAXED, __HIP_MEMORY_SCOPE_WORKGROUP);
                  if ((k1 >> 8) == b1) __hip_atomic_fetch_add(hrow + (k1 & 255u), 1u, __ATOMIC_RELAXED, __HIP_MEMORY_SCOPE_WORKGROUP); } }
          LDS_WAIT();
          unsigned b2, ab2; hist_find(hrow, lane, need2, b2, ab2);
          thr = (b1 << 8) | b2; ties = need2 - ab2;
      }
      const int nwords = 4 * ((qpos >> 8) + 1); unsigned tiecnt = 0u; unsigned long long my0 = 0ull, my1 = 0ull;
      for (int c = 0; c < nwords; ++c) { const int k = 64 * c + lane; const unsigned key = (k < nk) ? (unsigned)row[k] : 0u;
          const bool gt_ = key > thr, eq = (key == thr) && (thr != 0u); const unsigned long long eqm = __ballot(eq);
          const unsigned before = (unsigned)__builtin_popcountll(eqm & ((1ull << lane) - 1ull));
          const bool take = gt_ || (eq && (tiecnt + before < ties)); tiecnt += (unsigned)__builtin_popcountll(eqm);
          const unsigned long long wv = __ballot(take);
          if (lane == (c & 63)) { if (c < 64) my0 = wv; else my1 = wv; } }
      unsigned long long* mrow = MASK + (rowb + qpos) * 128;
      if (lane < nwords) mrow[lane] = my0;
      if (64 + lane < nwords) mrow[64 + lane] = my1; }
    __syncthreads();
}

__device__ __forceinline__ void final_norm(KArgs ap, unsigned char* ws, int gw, int NGW, int lane) {
    const float* rowss = (const float*)(ws + WS_ROWSS); const f32x4* gf = (const f32x4*)ap->in[21] + lane; float* out = ap->out;
    f32x4 g4[4];
#pragma unroll
    for (int j = 0; j < 4; ++j) g4[j] = gf[64 * j];
    for (int row = gw; row < MROWS; row += NGW) {
        const float ss = wave_sum(lane < 16 ? rowss[(size_t)row * 16 + lane] : 0.f); const float rstd = 1.0f / sqrtf(ss * (1.f / 1024.f) + RMS_EPS);
        f32x4* o = (f32x4*)(out + (size_t)row * 1024) + lane;
#pragma unroll
        for (int j = 0; j < 4; ++j) o[64 * j] = o[64 * j] * rstd * g4[j]; }
}


#ifdef PROBE_STOP
#ifndef PROBE_OFF
#define PROBE_OFF WS_R
#endif
#ifndef PROBE_CHUNKS
#define PROBE_CHUNKS 0
#endif
#ifndef PROBE_LEN
#define PROBE_LEN (1ull << 40)
#endif
#ifdef PROBE_OWN_TILE
#define PROBE_AT(k) if ((k) == PROBE_STOP) { PHASE_ENV(); pg8::StaticOrder S_; S_.init(MROWS, 1024, G, bx); pg8::Unit u_; if (S_.next(0, u_)) { const bf16* src = (const bf16*)(ws + PROBE_OFF); \
      for (int e = tid; e < 256 * 256; e += 512) { const size_t i = (size_t)(u_.pm * 256 + (e >> 8)) * 1024 + u_.pn * 256 + (e & 255); float v_ = bf2f(src[i]); if (!(fabsf(v_) < 1e30f)) v_ = 12345.f; OUT[i] = v_; } } return; }
#else
#define PROBE_AT(k) if ((k) == PROBE_STOP) { PHASE_ENV(); if (PROBE_CHUNKS > 0) { const bf16* src = (const bf16*)(ws + PROBE_OFF); \
      for (size_t i = (size_t)bx * 512 + tid; i < (size_t)MROWS * 1024; i += (size_t)G * 512) { float acc_ = 0.f; \
          for (int j = 0; j < PROBE_CHUNKS; ++j) { float v_ = bf2f(src[(i + (size_t)j * MROWS * 1024) % (size_t)(PROBE_LEN)]); if (!(fabsf(v_) < 1e30f)) v_ = 12345.f; acc_ += v_; } OUT[i] = acc_; } } return; }
#endif
#else
#define PROBE_AT(k)
#endif
__global__ void __launch_bounds__(NWAVES * 64, 2) trunk_fwd(Args args) {
    extern __shared__ __attribute__((aligned(16))) unsigned char lds_raw[];
    LAS unsigned char* lds = (LAS unsigned char*)lds_raw;
    volatile LAS unsigned* MISC = (volatile LAS unsigned*)(lds + LDSCTL_OFF);
    const int tid0 = threadIdx.x;
    const int G = gridDim.x; const int bx = blockIdx.x; const int vcu = (G % 8 == 0) ? (bx % 8) * (G / 8) + bx / 8 : bx;
    KArgs ap0 = (KArgs)__builtin_amdgcn_kernarg_segment_ptr();
    gu32* ctl = (gu32*)(ap0->ws + WS_CTL);
    for (int u = tid0; u < (LDS_BYTES - LDSCTL_OFF) / 4; u += NWAVES * 64) ((LAS unsigned*)(lds + LDSCTL_OFF))[u] = 0u;
    __syncthreads();
    XcdBarrier bar = xcd_barrier_post((unsigned*)(ctl + CW_BAR), MISC + 8);
#ifdef PROBE_TIME
    if (bx == 0 && tid0 == 0) *(unsigned long long*)(ap0->ws + 512 * 1024) = __builtin_amdgcn_s_memrealtime();
#endif
#define GRID_BAR() xcd_barrier(bar)
    const int NGW = G * NWAVES;
#define PHASE_ENV() KArgs ap = (KArgs)__builtin_amdgcn_kernarg_segment_ptr(); asm volatile("" : "+s"(ap)); unsigned char* ws = ap->ws; \
    int tid_p = threadIdx.x; asm volatile("" : "+v"(tid_p)); const int tid = tid_p, lane = tid & 63, wave = __builtin_amdgcn_readfirstlane(tid >> 6); const int gw = vcu * NWAVES + wave; (void)lane; (void)gw; \
    pg8::bf16_t* HB = (pg8::bf16_t*)(ws + WS_HB); float* ROWSS = (float*)(ws + WS_ROWSS); const float* CS = (const float*)(ws + WS_ROPE); const float* SN = CS + MROWS * 8; float* OUT = ap->out; \
    (void)HB; (void)ROWSS; (void)CS; (void)SN; (void)OUT;

    enum { PROBE_C0 = __COUNTER__ + 1 };
    if (RUNPH(0)) { PHASE_ENV(); p0_prologue(ap, ws, lds, vcu, G, wave, lane, tid); }
    GRID_BAR(); PROBE_AT(__COUNTER__ - PROBE_C0);


#ifdef PROBE_GEMM2X
#ifndef PROBE_ALIGN
#define PROBE_ALIGN PG8_ALIGN
#endif
#ifndef PROBE_SP2
#define PROBE_SP2 PG8_SP2
#endif
    {
        for (int rep = 0; rep < 2; ++rep) {
            { PHASE_ENV(); pg8::Gemm g{HB, (const pg8::bf16_t*)(ws + WS_W_PG0), MROWS, 1024, 1024}; pg8::StaticOrder S; S.init(MROWS, 1024, G, bx);
              epi::EpiPleGate E{ROWSS, (pg8::bf16_t*)(ws + WS_R + (size_t)rep * 32 * MiB)};
              pg8::gemm_phase<epi::EpiPleGate, pg8::StaticOrder, PROBE_ALIGN, PROBE_SP2>(lds, g, S, E); }
            GRID_BAR();
        }
        { PHASE_ENV(); const bf16* g1 = (const bf16*)(ws + WS_R); const bf16* g2 = g1 + (size_t)MROWS * 1024; unsigned e = 0;
          for (size_t i = (size_t)bx * 512 + tid; i < (size_t)MROWS * 1024; i += (size_t)G * 512) e += (g1[i] != g2[i]);
          if (e) atomicAdd((unsigned*)(ws + 512 * 1024 + 128), e); }
        GRID_BAR();
        { PHASE_ENV(); const unsigned e = __hip_atomic_load((unsigned*)(ws + 512 * 1024 + 128), __ATOMIC_RELAXED, __HIP_MEMORY_SCOPE_AGENT);
          float c = e ? 3.f : 1.f;
          for (size_t i = (size_t)bx * 512 + tid; i < (size_t)MROWS * 1024 / 4; i += (size_t)G * 512) ((f32x4*)OUT)[i] = (f32x4){c, c, c, c}; }
        return;
    }
#endif
    if (RUNPH(1)) {   PHASE_ENV();
        pg8::Gemm g{HB, (const pg8::bf16_t*)(ws + WS_W_IN0), MROWS, 2560, 1024}; pg8::StaticOrder S; S.init(MROWS, 2560, G, bx);
        epi::EpiInEven E{ROWSS, CS, SN, (pg8::bf16_t*)(ws + WS_QO), (pg8::bf16_t*)(ws + WS_VA), (pg8::bf16_t*)(ws + WS_KB0), (pg8::bf16_t*)(ws + WS_VB0)};
        pg8::gemm_phase<epi::EpiInEven, pg8::StaticOrder, PG8_ALIGN, PG8_SP2>(lds, g, S, E);
    }
    GRID_BAR(); PROBE_AT(__COUNTER__ - PROBE_C0);
    if (RUNPH(2)) {   PHASE_ENV();
        for (int u = gw; u < 512; u += NGW) kmean_unit(ws, u, lane);
        for (int u = vcu; u < 1024; u += G) sgu_unit(ap, ws, lds, u >> 3, u & 7, wave, lane, tid);
    }
    GRID_BAR(); PROBE_AT(__COUNTER__ - PROBE_C0);
    if (RUNPH(3)) {   PHASE_ENV();
        using attn_body::bf16;
        for (int p = vcu; p < 256; p += G) { const int bh = p >> 4, s = p & 15, b = bh >> 3, h = bh & 7;
            bf16* Qh = (bf16*)(ws + WS_QO) + (size_t)b * SEQ * 1024 + 512 + h * 64; const bf16* Kh = (const bf16*)(ws + WS_KB0) + (size_t)b * SEQ * 512 + h * 64;
            const bf16* Vh = (const bf16*)(ws + WS_VB0) + (size_t)b * SEQ * 512 + h * 64; const bf16* kmh = (const bf16*)(ws + WS_KMH) + bh * 32 * 64; const bf16* kml = (const bf16*)(ws + WS_KML) + bh * 32 * 64;
#ifndef SKIP_MOBA
            for (int i = 0; i < 2; ++i) { const int qb = i ? 31 - s : s; attn_body::moba_gates<1024>(qb, Qh, kmh, kml, (char*)lds_raw); attn_body::attn_unit<0, 8, 1024, 512>(qb, Qh, Kh, Vh, Qh, kmh, kml, nullptr, (char*)lds_raw); }
#endif
        }
    }
    GRID_BAR(); PROBE_AT(__COUNTER__ - PROBE_C0);
    if (RUNPH(4)) {   PHASE_ENV();
        pg8::Gemm g{(const pg8::bf16_t*)(ws + WS_QO), (const pg8::bf16_t*)(ws + WS_W_OUT0), MROWS, 1024, 1024}; pg8::StaticOrder S; S.init(MROWS, 1024, G, bx);
        epi::EpiResid E{ap->in[0], OUT, HB, ROWSS};
        pg8::gemm_phase<epi::EpiResid, pg8::StaticOrder, false, PG8_SP2>(lds, g, S, E);
    }
    GRID_BAR(); PROBE_AT(__COUNTER__ - PROBE_C0);
#ifdef PROBE_SWAPA
#define PROBE_A7 ((const pg8::bf16_t*)(ws + WS_HID))
#else
#define PROBE_A7 HB
#endif
#ifdef PROBE_SWAPW
#define PROBE_WPG(x) WS_W_OUT0
#else
#define PROBE_WPG(x) (x)
#endif
#define FFN_PLE(WGU, WDN, WPG, WPP, PBOFF) \
    if (RUNPH(5)) {   PHASE_ENV(); pg8::Gemm g{HB, (const pg8::bf16_t*)(ws + (WGU)), MROWS, 2 * DFF, 1024}; pg8::StaticOrder S; S.init(MROWS, 2 * DFF, G, bx); \
        epi::EpiSwiglu E{ROWSS, (pg8::bf16_t*)(ws + WS_HID)}; \
        pg8::gemm_phase<epi::EpiSwiglu, pg8::StaticOrder, PG8_ALIGN, PG8_SP2>(lds, g, S, E); } \
    GRID_BAR(); PROBE_AT(__COUNTER__ - PROBE_C0); \
    if (RUNPH(6)) {   PHASE_ENV(); pg8::Gemm g{(const pg8::bf16_t*)(ws + WS_HID), (const pg8::bf16_t*)(ws + (WDN)), MROWS, 1024, DFF}; pg8::StaticOrder S; S.init(MROWS, 1024, G, bx); \
        epi::EpiResid E{OUT, OUT, HB, ROWSS}; \
        pg8::gemm_phase<epi::EpiResid, pg8::StaticOrder, false, PG8_SP2>(lds, g, S, E); } \
    GRID_BAR(); PROBE_AT(__COUNTER__ - PROBE_C0); \
    if (RUNPH(7)) {   PHASE_ENV(); pg8::Gemm g{PROBE_A7, (const pg8::bf16_t*)(ws + PROBE_WPG(WPG)), MROWS, 1024, 1024}; pg8::StaticOrder S; S.init(MROWS, 1024, G, bx); \
        epi::EpiPleGate E{ROWSS, (pg8::bf16_t*)(ws + WS_G)}; \
        pg8::gemm_phase<epi::EpiPleGate, pg8::StaticOrder, false, PG8_SP2>(lds, g, S, E); } \
    GRID_BAR(); PROBE_AT(__COUNTER__ - PROBE_C0); \
    if (RUNPH(8)) {   PHASE_ENV(); int kpp = 256; asm volatile("" : "+s"(kpp)); pg8::Gemm g{(const pg8::bf16_t*)(ws + WS_PB) + (PBOFF), (const pg8::bf16_t*)(ws + (WPP)), MROWS, 1024, kpp}; pg8::StaticOrder S; S.init(MROWS, 1024, G, bx); \
        epi::EpiPleProj E{OUT, OUT, HB, ROWSS, (const pg8::bf16_t*)(ws + WS_G)}; \
        pg8::gemm_phase<epi::EpiPleProj, pg8::StaticOrder, false, PG8_SP2>(lds, g, S, E); } \
    GRID_BAR(); PROBE_AT(__COUNTER__ - PROBE_C0);
    FFN_PLE(WS_W_GU0, WS_W_DN0, WS_W_PG0, WS_W_PP0, (size_t)0)

    if (RUNPH(9)) {   PHASE_ENV();
        pg8::Gemm g{HB, (const pg8::bf16_t*)(ws + WS_W_IN1), MROWS, 3840, 1024}; pg8::StaticOrder S; S.init(MROWS, 3840, G, bx);
        epi::EpiInOdd E{ROWSS, CS, SN, (pg8::bf16_t*)(ws + WS_QO), (pg8::bf16_t*)(ws + WS_KC), (pg8::bf16_t*)(ws + WS_VC), (pg8::bf16_t*)(ws + WS_QI), (float*)(ws + WS_KIRAW), (float*)(ws + WS_WI)};
        pg8::gemm_phase<epi::EpiInOdd, pg8::StaticOrder, PG8_ALIGN, PG8_SP2>(lds, g, S, E);
    }
    GRID_BAR(); PROBE_AT(__COUNTER__ - PROBE_C0);
    if (RUNPH(10)) { PHASE_ENV(); kidx_rows(ap, ws, gw, NGW, lane); }
    GRID_BAR(); PROBE_AT(__COUNTER__ - PROBE_C0);
    if (RUNPH(11)) {   PHASE_ENV();
        for (int v = vcu; v < 256; v += G)
#ifndef SKIP_IDX
            for (int j = 0; j < 8; ++j) { const int R = (j >> 1) * 512 + ((j & 1) ? 511 - v : v); dsa_index_unit(ws, lds, R & 1, (R >> 1) * 8, wave, lane, tid); }
#endif
            ;
    }
    GRID_BAR(); PROBE_AT(__COUNTER__ - PROBE_C0);
    if (RUNPH(12)) {   PHASE_ENV();
        using attn_body::bf16;
        for (int p = vcu; p < 256; p += G) { const int bh = p >> 3, s = p & 7, b = bh >> 4, h = bh & 15;
            bf16* Qh = (bf16*)(ws + WS_QO) + (size_t)b * SEQ * 1024 + h * 64; const bf16* Kh = (const bf16*)(ws + WS_KC) + (size_t)b * SEQ * 1024 + h * 64;
            const bf16* Vh = (const bf16*)(ws + WS_VC) + (size_t)b * SEQ * 1024 + h * 64; const unsigned long long* mk = (const unsigned long long*)(ws + WS_MASK) + (size_t)b * SEQ * 128;
#ifndef SKIP_DSA
            for (int i = 0; i < 4; ++i) { const int qb = (i == 0) ? s : (i == 1) ? 15 - s : (i == 2) ? 16 + s : 31 - s; attn_body::attn_unit<1, 8, 1024, 1024>(qb, Qh, Kh, Vh, Qh, nullptr, nullptr, mk, (char*)lds_raw); }
#endif
        }
    }
    GRID_BAR(); PROBE_AT(__COUNTER__ - PROBE_C0);
    if (RUNPH(13)) {   PHASE_ENV();
        pg8::Gemm g{(const pg8::bf16_t*)(ws + WS_QO), (const pg8::bf16_t*)(ws + WS_W_OUT1), MROWS, 1024, 1024}; pg8::StaticOrder S; S.init(MROWS, 1024, G, bx);
        epi::EpiResid E{OUT, OUT, HB, ROWSS};
        pg8::gemm_phase<epi::EpiResid, pg8::StaticOrder, false, PG8_SP2>(lds, g, S, E);
    }
    GRID_BAR(); PROBE_AT(__COUNTER__ - PROBE_C0);
    FFN_PLE(WS_W_GU1, WS_W_DN1, WS_W_PG1, WS_W_PP1, (size_t)MROWS * 256)
    if (RUNPH(14)) { PHASE_ENV(); final_norm(ap, ws, gw, NGW, lane); }
#ifdef PROBE_TIME
    GRID_BAR();
    { PHASE_ENV();
      if (bx == 0 && tid == 0) { const unsigned long long t0 = *(unsigned long long*)(ws + 512 * 1024); const unsigned long long el = (__builtin_amdgcn_s_memrealtime() - t0) / 100ull;
          unsigned c = 1; unsigned long long e = el >> 7; while (e) { ++c; e >>= 1; }
          const unsigned tmo = __hip_atomic_load((unsigned*)(ctl + CW_BAR) + XB_TMO, __ATOMIC_RELAXED, __HIP_MEMORY_SCOPE_AGENT);
          if (tmo) c += 16;
          __hip_atomic_store((unsigned*)(ws + 512 * 1024 + 64), c, __ATOMIC_RELAXED, __HIP_MEMORY_SCOPE_AGENT); }
    }
    GRID_BAR();
    { PHASE_ENV(); const unsigned c = __hip_atomic_load((unsigned*)(ws + 512 * 1024 + 64), __ATOMIC_RELAXED, __HIP_MEMORY_SCOPE_AGENT); const float cf = (float)c;
      for (size_t i = (size_t)bx * 512 + tid; i < (size_t)MROWS * 1024 / 4; i += (size_t)G * 512) ((f32x4*)OUT)[i] = (f32x4){cf, cf, cf, cf}; }
#endif
#undef FFN_PLE
#undef GRID_BAR
#undef PHASE_ENV
}

extern "C" void kernel_launch(void* const* d_in, const int* in_sizes, int n_in, void* d_out, int out_size, void* d_ws, size_t ws_size, hipStream_t stream) {
    static int grid = 0;
    if (grid == 0) {
        if (n_in != 22 || out_size != MROWS * DMODEL || ws_size < WS_END) { fprintf(stderr, "kernel_launch: unexpected problem (n_in %d, out %d, ws %zu); nothing launched\n", n_in, out_size, ws_size); grid = -1; return; }
        int dev = 0, cus = 0, per_cu = 0;
        if (hipGetDevice(&dev) != hipSuccess || hipDeviceGetAttribute(&cus, hipDeviceAttributeMultiprocessorCount, dev) != hipSuccess) { grid = -1; return; }
        if (hipFuncSetAttribute((const void*)trunk_fwd, hipFuncAttributeMaxDynamicSharedMemorySize, LDS_BYTES) != hipSuccess) { fprintf(stderr, "kernel_launch: hipFuncSetAttribute failed\n"); grid = -1; return; }
        if (hipOccupancyMaxActiveBlocksPerMultiprocessor(&per_cu, (const void*)trunk_fwd, NWAVES * 64, LDS_BYTES) != hipSuccess || per_cu < 1) { fprintf(stderr, "kernel_launch: occupancy query says %d blocks per CU\n", per_cu); per_cu = 1; }
        (void)hipGetLastError();
        grid = cus;
    }
    if (grid < 0) return;
    if (hipMemsetAsync((char*)d_ws + WS_CTL, 0, CTL_ZERO_BYTES, stream) != hipSuccess) { fprintf(stderr, "kernel_launch: memset failed\n"); return; }
    Args a{};
    for (int i = 0; i < 22; ++i) a.in[i] = (const float*)d_in[i];
    a.out = (float*)d_out; a.ws = (unsigned char*)d_ws;
    float f[8]; for (int i = 0; i < 8; ++i) f[i] = powf(500000.0f, -(float)(2 * i) / 16.0f);
    a.f0 = f[0]; a.f1 = f[1]; a.f2 = f[2]; a.f3 = f[3]; a.f4 = f[4]; a.f5 = f[5]; a.f6 = f[6]; a.f7 = f[7];
    hipLaunchKernelGGL(trunk_fwd, dim3(grid), dim3(NWAVES * 64), LDS_BYTES, stream, a);
    const hipError_t le = hipPeekAtLastError();
    if (le != hipSuccess) fprintf(stderr, "kernel_launch: launch failed: %s\n", hipGetErrorName(le));
}
```

```cpp
#include <hip/hip_runtime.h>
#include <cstdio>
#include <cstdint>
namespace pg8 {
#define PG8_LAS __attribute__((address_space(3)))
typedef unsigned short bf16_t;
typedef short bf16x8 __attribute__((ext_vector_type(8)));
typedef float f32x4 __attribute__((ext_vector_type(4)));
typedef unsigned u32x4 __attribute__((ext_vector_type(4)));
constexpr int BM = 256, BK = 64, HALF = 128, HTB = HALF * BK * 2  , STAGE_BYTES = 8 * HTB, NXCD = 8, WGM = 8;

__host__ __device__ __forceinline__ int lds_byte(int r, int c) { const int st = (r >> 4) * 2 + (c >> 5), rr = r & 15, cc = c & 31, ob = rr * 64 + cc * 2; return st * 1024 + (ob ^ (((ob >> 9) & 1) << 5)); }
__host__ __device__ __forceinline__ void stage_rc(int b, int& R, int& C) { const int st = b / 1024, sb = b % 1024, swz = sb ^ (((sb >> 9) & 1) << 5); R = (st >> 1) * 16 + swz / 64; C = (st & 1) * 32 + (swz % 64) / 2; }
__host__ __device__ __forceinline__ int perm32(int rho) { const int n = rho >> 4, i = rho & 15; return 8 * (i >> 2) + 4 * n + (i & 3); }

struct Unit { int pm, pn; };
struct Gemm { const bf16_t* A; const bf16_t* Bt; int M, N, K; };

struct StaticOrder {
    int nM, nN, nwg, G, c;
    __host__ __device__ void init(int M, int N, int G_, int c_) { nM = M / BM; nN = N / BM; nwg = nM * nN; G = G_; c = c_; }
    __host__ __device__ bool next(int i, Unit& u) const {
        const long L = (long)i * G + c; if (L >= nwg) return false;
        int wgid = (int)L; { const int q = nwg / NXCD, r = nwg % NXCD, xcd = wgid % NXCD, off = wgid / NXCD; wgid = (xcd < r ? xcd * (q + 1) : r * (q + 1) + (xcd - r) * q) + off; }
        const int nig = WGM * nN, gid = wgid / nig, fm = gid * WGM, gsz = (nM - fm) < WGM ? (nM - fm) : WGM;
        u.pm = fm + ((wgid % nig) % gsz); u.pn = (wgid % nig) / gsz; return true;
    }
    __device__ __forceinline__ void a_ready(const Unit&) const {}
    __device__ __forceinline__ void done(const Unit&) const {}
};
__device__ __forceinline__ unsigned cvt_pk_bf16(float lo, float hi) { unsigned r; asm volatile("v_cvt_pk_bf16_f32 %0, %1, %2" : "=v"(r) : "v"(lo), "v"(hi)); return r; }
typedef float f32x2 __attribute__((ext_vector_type(2)));
__device__ __forceinline__ f32x2 gelu_pk(f32x2 v) {
    const f32x2 av = __builtin_elementwise_abs(v), d = av * 0.2316418882f + 1.0f;
    f32x2 t; t.x = __builtin_amdgcn_rcpf(d.x); t.y = __builtin_amdgcn_rcpf(d.y);
    f32x2 q = t * 0.5307027145f + (-0.7265760135f); q = q * t + 0.7107068705f; q = q * t + (-0.142248368f); q = q * t + 0.127414796f; q = q * t;
    const f32x2 s = (v * v) * (-0.72134752044f);
    f32x2 e; e.x = __builtin_amdgcn_exp2f(s.x); e.y = __builtin_amdgcn_exp2f(s.y);
    const f32x2 m = v * (q * e), r = v - m;
    f32x2 o; o.x = v.x < 0.f ? m.x : r.x; o.y = v.y < 0.f ? m.y : r.y; return o;
}
template <class Epi, class Sched, bool ALIGN_EPI = false, bool SP2 = false>
__device__ __forceinline__ void gemm_phase(PG8_LAS unsigned char* lds, const Gemm g, const Sched& S, const Epi& E) {
    int tid_l = threadIdx.x; asm volatile("" : "+v"(tid_l)); const int tid = tid_l, wid = __builtin_amdgcn_readfirstlane(tid >> 6), lane = tid & 63, wr = wid >> 2, wc = wid & 3, fr = lane & 15, fq = lane >> 4;
    const int K = g.K, nt = K / BK;
    unsigned voffA[2], voffB[2];
#pragma unroll
    for (int i = 0; i < 2; ++i) { int R, C; stage_rc(tid * 16 + i * 8192, R, C); const int Rb = Epi::PERM ? ((R & ~31) + perm32(R & 31)) : R;
        voffA[i] = (unsigned)(R * K + C) * 2u; voffB[i] = (unsigned)(Rb * K + C) * 2u; }
    const size_t kstep = (size_t)(BK * 2);
    const size_t hstep = (size_t)HALF * K * 2;
    const size_t tstep = 2 * hstep;
    const unsigned ldsw = (unsigned)wid * 1024u;
    const int aoff = lds_byte(wr * 64 + fr, fq * 8), boff = lds_byte(wc * 32 + fr, fq * 8);
#define PG8_SA(b, h) (((b) * 2 + (h)) * HTB)
#define PG8_SB(b, h) ((4 + (b) * 2 + (h)) * HTB)
#define PG8_STAGE(bufoff, gbase, voff) do { _Pragma("unroll") for (int _i = 0; _i < 2; ++_i) \
        __builtin_amdgcn_global_load_lds((const unsigned*)((const char*)(gbase) + (voff)[_i]), (PG8_LAS unsigned*)(lds + (bufoff) + ldsw + _i * 8192), 16, 0, 0); } while (0)
#define PG8_LDA(dst, b, h) do { _Pragma("unroll") for (int m = 0; m < 4; ++m) _Pragma("unroll") for (int k = 0; k < 2; ++k) dst[m][k] = *(const PG8_LAS bf16x8*)(lds + PG8_SA(b, h) + aoff + m * 2048 + k * 1024); } while (0)
#define PG8_LDB(dst, b, h) do { _Pragma("unroll") for (int n = 0; n < 2; ++n) _Pragma("unroll") for (int k = 0; k < 2; ++k) dst[n][k] = *(const PG8_LAS bf16x8*)(lds + PG8_SB(b, h) + boff + n * 2048 + k * 1024); } while (0)
#define PG8_MMA(ai, bj, At, Bt) do { __builtin_amdgcn_s_setprio(1); _Pragma("unroll") for (int m = 0; m < 4; ++m) _Pragma("unroll") for (int n = 0; n < 2; ++n) _Pragma("unroll") for (int k = 0; k < 2; ++k) \
        acc[ai][bj][m][n] = __builtin_amdgcn_mfma_f32_16x16x32_bf16(Bt[n][k], At[m][k], acc[ai][bj][m][n], 0, 0, 0); __builtin_amdgcn_s_setprio(0); } while (0)
#define PG8_WAIT_V(n) asm volatile("s_waitcnt vmcnt(" #n ")" ::: "memory")
#define PG8_WAIT_L(n) asm volatile("s_waitcnt lgkmcnt(" #n ")" ::: "memory")
#define PG8_BAR __builtin_amdgcn_s_barrier()
#define PG8_SCHED __builtin_amdgcn_sched_barrier(0)
    Unit cur, nxt; int ui = 0;
    if (!S.next(0, cur)) return;
    f32x4 acc[2][2][4][2];
#pragma unroll
    for (int a = 0; a < 2; ++a)
#pragma unroll
        for (int b = 0; b < 2; ++b)
#pragma unroll
            for (int m = 0; m < 4; ++m)
#pragma unroll
                for (int n = 0; n < 2; ++n) acc[a][b][m][n] = (f32x4){0.f, 0.f, 0.f, 0.f};
    bf16x8 At[4][2], B0[2][2], B1[2][2];
    const char* cA = (const char*)g.A + (size_t)cur.pm * tstep; const char* cB = (const char*)g.Bt + (size_t)cur.pn * tstep;
    S.a_ready(cur);
    if constexpr (SP2) {
        PG8_STAGE(PG8_SB(0, 0), cB, voffB); PG8_STAGE(PG8_SB(0, 1), cB + hstep, voffB); PG8_STAGE(PG8_SA(0, 0), cA, voffA); PG8_STAGE(PG8_SA(0, 1), cA + hstep, voffA);
        if (wr == 1) PG8_BAR;
        PG8_WAIT_V(2); PG8_BAR;
        PG8_STAGE(PG8_SB(1, 0), cB + kstep, voffB); PG8_STAGE(PG8_SA(1, 0), cA + kstep, voffA); PG8_STAGE(PG8_SB(1, 1), cB + hstep + kstep, voffB);
        PG8_WAIT_V(6); PG8_BAR;
    } else {
        PG8_STAGE(PG8_SB(0, 0), cB, voffB); PG8_STAGE(PG8_SA(0, 0), cA, voffA); PG8_STAGE(PG8_SB(0, 1), cB + hstep, voffB); PG8_STAGE(PG8_SA(0, 1), cA + hstep, voffA);
        if (wr == 1) PG8_BAR;
        PG8_WAIT_V(4); PG8_BAR;
        PG8_STAGE(PG8_SB(1, 0), cB + kstep, voffB); PG8_STAGE(PG8_SA(1, 0), cA + kstep, voffA); PG8_STAGE(PG8_SB(1, 1), cB + hstep + kstep, voffB);
        PG8_WAIT_V(6); PG8_BAR;
    }
    for (;;) {
        const bool has_next = S.next(ui + 1, nxt);
        const char* nA = has_next ? (const char*)g.A + (size_t)nxt.pm * tstep : cA; const char* nB = has_next ? (const char*)g.Bt + (size_t)nxt.pn * tstep : cB;
        for (int t = 0; t < nt; t += 2) {
            const bool last = (t == nt - 2);
            const char* a1 = cA + (size_t)(t + 1) * kstep;
            const char* a2 = last ? nA : cA + (size_t)(t + 2) * kstep; const char* b2 = last ? nB : cB + (size_t)(t + 2) * kstep;
            const char* a3 = a2 + kstep; const char* b3 = b2 + kstep;
            if (last && has_next) S.a_ready(nxt);
            if constexpr (SP2) {
            PG8_LDB(B0, 0, 0); PG8_LDB(B1, 0, 1); PG8_SCHED; PG8_LDA(At, 0, 0); PG8_STAGE(PG8_SA(1, 1), a1 + hstep, voffA);
            PG8_WAIT_V(8); PG8_WAIT_L(0); PG8_BAR; PG8_MMA(0, 0, At, B0); PG8_MMA(0, 1, At, B1); PG8_BAR; PG8_SCHED;
            PG8_LDA(At, 0, 1); PG8_STAGE(PG8_SB(0, 0), b2, voffB); PG8_STAGE(PG8_SB(0, 1), b2 + hstep, voffB); PG8_STAGE(PG8_SA(0, 0), a2, voffA);
            PG8_WAIT_V(8); PG8_WAIT_L(0); PG8_BAR; PG8_MMA(1, 0, At, B0); PG8_MMA(1, 1, At, B1); PG8_BAR; PG8_SCHED;
            PG8_LDB(B0, 1, 0); PG8_LDB(B1, 1, 1); PG8_SCHED; PG8_LDA(At, 1, 0); PG8_STAGE(PG8_SA(0, 1), a2 + hstep, voffA);
            PG8_WAIT_V(8); PG8_WAIT_L(0); PG8_BAR; PG8_MMA(0, 0, At, B0); PG8_MMA(0, 1, At, B1); PG8_BAR; PG8_SCHED;
            PG8_LDA(At, 1, 1); PG8_STAGE(PG8_SB(1, 0), b3, voffB); PG8_STAGE(PG8_SB(1, 1), b3 + hstep, voffB); PG8_STAGE(PG8_SA(1, 0), a3, voffA);
            PG8_WAIT_V(8); PG8_WAIT_L(0); PG8_BAR; PG8_MMA(1, 0, At, B0); PG8_MMA(1, 1, At, B1); PG8_BAR; PG8_SCHED;
            } else {
            PG8_LDB(B0, 0, 0); PG8_SCHED; PG8_LDA(At, 0, 0); PG8_STAGE(PG8_SA(1, 1), a1 + hstep, voffA);
            PG8_WAIT_L(8); PG8_BAR; PG8_WAIT_L(0); PG8_MMA(0, 0, At, B0); PG8_BAR; PG8_SCHED;
            PG8_LDB(B1, 0, 1); PG8_STAGE(PG8_SB(0, 0), b2, voffB);
            PG8_BAR; PG8_WAIT_L(0); PG8_MMA(0, 1, At, B1); PG8_BAR;
            PG8_LDA(At, 0, 1); PG8_STAGE(PG8_SA(0, 0), a2, voffA);
            PG8_BAR; PG8_WAIT_L(0); PG8_MMA(1, 0, At, B0); PG8_BAR; PG8_SCHED;
            PG8_STAGE(PG8_SB(0, 1), b2 + hstep, voffB);
            PG8_WAIT_V(6); PG8_BAR; PG8_MMA(1, 1, At, B1); PG8_BAR;
            PG8_LDB(B0, 1, 0); PG8_SCHED; PG8_LDA(At, 1, 0); PG8_STAGE(PG8_SA(0, 1), a2 + hstep, voffA);
            PG8_WAIT_L(8); PG8_BAR; PG8_WAIT_L(0); PG8_MMA(0, 0, At, B0); PG8_BAR; PG8_SCHED;
            PG8_LDB(B1, 1, 1); PG8_STAGE(PG8_SB(1, 0), b3, voffB);
            PG8_BAR; PG8_WAIT_L(0); PG8_MMA(0, 1, At, B1); PG8_BAR;
            PG8_LDA(At, 1, 1); PG8_STAGE(PG8_SA(1, 0), a3, voffA);
            PG8_BAR; PG8_WAIT_L(0); PG8_MMA(1, 0, At, B0); PG8_BAR; PG8_SCHED;
            PG8_STAGE(PG8_SB(1, 1), b3 + hstep, voffB);
            PG8_WAIT_V(6); PG8_BAR; PG8_MMA(1, 1, At, B1); PG8_BAR;
            }
        }
        if constexpr (ALIGN_EPI) { if (wr == 0) PG8_BAR; }
        if constexpr (!Epi::AFTER_DRAIN) { E(acc, cur, wr, wc, fr, fq); S.done(cur); }
        if (!has_next) break;
#pragma unroll
        for (int a = 0; a < 2; ++a)
#pragma unroll
            for (int b = 0; b < 2; ++b)
#pragma unroll
                for (int m = 0; m < 4; ++m)
#pragma unroll
                    for (int n = 0; n < 2; ++n) acc[a][b][m][n] = (f32x4){0.f, 0.f, 0.f, 0.f};
        cur = nxt; cA = nA; cB = nB; ++ui;
        if constexpr (ALIGN_EPI) { if (wr == 1) PG8_BAR; }
    }
    PG8_WAIT_V(0);
    if constexpr (!ALIGN_EPI) { if (wr == 0) PG8_BAR; }
    PG8_BAR;
    if constexpr (Epi::AFTER_DRAIN) { E.fused(acc, cur, wr, wc, fr, fq, lds, wid, lane); S.done(cur); }
#undef PG8_SA
#undef PG8_SB
#undef PG8_STAGE
#undef PG8_LDA
#undef PG8_LDB
#undef PG8_MMA
#undef PG8_WAIT_V
#undef PG8_WAIT_L
#undef PG8_BAR
#undef PG8_SCHED
}
}
#ifndef PG8_SP2
#define PG8_SP2 true
#endif
#ifndef PG8_ALIGN
#define PG8_ALIGN true
#endif
#include <hip/hip_bf16.h>
#include <cmath>
namespace attn_body {
using bf16=__hip_bfloat16;
using bf16x8=__attribute__((ext_vector_type(8)))short;
using s16x4=__attribute__((ext_vector_type(4)))short;
using f32x16=__attribute__((ext_vector_type(16)))float;
using u32x4=__attribute__((ext_vector_type(4)))unsigned;
constexpr int SEQ=8192,D=64;
constexpr int NW=8,QBLK=32,QB=QBLK*NW,KVBLK=64,NQB=SEQ/QB;
constexpr int ATTN_UNIT_ROWS=QB;
__device__ __forceinline__ int crow(int r,int hi){return (r&3)+8*(r>>2)+4*hi;}
#define SBAR() __builtin_amdgcn_sched_barrier(0)
__device__ __forceinline__ void cmask(f32x16&p0,f32x16&p1,int jb,int qrel,int hi){
  const float NEG=-INFINITY; int kb=64*jb+4*hi;
  #pragma unroll
  for(int r=0;r<16;++r){int kv=kb+(r&3)+8*(r>>2); if(kv>qrel)p0[r]=NEG; if(kv+32>qrel)p1[r]=NEG;}
}

constexpr int SEL_OFF=86016;
template<int MODE,bool BAND> __device__ __forceinline__ void apply_mask(f32x16&p0,f32x16&p1,int t,int NT,int qrel,int hi,unsigned selmask,unsigned long long mw,float mhat){
  const float NEG=-INFINITY;
  if(MODE==0&&!BAND){
    const float sub=(((selmask>>(t>>2))&1u)!=0u)?mhat:INFINITY;
    #pragma unroll
    for(int r=0;r<16;++r){ p0[r]-=sub; p1[r]-=sub; }
    return;
  }
  if(MODE==0){
    const int jb=t-(NT-4);
    if(BAND&&jb>=0){ const int dq=qrel-64*jb; mw=(dq>=63)?~0ull:((dq<0)?0ull:((2ull<<dq)-1ull)); }
    else mw=(((selmask>>(t>>2))&1u)!=0u)?~0ull:0ull;
  }
  if(MODE==1){
    unsigned t0=(((unsigned)mw)>>(4*hi))<<4, t1=(((unsigned)(mw>>32))>>(4*hi))<<4; const float neg=NEG;
    asm volatile("s_nop 15\n\ts_nop 3":"+v"(p0),"+v"(p1));
    #pragma unroll
    for(int g=3;g>=0;--g){
      #pragma unroll
      for(int e=3;e>=0;--e){ const int r=4*g+e;
        asm volatile("v_add_co_u32 %0, vcc, %0, %0\n\tv_cndmask_b32 %1, %2, %1, vcc":"+v"(t0),"+v"(p0[r]):"v"(neg):"vcc");
        asm volatile("v_add_co_u32 %0, vcc, %0, %0\n\tv_cndmask_b32 %1, %2, %1, vcc":"+v"(t1),"+v"(p1[r]):"v"(neg):"vcc"); }
      t0<<=4; t1<<=4; }
    return;
  }
  {
    const unsigned lo=((unsigned)mw)>>(4*hi), hw=((unsigned)(mw>>32))>>(4*hi);
    #pragma unroll
    for(int r=0;r<16;++r){ const int bt=(r&3)+8*(r>>2); p0[r]=((lo>>bt)&1u)?(p0[r]-mhat):NEG; p1[r]=((hw>>bt)&1u)?(p1[r]-mhat):NEG; }
  }
}
constexpr int NSLOT=3, SLOTB=8192;
constexpr int LDS_K=0, LDS_V=NSLOT*SLOTB, LDS_WS=2*NSLOT*SLOTB, LDS_OST=LDS_WS+NW*64*4, LDS_BYTES=LDS_OST+NW*4096;
constexpr float C2=0.125f*1.4426950408889634f;
__device__ __forceinline__ void glds16(const void*gsrc,unsigned lds_dst){unsigned keep;
  asm volatile("s_mov_b32 %0, m0\n\ts_mov_b32 m0, %2\n\ts_nop 0\n\tglobal_load_lds_dwordx4 %1, off\n\ts_mov_b32 m0, %0":"=&s"(keep):"v"(gsrc),"s"(lds_dst):"memory");}
__device__ __forceinline__ float max3f(float a,float b,float c){float r;asm("v_max3_f32 %0, %1, %2, %3":"=v"(r):"v"(a),"v"(b),"v"(c));return r;}
__device__ __forceinline__ float max2f(float a,float b){float r;asm("v_max_f32_e32 %0, %1, %2":"=v"(r):"v"(a),"v"(b));return r;}
__device__ __forceinline__ float fadd_s(float a,float b){float r;asm("v_add_f32_e32 %0, %1, %2":"=v"(r):"v"(a),"v"(b));return r;}
__device__ __forceinline__ float fsub_s(float a,float b){float r;asm("v_sub_f32_e32 %0, %1, %2":"=v"(r):"v"(a),"v"(b));return r;}
typedef float f32x2_t __attribute__((ext_vector_type(2))); typedef __bf16 bf16x2_t __attribute__((ext_vector_type(2)));
__device__ __forceinline__ unsigned cvtpk_s(float lo,float hi){f32x2_t v={lo,hi};bf16x2_t b=__builtin_convertvector(v,bf16x2_t);return __builtin_bit_cast(unsigned,b);}
#define WAIT_BAR(N) asm volatile("s_waitcnt vmcnt(" #N ") lgkmcnt(0)\n\ts_barrier":::"memory")

__device__ __forceinline__ void qkt(f32x16&p0,f32x16&p1,const char*Kslot,const bf16x8*qr,const f32x16&negm,int r32,int hi){
  const char*kb=Kslot+hi*1024+r32*16;
  #pragma unroll
  for(int d0=0;d0<4;++d0){
    const bf16x8 b0=*reinterpret_cast<const bf16x8*>(kb+d0*2048);
    const bf16x8 b1=*reinterpret_cast<const bf16x8*>(kb+d0*2048+512);
    if(d0==0){p0=__builtin_amdgcn_mfma_f32_32x32x16_bf16(b0,qr[0],negm,0,0,0);p1=__builtin_amdgcn_mfma_f32_32x32x16_bf16(b1,qr[0],negm,0,0,0);}
    else{p0=__builtin_amdgcn_mfma_f32_32x32x16_bf16(b0,qr[d0],p0,0,0,0);p1=__builtin_amdgcn_mfma_f32_32x32x16_bf16(b1,qr[d0],p1,0,0,0);}}
}
typedef __attribute__((address_space(3))) const char* lds_cptr;
typedef short v4i16_t __attribute__((ext_vector_type(4)));
__device__ __forceinline__ void kload8(bf16x8*kf,lds_cptr kp){
  kf[0]=*(const __attribute__((address_space(3))) bf16x8*)(kp);      kf[1]=*(const __attribute__((address_space(3))) bf16x8*)(kp+512);
  kf[2]=*(const __attribute__((address_space(3))) bf16x8*)(kp+2048); kf[3]=*(const __attribute__((address_space(3))) bf16x8*)(kp+2560);
  kf[4]=*(const __attribute__((address_space(3))) bf16x8*)(kp+4096); kf[5]=*(const __attribute__((address_space(3))) bf16x8*)(kp+4608);
  kf[6]=*(const __attribute__((address_space(3))) bf16x8*)(kp+6144); kf[7]=*(const __attribute__((address_space(3))) bf16x8*)(kp+6656);
}
__device__ __forceinline__ void kload2(bf16x8*kf,lds_cptr kp,int j){ kf[2*j]=*(const __attribute__((address_space(3))) bf16x8*)(kp+j*2048); kf[2*j+1]=*(const __attribute__((address_space(3))) bf16x8*)(kp+j*2048+512); }
__device__ __forceinline__ s16x4 vtr(lds_cptr p){ return __builtin_bit_cast(s16x4,__builtin_amdgcn_ds_read_tr16_b64_v4i16((__attribute__((address_space(3))) v4i16_t*)p)); }
__device__ __forceinline__ float rowmax(const f32x16&p0,const f32x16&p1){
  float a=max3f(p0[0],p0[1],p1[0]),b=max3f(p0[2],p0[3],p1[1]);a=max3f(a,p1[2],p1[3]);
  #pragma unroll
  for(int r=4;r<16;r+=4){a=max3f(a,p0[r],p0[r+1]);b=max3f(b,p0[r+2],p0[r+3]);a=max3f(a,p1[r],p1[r+1]);b=max3f(b,p1[r+2],p1[r+3]);}
  const float m=max2f(a,b);
  auto rr=__builtin_amdgcn_permlane32_swap(__float_as_uint(m),__float_as_uint(m),false,false);
  return max2f(__uint_as_float(rr[0]),__uint_as_float(rr[1]));
}
__device__ __forceinline__ void pv(f32x16*o,int vb,bf16x8 pa0,bf16x8 pa1,bf16x8 pa2,bf16x8 pa3){
  #pragma unroll
  for(int d0=0;d0<2;++d0){s16x4 lo[4],hi[4];
    #pragma unroll
    for(int ks=0;ks<4;++ks){
      asm volatile("ds_read_b64_tr_b16 %0,%1 offset:%c2":"=&v"(lo[ks]):"v"(vb),"i"(d0*4096+ks*1024):"memory");
      asm volatile("ds_read_b64_tr_b16 %0,%1 offset:%c2":"=&v"(hi[ks]):"v"(vb),"i"(d0*4096+ks*1024+512):"memory");}
    asm volatile("s_waitcnt lgkmcnt(0)":::"memory");SBAR();
    #define PK(k) (bf16x8){lo[k][0],lo[k][1],lo[k][2],lo[k][3],hi[k][0],hi[k][1],hi[k][2],hi[k][3]}
    o[d0]=__builtin_amdgcn_mfma_f32_32x32x16_bf16(pa0,PK(0),o[d0],0,0,0);
    o[d0]=__builtin_amdgcn_mfma_f32_32x32x16_bf16(pa1,PK(1),o[d0],0,0,0);
    o[d0]=__builtin_amdgcn_mfma_f32_32x32x16_bf16(pa2,PK(2),o[d0],0,0,0);
    o[d0]=__builtin_amdgcn_mfma_f32_32x32x16_bf16(pa3,PK(3),o[d0],0,0,0);
    #undef PK
  }
}

#ifndef ATTN_STORE16
#define ATTN_STORE16(p,v) (*(u32x4*)(p)=(v))
#endif
template<int MODE,int THRL,int QP,int KP> __device__ __forceinline__ void attn_unit(int qb,const bf16*Qh,const bf16*__restrict__ Kh,const bf16*__restrict__ Vh,bf16*Oh,const bf16*__restrict__ kmh,const bf16*__restrict__ kml,const unsigned long long*__restrict__ maskb,char*shm){
  int tid_l=threadIdx.x; asm volatile("":"+v"(tid_l)); const int tid=tid_l,lane=tid&63,r32=lane&31,hi=lane>>5; const int wid=__builtin_amdgcn_readfirstlane(tid>>6);
  const int q0=qb*QB;
  const bf16*Qw=Qh+(long)(q0+wid*QBLK)*QP;
  const unsigned lds0=(unsigned)(uintptr_t)shm;
  float*wsf=(float*)(shm+LDS_WS)+wid*64;
  const bf16*ksrc=Kh+(long)lane*KP+wid*8;
  const bf16*vsrc=Vh+(long)(16*(wid&3)+(lane>>2))*KP+(wid>>2)*32+(lane&3)*8;
  const unsigned kdst=lds0+LDS_K+wid*1024, vdst=lds0+LDS_V+wid*1024;
  #define DMA_K(t,slot) glds16(ksrc+(long)(t)*KVBLK*KP,(unsigned)__builtin_amdgcn_readfirstlane(kdst+(slot)))
  #define DMA_V(t,slot) glds16(vsrc+(long)(t)*KVBLK*KP,(unsigned)__builtin_amdgcn_readfirstlane(vdst+(slot)))
  const int vb0=(int)(lds0+LDS_V)+((lane>>4)&1)*32+(lane&3)*8+(4*hi+((lane&15)>>2))*64;
  const char*Kbase=shm+LDS_K; bf16x8 kf[8];
  const lds_cptr shm3=(lds_cptr)shm; const lds_cptr kp0=shm3+LDS_K+hi*1024+r32*16; const lds_cptr vp0=shm3+LDS_V+((lane>>4)&1)*32+(lane&3)*8+(4*hi+((lane&15)>>2))*64;
  const int NT=(q0+QB)/KVBLK;
  DMA_K(0,0);DMA_V(0,0);DMA_K(1,SLOTB);
  bf16x8 qr[4];
  #pragma unroll
  for(int d0=0;d0<4;++d0)qr[d0]=*reinterpret_cast<const bf16x8*>(&Qw[(long)r32*QP+d0*16+hi*8]);
  unsigned selmask=0u; unsigned long long mw0=0ull,mw_c=0ull,mw_n=0ull; const unsigned long long*mq=maskb;
  if(MODE==1){ mq=maskb+(long)(q0+wid*QBLK+r32)*128; mw0=mq[0]; mw_c=mq[1]; }
  if(MODE==0){ selmask=((const unsigned*)(shm+SEL_OFF))[wid*QBLK+r32]; }
  float mhat=0.f,l_reg=0.f;f32x16 o[2];o[0]=f32x16{};o[1]=f32x16{};f32x16 negm=f32x16{}; if(MODE==1){asm volatile("":"+v"(negm));} const f32x16 zero16=f32x16{};
  const int qrel=wid*QBLK+r32;
  #define CMASK(P0,P1,t) apply_mask<MODE,true>(P0,P1,(t),NT,qrel,hi,selmask,mw_c,mhat)
  bool resc=false;
  #define START(P0,P1) do{ const float rm=rowmax(P0,P1); resc=false; \
    { const float dl=(rm>-1e30f)?rm:0.f; mhat=fadd_s(mhat,dl); \
      _Pragma("unroll") for(int r=0;r<16;++r){P0[r]=fsub_s(P0[r],dl);P1[r]=fsub_s(P1[r],dl);} \
      if(MODE==1){ _Pragma("unroll") for(int r=0;r<16;++r)negm[r]=-mhat; asm volatile("":"+v"(negm)); } } \
    _Pragma("unroll") for(int r=0;r<16;++r)P0[r]=__builtin_amdgcn_exp2f(P0[r]); }while(0)
  #define RESC() do{ if(resc){ asm volatile("s_waitcnt lgkmcnt(0)":::"memory"); \
      _Pragma("unroll") for(int d_=0;d_<2;++d_) _Pragma("unroll") for(int r=0;r<16;++r)o[d_][r]*=wsf[crow(r,hi)]; } }while(0)
  f32x16 pA0,pA1,pB0,pB1;
  int sl_prev=0,sl_cur=0,sl_next=SLOTB;
  #define ROT() do{sl_prev=sl_cur;sl_cur=sl_next;sl_next=(sl_next==(NSLOT-1)*SLOTB)?0:sl_next+SLOTB;}while(0)
  DMA_K(2,2*SLOTB);
  WAIT_BAR(3);
  qkt(pA0,pA1,Kbase,qr,(MODE==1?negm:zero16),r32,hi);asm volatile("s_nop 15\n\ts_nop 7":"+v"(pA0),"+v"(pA1));apply_mask<MODE,true>(pA0,pA1,0,NT,qrel,hi,selmask,mw0,0.f);
  START(pA0,pA1);
  _Pragma("unroll") for(int r=0;r<16;++r)pA1[r]=__builtin_amdgcn_exp2f(pA1[r]);
  WAIT_BAR(0);
  DMA_K(3,0);DMA_V(1,SLOTB);
  ROT();
  kload8(kf,kp0+sl_cur);
  WAIT_BAR(2);
  s16x4 vlo[8],vhi[8]; u32x4 pw0,pw1,pw2,pw3;
  #define PKW(P,B) cvtpk_s(P[B],P[B+1])
  #define PAF(k) __builtin_bit_cast(bf16x8,pw##k)
  #define VFR(i) (bf16x8){vlo[i][0],vlo[i][1],vlo[i][2],vlo[i][3],vhi[i][0],vhi[i][1],vhi[i][2],vhi[i][3]}
  #define PIN(x) asm volatile("":"+v"(x))
  #define MX3(a,b,c) __builtin_fmaxf(__builtin_fmaxf((a),(b)),(c))
  #define GAPA(MF,A0,A1,A2,A3,W0,W1,PW) do{ MF; sacc+=A0; sacc+=A1; sacc+=A2; sacc+=A3; PIN(sacc); W0; W1; PIN(PW); SBAR(); }while(0)
  #define EX(v) __builtin_amdgcn_exp2f(v)
  #define GAPB(MF,X,B) do{ MF; X[B]=EX(X[B]); X[B+1]=EX(X[B+1]); X[B+2]=EX(X[B+2]); X[B+3]=EX(X[B+3]); PIN(X); SBAR(); }while(0)
  #define VRD(i) do{ vlo[i]=vtr(vp_+(((i)>>2)*4096+((i)&3)*1024)); vhi[i]=vtr(vp_+(((i)>>2)*4096+((i)&3)*1024+512)); }while(0)
  #define KRD(G,j) do{ if(G){ kload2(kf,kp0+sl_next,j); SBAR(); } }while(0)
  #define STEP(C0,C1,P0,P1,t,GK,GV,GL) do{ SBAR(); if(MODE==1){ mw_n=((t)+1<NT)?mq[(t)+1]:0ull; } \
    const lds_cptr vp_=vp0+sl_prev; \
    VRD(0); SBAR(); float sacc=(P0[0]+P0[1]); \
    GAPA(C0=__builtin_amdgcn_mfma_f32_32x32x16_bf16(kf[0],qr[0],(MODE==1?negm:zero16),0,0,0), P0[2],P0[3],P0[4],P0[5],     pw0[0]=PKW(P0,0), pw0[1]=PKW(P0,2), pw0); \
    VRD(4); SBAR(); GAPA(C1=__builtin_amdgcn_mfma_f32_32x32x16_bf16(kf[1],qr[0],(MODE==1?negm:zero16),0,0,0), P0[6],P0[7],P0[8],P0[9],     pw0[2]=PKW(P0,4), pw0[3]=PKW(P0,6), pw0); \
    VRD(1); SBAR(); GAPA(C0=__builtin_amdgcn_mfma_f32_32x32x16_bf16(kf[2],qr[1],C0,0,0,0),   P0[10],P0[11],P0[12],P0[13], pw1[0]=PKW(P0,8), pw1[1]=PKW(P0,10), pw1); \
    VRD(5); SBAR(); GAPA(C1=__builtin_amdgcn_mfma_f32_32x32x16_bf16(kf[3],qr[1],C1,0,0,0),   P0[14],P0[15],P1[0],P1[1],   pw1[2]=PKW(P0,12),pw1[3]=PKW(P0,14), pw1); \
    VRD(2); SBAR(); GAPA(C0=__builtin_amdgcn_mfma_f32_32x32x16_bf16(kf[4],qr[2],C0,0,0,0),   P1[2],P1[3],P1[4],P1[5],     pw2[0]=PKW(P1,0), pw2[1]=PKW(P1,2), pw2); \
    VRD(6); SBAR(); GAPA(C1=__builtin_amdgcn_mfma_f32_32x32x16_bf16(kf[5],qr[2],C1,0,0,0),   P1[6],P1[7],P1[8],P1[9],     pw2[2]=PKW(P1,4), pw2[3]=PKW(P1,6), pw2); \
    VRD(3); SBAR(); GAPA(C0=__builtin_amdgcn_mfma_f32_32x32x16_bf16(kf[6],qr[3],C0,0,0,0),   P1[10],P1[11],P1[12],P1[13], pw3[0]=PKW(P1,8), pw3[1]=PKW(P1,10), pw3); \
    VRD(7); SBAR(); GAPA(C1=__builtin_amdgcn_mfma_f32_32x32x16_bf16(kf[7],qr[3],C1,0,0,0),   P1[14],P1[15],0.f,0.f,       pw3[2]=PKW(P1,12),pw3[3]=PKW(P1,14), pw3); \
    l_reg+=sacc; \
    CMASK(C0,C1,t); if(MODE==1){ mw_c=mw_n; } \
    if(GK){DMA_K((t)+3,sl_cur);} if(GV){DMA_V((t)+1,sl_next);} \
    { float a=MX3(C0[0],C0[1],C1[0]),b=MX3(C0[2],C0[3],C1[1]); a=MX3(a,C1[2],C1[3]); \
      _Pragma("unroll") for(int r=4;r<16;r+=4){a=MX3(a,C0[r],C0[r+1]);b=MX3(b,C0[r+2],C0[r+3]);a=MX3(a,C1[r],C1[r+1]);b=MX3(b,C1[r+2],C1[r+3]);} \
      float rm=__builtin_fmaxf(a,b); { auto rr=__builtin_amdgcn_permlane32_swap(__float_as_uint(rm),__float_as_uint(rm),false,false); rm=__builtin_fmaxf(__uint_as_float(rr[0]),__uint_as_float(rr[1])); } \
      resc=false; \
      if(__builtin_expect(__any(rm>(float)THRL),0)){ const float dl=__builtin_fmaxf(rm,0.f); mhat+=dl; \
        _Pragma("unroll") for(int r=0;r<16;++r){C0[r]-=dl;C1[r]-=dl;} \
        if(MODE==1){ _Pragma("unroll") for(int r=0;r<16;++r)negm[r]=-mhat; asm volatile("":"+v"(negm)); } \
        const float f=__builtin_amdgcn_exp2f(-dl); l_reg*=f; if(hi==0)wsf[r32]=f; resc=true; } } \
    SBAR(); \
    GAPB(o[0]=__builtin_amdgcn_mfma_f32_32x32x16_bf16(PAF(0),VFR(0),o[0],0,0,0), C0,0); \
    GAPB(o[1]=__builtin_amdgcn_mfma_f32_32x32x16_bf16(PAF(0),VFR(4),o[1],0,0,0), C0,4); \
    KRD(GL,0); GAPB(o[0]=__builtin_amdgcn_mfma_f32_32x32x16_bf16(PAF(1),VFR(1),o[0],0,0,0), C0,8); \
    KRD(GL,1); GAPB(o[1]=__builtin_amdgcn_mfma_f32_32x32x16_bf16(PAF(1),VFR(5),o[1],0,0,0), C0,12); \
    KRD(GL,2); GAPB(o[0]=__builtin_amdgcn_mfma_f32_32x32x16_bf16(PAF(2),VFR(2),o[0],0,0,0), C1,0); \
    KRD(GL,3); GAPB(o[1]=__builtin_amdgcn_mfma_f32_32x32x16_bf16(PAF(2),VFR(6),o[1],0,0,0), C1,4); \
    GAPB(o[0]=__builtin_amdgcn_mfma_f32_32x32x16_bf16(PAF(3),VFR(3),o[0],0,0,0), C1,8); \
    GAPB(o[1]=__builtin_amdgcn_mfma_f32_32x32x16_bf16(PAF(3),VFR(7),o[1],0,0,0), C1,12); \
    }while(0)
  int t=1;
  #undef CMASK
  #define CMASK(P0,P1,t) apply_mask<MODE,false>(P0,P1,(t),NT,qrel,hi,selmask,mw_c,mhat)
  for(;t+5<NT;t+=2){
    STEP(pB0,pB1,pA0,pA1,t,true,true,true);     WAIT_BAR(2); RESC(); ROT();
    STEP(pA0,pA1,pB0,pB1,t+1,true,true,true);   WAIT_BAR(2); RESC(); ROT();
  }
  #undef CMASK
  #define CMASK(P0,P1,t) apply_mask<MODE,true>(P0,P1,(t),NT,qrel,hi,selmask,mw_c,mhat)
  #define ENDW(tt) do{ if((tt)+3<NT){WAIT_BAR(2);} else if((tt)+2<NT){WAIT_BAR(1);} else {WAIT_BAR(0);} }while(0)
  for(;t+1<NT;t+=2){
    STEP(pB0,pB1,pA0,pA1,t,(t+3<NT),(t+1<NT),(t+1<NT));       ENDW(t);   RESC(); ROT();
    STEP(pA0,pA1,pB0,pB1,t+1,(t+4<NT),(t+2<NT),(t+2<NT));     ENDW(t+1); RESC(); ROT();
  }
  STEP(pB0,pB1,pA0,pA1,NT-1,false,false,false); RESC();
  { float sacc=pB0[0]+pB0[1]; _Pragma("unroll") for(int r=2;r<16;++r)sacc+=pB0[r]; _Pragma("unroll") for(int r=0;r<16;++r)sacc+=pB1[r]; l_reg+=sacc;
    pw0=(u32x4){PKW(pB0,0),PKW(pB0,2),PKW(pB0,4),PKW(pB0,6)};pw1=(u32x4){PKW(pB0,8),PKW(pB0,10),PKW(pB0,12),PKW(pB0,14)};pw2=(u32x4){PKW(pB1,0),PKW(pB1,2),PKW(pB1,4),PKW(pB1,6)};pw3=(u32x4){PKW(pB1,8),PKW(pB1,10),PKW(pB1,12),PKW(pB1,14)};
    SBAR(); pv(o,vb0+sl_cur,PAF(0),PAF(1),PAF(2),PAF(3)); }
  #undef PKW
  #undef PAF
  #undef VFR
  #undef PIN
  #undef MX3
  #undef GAPA
  #undef GAPB
  #undef EX
  #undef VRD
  #undef KRD
  #undef STEP
  #undef ENDW
  {auto rr=__builtin_amdgcn_permlane32_swap(__float_as_uint(l_reg),__float_as_uint(l_reg),false,false);l_reg=__uint_as_float(rr[0])+__uint_as_float(rr[1]);}
  if(hi==0)wsf[32+r32]=l_reg;asm volatile("s_waitcnt lgkmcnt(0)":::"memory");
  float rli[16];
  #pragma unroll
  for(int r=0;r<16;++r)rli[r]=__builtin_amdgcn_rcpf(wsf[32+crow(r,hi)]);
  bf16*Ow=Oh+(long)(q0+wid*QBLK)*QP;
  { bf16*stg=(bf16*)(shm+LDS_OST)+wid*2048;
    #pragma unroll
    for(int r=0;r<16;++r){const int orow=crow(r,hi);
      #pragma unroll
      for(int d0=0;d0<2;++d0)stg[orow*64+d0*32+r32]=__float2bfloat16(o[d0][r]*rli[r]);}
    asm volatile("s_waitcnt lgkmcnt(0)":::"memory");
    #pragma unroll
    for(int i=0;i<4;++i){const int row=i*8+(lane>>3),ch=lane&7; const u32x4 v=*(const u32x4*)(stg+row*64+ch*8); ATTN_STORE16(Ow+(long)row*QP+ch*8,v);} }
  asm volatile("s_waitcnt lgkmcnt(0)\n\ts_barrier":::"memory");
  #undef DMA_K
  #undef DMA_V
  #undef CMASK
  #undef START
  #undef RESC
  #undef ROT
}
constexpr int ATTN_LDS_BYTES=LDS_BYTES;

static_assert(SEL_OFF>=LDS_BYTES,"selection words above the attention body's own LDS use");
template<int QP> __device__ __forceinline__ void moba_gates(int qb,const bf16*Qh,const bf16*__restrict__ kmh,const bf16*__restrict__ kml,char*shm){
  int tid_l=threadIdx.x; asm volatile("":"+v"(tid_l)); const int tid=tid_l,lane=tid&63,r32=lane&31,hi=lane>>5; const int wid=__builtin_amdgcn_readfirstlane(tid>>6);
  const int q0=qb*QB; const bf16*Qw=Qh+(long)(q0+wid*QBLK)*QP;
  bf16x8 qr[4];
  #pragma unroll
  for(int d0=0;d0<4;++d0)qr[d0]=*reinterpret_cast<const bf16x8*>(&Qw[(long)r32*QP+d0*16+hi*8]);
  unsigned selmask=0u;
  {
    f32x16 g=f32x16{};
    #pragma unroll
    for(int d0=0;d0<4;++d0){
      const bf16x8 ah=*reinterpret_cast<const bf16x8*>(&kmh[r32*64+d0*16+hi*8]);
      const bf16x8 al=*reinterpret_cast<const bf16x8*>(&kml[r32*64+d0*16+hi*8]);
      g=__builtin_amdgcn_mfma_f32_32x32x16_bf16(ah,qr[d0],g,0,0,0);
      g=__builtin_amdgcn_mfma_f32_32x32x16_bf16(al,qr[d0],g,0,0,0);}
    float v1=-INFINITY,v2=-INFINITY,v3=-INFINITY; int i1=64,i2=64,i3=64;
    #define TOP3_INS(vv,ii) do{ const float v_=(vv); const int i_=(ii); \
      const bool b1=(v_>v1)||(v_==v1&&i_<i1), b2=(v_>v2)||(v_==v2&&i_<i2), b3=(v_>v3)||(v_==v3&&i_<i3); \
      if(b1){v3=v2;i3=i2;v2=v1;i2=i1;v1=v_;i1=i_;} else if(b2){v3=v2;i3=i2;v2=v_;i2=i_;} else if(b3){v3=v_;i3=i_;} }while(0)
    #pragma unroll
    for(int r=0;r<16;++r){ const int j=crow(r,hi); const float gv=(j<qb)?g[r]:-INFINITY; TOP3_INS(gv,(j<qb)?j:64); }
    { const float pv1=__shfl_xor(v1,32),pv2=__shfl_xor(v2,32),pv3=__shfl_xor(v3,32); const int pi1=__shfl_xor(i1,32),pi2=__shfl_xor(i2,32),pi3=__shfl_xor(i3,32);
      TOP3_INS(pv1,pi1); TOP3_INS(pv2,pi2); TOP3_INS(pv3,pi3); }
    #undef TOP3_INS
    if(i1<32)selmask|=1u<<i1; if(i2<32)selmask|=1u<<i2; if(i3<32)selmask|=1u<<i3;
  }
  if(hi==0)((unsigned*)(shm+SEL_OFF))[wid*QBLK+r32]=selmask;
}
#undef SBAR
#undef WAIT_BAR
}
#define GAS __attribute__((address_space(1)))
#define LAS __attribute__((address_space(3)))
typedef unsigned short bf16;
typedef unsigned v4u __attribute__((ext_vector_type(4)));
typedef float f32x4 __attribute__((ext_vector_type(4)));
typedef short bf16x8 __attribute__((ext_vector_type(8)));
typedef GAS unsigned gu32;
typedef GAS unsigned long long gu64;
#define RLX_AGENT __ATOMIC_RELAXED, __HIP_MEMORY_SCOPE_AGENT
#define LDS_WAIT() asm volatile("s_waitcnt lgkmcnt(0)" ::: "memory")
#define VM_WAIT() asm volatile("s_waitcnt vmcnt(0)" ::: "memory")
__device__ __forceinline__ unsigned long long rt() { return __builtin_amdgcn_s_memrealtime(); }
__device__ __forceinline__ unsigned f2bf(float f) { unsigned u = __builtin_bit_cast(unsigned, f); return (u + 0x7fffu + ((u >> 16) & 1u)) >> 16; }
__device__ __forceinline__ unsigned pk2(float lo, float hi) { return f2bf(lo) | (f2bf(hi) << 16); }

#define XB_TMO      128
#define XB_XCNT(j)  (256  + 64 * (j))
#define XB_XSUB(j)  (1280 + 64 * (j))
#define XB_XGEN(j)  (2304 + 64 * (j))
#define XB_TOP      3328
#define XB_TOPGEN   3392
#define XCD_BAR_WORDS 3456
#define XB_SPIN_CAP (1u << 18)

__device__ __forceinline__ unsigned xb_ld(unsigned* p)              { return __hip_atomic_load(p, __ATOMIC_RELAXED, __HIP_MEMORY_SCOPE_AGENT); }
__device__ __forceinline__ unsigned xb_add(unsigned* p, unsigned v) { return __hip_atomic_fetch_add(p, v, __ATOMIC_RELAXED, __HIP_MEMORY_SCOPE_AGENT); }
__device__ __forceinline__ unsigned xb_xcc_id() { return (unsigned)__builtin_amdgcn_s_getreg((3 << 11) | 20) & 0xFu; }
#define XB_SPIN(cond, bar) do { unsigned _sp = 0; while (cond) { __builtin_amdgcn_s_sleep(1); \
    if ((++_sp & 255u) == 0u) { if (xb_ld(&(bar)[XB_TMO])) break; if (_sp > XB_SPIN_CAP) { atomicAdd(&(bar)[XB_TMO], 1u); break; } } } } while (0)

struct XcdBarrier {
    unsigned* bar; unsigned x;
    volatile LAS unsigned* st;
};

__device__ __forceinline__ XcdBarrier xcd_barrier_post(unsigned* bar, volatile LAS unsigned* st) {
    XcdBarrier b; b.bar = bar; b.x = xb_xcc_id(); b.st = st;
    if (threadIdx.x == 0) (void)xb_add(&bar[XB_XCNT(b.x)], 1u);
    return b;
}
__device__ __forceinline__ void xcd_barrier_complete(unsigned* bar, unsigned x, unsigned& nloc, unsigned& nx) {
    const unsigned G = gridDim.x * gridDim.y * gridDim.z;
    unsigned sum, cnt, mine, sp = 0u;
    for (;;) {
        sum = 0u; cnt = 0u; mine = 0u;
#pragma unroll
        for (unsigned j = 0; j < 16; ++j) { const unsigned c = xb_ld(&bar[XB_XCNT(j)]); sum += c; cnt += (c > 0u) ? 1u : 0u; mine = (j == x) ? c : mine; }
        if (sum == G) break;
        __builtin_amdgcn_s_sleep(1);
        if ((++sp & 255u) == 0u) { if (xb_ld(&bar[XB_TMO])) break; if (sp > XB_SPIN_CAP) { atomicAdd(&bar[XB_TMO], 1u); break; } }
    }
    nloc = mine > 0u ? mine : 1u; nx = cnt > 0u ? cnt : 1u;
}

__device__ __forceinline__ void xcd_barrier(const XcdBarrier& b) {
    asm volatile("s_waitcnt vmcnt(0)" ::: "memory");
    __syncthreads();
    if (threadIdx.x == 0) {
        unsigned* bar = b.bar;
        __builtin_amdgcn_s_waitcnt(0);
        unsigned nloc = b.st[0], nx = b.st[1];
        if (nloc == 0u) { xcd_barrier_complete(bar, b.x, nloc, nx); b.st[0] = nloc; b.st[1] = nx; }
        const unsigned old = xb_add(&bar[XB_XSUB(b.x)], 1u);
        const unsigned gen = old / nloc;
        if (old + 1u == (gen + 1u) * nloc) {
            __builtin_amdgcn_fence(__ATOMIC_RELEASE, "agent");
            asm volatile("s_waitcnt vmcnt(0)" ::: "memory");
            const unsigned og = xb_add(&bar[XB_TOP], 1u);
            const unsigned tg = og / nx;
            if (og + 1u == (tg + 1u) * nx) xb_add(&bar[XB_TOPGEN], 1u);
            else XB_SPIN(xb_ld(&bar[XB_TOPGEN]) == tg, bar);
            __builtin_amdgcn_fence(__ATOMIC_ACQUIRE, "agent");
            xb_add(&bar[XB_XGEN(b.x)], 1u);
            asm volatile("s_waitcnt vmcnt(0)" ::: "memory");
        } else {
            XB_SPIN(xb_ld(&bar[XB_XGEN(b.x)]) == gen, bar);
            __builtin_amdgcn_fence(__ATOMIC_ACQUIRE, "agent");
            asm volatile("s_waitcnt vmcnt(0)" ::: "memory");
        }
    }
    __syncthreads();
}

constexpr int NWAVES = 8;
#ifndef STAG_TICKS
#define STAG_TICKS 0u
#endif
#ifndef PG8_ALIGN1
#define PG8_ALIGN1 true
#endif
constexpr int SEQ = 8192, DMODEL = 1024, MROWS = 16384, DFF = 2816;
constexpr float RMS_EPS = 1e-6f;
constexpr float QC2 = 0.125f * 1.4426950408889634f;
constexpr size_t MiB = 1u << 20;
constexpr size_t WS_CTL = 0, CTL_ZERO_BYTES = 1 * MiB;
constexpr size_t WS_W_IN0 = 1 * MiB, WS_W_OUT0 = 6 * MiB, WS_W_GU0 = 8 * MiB, WS_W_DN0 = 19 * MiB, WS_W_PG0 = 25 * MiB, WS_W_PP0 = 27 * MiB;
constexpr size_t WS_W_IN1 = 28 * MiB, WS_W_OUT1 = 36 * MiB, WS_W_GU1 = 38 * MiB, WS_W_DN1 = 49 * MiB, WS_W_PG1 = 55 * MiB, WS_W_PP1 = 57 * MiB;
constexpr size_t WS_ROPE = 58 * MiB;
constexpr size_t WS_ROWSS = 59 * MiB;
constexpr size_t WS_KMH = 60 * MiB, WS_KML = 60 * MiB + 64 * 1024, WS_WI = 60 * MiB + 512 * 1024;
constexpr size_t WS_KIRAW = 61 * MiB, WS_KI = 65 * MiB;
constexpr size_t WS_HB = 68 * MiB, WS_PB = 100 * MiB, WS_MASK = 116 * MiB, WS_R = 132 * MiB;
constexpr size_t WS_QO = WS_R, WS_VA = WS_R + 32 * MiB, WS_KB0 = WS_R + 48 * MiB, WS_VB0 = WS_R + 64 * MiB;
constexpr size_t WS_KC = WS_R + 32 * MiB, WS_VC = WS_R + 64 * MiB, WS_QI = WS_R + 96 * MiB;
constexpr size_t WS_ROWSS2 = 244 * MiB;
constexpr size_t WS_HID = WS_R,
#ifdef PROBE_G_ELSEWHERE
 WS_G = 100 * MiB,
#else
 WS_G = WS_R,
#endif
 WS_END = 256 * MiB;
static_assert(WS_QI + 16 * MiB <= WS_END && WS_HID + (size_t)MROWS * DFF * 2 <= WS_END, "ws map");
constexpr int CW_BAR = 4096;
constexpr int PHASE_LDS = 147456, LDSCTL_OFF = PHASE_LDS, LDS_BYTES = PHASE_LDS + 1024;

#ifndef PHMASK
#define PHMASK 0xffffffffu
#endif
#define RUNPH(k) (((PHMASK) >> (k)) & 1u)
#ifndef DUPMASK
#define DUPMASK 0u
#endif
#ifndef PROBE_VAR
#define PROBE_VAR 0
#endif
#define NREP(k) ((int)(RUNPH(k) * (1u + (((DUPMASK) >> (k)) & 1u))))
struct Args { const float* in[22]; float* out; unsigned char* ws; float f0, f1, f2, f3, f4, f5, f6, f7; };
typedef const __attribute__((address_space(4))) Args* KArgs;

namespace epi {
using pg8::f32x4; using pg8::f32x2; using pg8::Unit; using pg8::bf16_t;
typedef unsigned u32x2 __attribute__((ext_vector_type(2)));
typedef __bf16 bf16x2_t __attribute__((ext_vector_type(2)));
__device__ __forceinline__ unsigned cvtpk(float lo, float hi) { const f32x2 v = {lo, hi}; const bf16x2_t b = __builtin_convertvector(v, bf16x2_t); return __builtin_bit_cast(unsigned, b); }
__device__ __forceinline__ void st4(bf16_t* p, f32x4 v) { u32x2 w; w.x = cvtpk(v[0], v[1]); w.y = cvtpk(v[2], v[3]); *(u32x2*)p = w; }
__device__ __forceinline__ f32x4 ld4(const bf16_t* p) { const u32x2 w = *(const u32x2*)p; f32x4 v; v[0] = __uint_as_float(w.x << 16); v[1] = __uint_as_float(w.x & 0xffff0000u); v[2] = __uint_as_float(w.y << 16); v[3] = __uint_as_float(w.y & 0xffff0000u); return v; }
__device__ __forceinline__ f32x4 gelu4(f32x4 v) { const f32x2 a = pg8::gelu_pk((f32x2){v[0], v[1]}), b = pg8::gelu_pk((f32x2){v[2], v[3]}); return (f32x4){a.x, a.y, b.x, b.y}; }
__device__ __forceinline__ float sigm(float x) { return __builtin_amdgcn_rcpf(1.f + __builtin_amdgcn_exp2f(-1.4426950408889634f * x)); }
__device__ __forceinline__ float sum_fq(float s) {
    auto a = __builtin_amdgcn_permlane16_swap(__float_as_uint(s), __float_as_uint(s), false, false); s = __uint_as_float(a[0]) + __uint_as_float(a[1]);
    auto b = __builtin_amdgcn_permlane32_swap(__float_as_uint(s), __float_as_uint(s), false, false); return __uint_as_float(b[0]) + __uint_as_float(b[1]);
}
__device__ __forceinline__ float xor32(float v, int fq) {
    auto b = __builtin_amdgcn_permlane32_swap(__float_as_uint(v), __float_as_uint(v), false, false); return __uint_as_float(fq < 2 ? b[1] : b[0]);
}
__device__ __forceinline__ void row_rstd8(const float* rowss, int row0, int fq, float (&rs)[2][4]) {
    f32x4 v[2][4];
#pragma unroll
    for (int ai = 0; ai < 2; ++ai)
#pragma unroll
        for (int m = 0; m < 4; ++m) v[ai][m] = *(const f32x4*)(rowss + (size_t)(row0 + ai * 128 + m * 16) * 16 + 4 * fq);
#pragma unroll
    for (int ai = 0; ai < 2; ++ai)
#pragma unroll
        for (int m = 0; m < 4; ++m) { const float s = sum_fq((v[ai][m][0] + v[ai][m][1]) + (v[ai][m][2] + v[ai][m][3])); rs[ai][m] = 1.0f / sqrtf(s * (1.f / 1024.f) + RMS_EPS); }
}
#define EPI_FENCE() asm volatile("" ::: "memory")
typedef unsigned u32x4e __attribute__((ext_vector_type(4)));
__device__ __forceinline__ void st8(bf16_t* p, f32x4 a, f32x4 b) { u32x4e w; w.x = cvtpk(a[0], a[1]); w.y = cvtpk(a[2], a[3]); w.z = cvtpk(b[0], b[1]); w.w = cvtpk(b[2], b[3]); *(u32x4e*)p = w; }
__device__ __forceinline__ void ld8(const bf16_t* p, f32x4& a, f32x4& b) { const u32x4e w = *(const u32x4e*)p;
    a[0] = __uint_as_float(w.x << 16); a[1] = __uint_as_float(w.x & 0xffff0000u); a[2] = __uint_as_float(w.y << 16); a[3] = __uint_as_float(w.y & 0xffff0000u);
    b[0] = __uint_as_float(w.z << 16); b[1] = __uint_as_float(w.z & 0xffff0000u); b[2] = __uint_as_float(w.w << 16); b[3] = __uint_as_float(w.w & 0xffff0000u); }
__device__ __forceinline__ float xor16(float v, int fq) {
    auto a = __builtin_amdgcn_permlane16_swap(__float_as_uint(v), __float_as_uint(v), false, false); return __uint_as_float((fq & 1) ? a[0] : a[1]);
}
__device__ __forceinline__ void rope8(f32x4& a, f32x4& b, const float* cs, const float* sn, int row, int fq) {
    const f32x4 c0 = *(const f32x4*)(cs + (size_t)row * 8), c1 = *(const f32x4*)(cs + (size_t)row * 8 + 4), s0 = *(const f32x4*)(sn + (size_t)row * 8), s1 = *(const f32x4*)(sn + (size_t)row * 8 + 4);
    f32x4 pa, pb;
#pragma unroll
    for (int j = 0; j < 4; ++j) { pa[j] = xor16(a[j], fq); pb[j] = xor16(b[j], fq); }
    if (fq < 2) {
#pragma unroll
        for (int j = 0; j < 4; ++j) { a[j] = (fq == 0) ? (a[j] * c0[j] - pa[j] * s0[j]) : (a[j] * c0[j] + pa[j] * s0[j]); b[j] = (fq == 0) ? (b[j] * c1[j] - pb[j] * s1[j]) : (b[j] * c1[j] + pb[j] * s1[j]); } }
}
struct EpiInEven {
    static constexpr bool PERM = true, AFTER_DRAIN = false;
    const float* rowss; const float* cs; const float* sn; bf16_t *UQ, *VA, *KB, *VB;
    __device__ __forceinline__ void operator()(const f32x4 (&acc)[2][2][4][2], const Unit& u, int wr, int wc, int fr, int fq) const {
        const int row0 = u.pm * 256 + wr * 64 + fr; float rs8[2][4]; row_rstd8(rowss, row0, fq, rs8);
        const int sec = u.pn >> 1, cb = (u.pn & 1) * 256 + wc * 32 + 8 * fq; const bool ropew = (wc & 1) == 0;
#pragma unroll
        for (int ai = 0; ai < 2; ++ai) {
#pragma unroll
            for (int m = 0; m < 4; ++m) { const int row = row0 + ai * 128 + m * 16; const float r_ = rs8[ai][m];
#pragma unroll
                for (int bj = 0; bj < 2; ++bj) { const int c = cb + bj * 128; f32x4 a = acc[ai][bj][m][0] * r_, b = acc[ai][bj][m][1] * r_;
                    if (sec == 0) { st8(UQ + (size_t)row * 1024 + c, gelu4(a), gelu4(b)); }
                    else if (sec == 1) { st8(VA + (size_t)row * 512 + c, gelu4(a), gelu4(b)); }
                    else if (sec == 2) { if (ropew) rope8(a, b, cs, sn, row, fq); st8(UQ + (size_t)row * 1024 + 512 + c, a * QC2, b * QC2); }
                    else if (sec == 3) { if (ropew) rope8(a, b, cs, sn, row, fq); st8(KB + (size_t)row * 512 + c, a, b); }
                    else { st8(VB + (size_t)row * 512 + c, a, b); } }
                EPI_FENCE(); } }
    }
};
struct EpiResid {
    static constexpr bool PERM = true, AFTER_DRAIN = false;
    bf16_t* hb; float* rowss;
    __device__ __forceinline__ void operator()(const f32x4 (&acc)[2][2][4][2], const Unit& u, int wr, int wc, int fr, int fq) const {
        const int row0 = u.pm * 256 + wr * 64 + fr, cb = u.pn * 256 + wc * 32 + 8 * fq;
#pragma unroll
        for (int ai = 0; ai < 2; ++ai)
#pragma unroll
            for (int m = 0; m < 4; ++m) { const int row = row0 + ai * 128 + m * 16; float ss = 0.f;
#pragma unroll
                for (int bj = 0; bj < 2; ++bj) { const size_t off = (size_t)row * 1024 + cb + bj * 128; f32x4 a, b; ld8(hb + off, a, b); a = a + acc[ai][bj][m][0]; b = b + acc[ai][bj][m][1];
                    st8(hb + off, a, b); ss += ((a[0] * a[0] + a[1] * a[1]) + (a[2] * a[2] + a[3] * a[3])) + ((b[0] * b[0] + b[1] * b[1]) + (b[2] * b[2] + b[3] * b[3])); }
                ss = sum_fq(ss);
                if (fq == 0) rowss[(size_t)row * 16 + u.pn * 4 + wc] = ss;
                EPI_FENCE(); }
    }
};
struct EpiSwiglu {
    static constexpr bool PERM = true, AFTER_DRAIN = false;
    const float* rowss; bf16_t* HID;
    __device__ __forceinline__ void operator()(const f32x4 (&acc)[2][2][4][2], const Unit& u, int wr, int wc, int fr, int fq) const {
        const int row0 = u.pm * 256 + wr * 64 + fr; float rs8[2][4]; row_rstd8(rowss, row0, fq, rs8);
        const int cb = u.pn * 128 + wc * 32 + 8 * fq;
#pragma unroll
        for (int ai = 0; ai < 2; ++ai) {
#pragma unroll
            for (int m = 0; m < 4; ++m) { const int row = row0 + ai * 128 + m * 16; const float r_ = rs8[ai][m]; f32x4 o[2];
#pragma unroll
                for (int n = 0; n < 2; ++n) { const f32x4 g = acc[ai][0][m][n] * r_, up = acc[ai][1][m][n] * r_;
#pragma unroll
                    for (int j = 0; j < 4; ++j) o[n][j] = g[j] * up[j] * sigm(g[j]); }
                st8(HID + (size_t)row * DFF + cb, o[0], o[1]);
                EPI_FENCE(); } }
    }
};
struct EpiStore {
    static constexpr bool PERM = true, AFTER_DRAIN = false;
    bf16_t* O;
    __device__ __forceinline__ void operator()(const f32x4 (&acc)[2][2][4][2], const Unit& u, int wr, int wc, int fr, int fq) const {
        const int row0 = u.pm * 256 + wr * 64 + fr, cb = u.pn * 256 + wc * 32 + 8 * fq;
#pragma unroll
        for (int ai = 0; ai < 2; ++ai)
#pragma unroll
            for (int m = 0; m < 4; ++m) { const int row = row0 + ai * 128 + m * 16;
#pragma unroll
                for (int bj = 0; bj < 2; ++bj) st8(O + (size_t)row * 1024 + cb + bj * 128, acc[ai][bj][m][0], acc[ai][bj][m][1]); }
    }
};
struct EpiPleFused {
    static constexpr bool PERM = true, AFTER_DRAIN = false;
    const float* rowss; const bf16_t* hin; const bf16_t* proj; bf16_t* hout; float* rowss_out;
    __device__ __forceinline__ void operator()(const f32x4 (&acc)[2][2][4][2], const Unit& u, int wr, int wc, int fr, int fq) const {
        const int row0 = u.pm * 256 + wr * 64 + fr, cb = u.pn * 256 + wc * 32 + 8 * fq; float rs8[2][4]; row_rstd8(rowss, row0, fq, rs8);
#pragma unroll
        for (int ai = 0; ai < 2; ++ai)
#pragma unroll
            for (int m = 0; m < 4; ++m) { const int row = row0 + ai * 128 + m * 16; const float r_ = rs8[ai][m]; float ss = 0.f;
#pragma unroll
                for (int bj = 0; bj < 2; ++bj) { const size_t off = (size_t)row * 1024 + cb + bj * 128; f32x4 a, b, pa, pb; ld8(hin + off, a, b); ld8(proj + off, pa, pb);
                    const f32x4 ga = acc[ai][bj][m][0] * r_, gb = acc[ai][bj][m][1] * r_;
#pragma unroll
                    for (int j = 0; j < 4; ++j) { a[j] += pa[j] * sigm(ga[j]); b[j] += pb[j] * sigm(gb[j]); }
                    st8(hout + off, a, b); ss += ((a[0] * a[0] + a[1] * a[1]) + (a[2] * a[2] + a[3] * a[3])) + ((b[0] * b[0] + b[1] * b[1]) + (b[2] * b[2] + b[3] * b[3])); }
                ss = sum_fq(ss);
                if (fq == 0) rowss_out[(size_t)row * 16 + u.pn * 4 + wc] = ss;
                EPI_FENCE(); }
    }
};
struct PairOrder {
    int first;
    __device__ __forceinline__ bool next(int i, Unit& u) const { if (i >= 2) return false; const int t = first + i; u.pm = t >> 2; u.pn = t & 3; return true; }
    __device__ __forceinline__ void a_ready(const Unit&) const {}
    __device__ __forceinline__ void done(const Unit&) const {}
};
struct EpiPleGate {
    static constexpr bool PERM = true, AFTER_DRAIN = false;
    const float* rowss; bf16_t* G;
    __device__ __forceinline__ void operator()(const f32x4 (&acc)[2][2][4][2], const Unit& u, int wr, int wc, int fr, int fq) const {
        const int row0 = u.pm * 256 + wr * 64 + fr; float rs8[2][4]; row_rstd8(rowss, row0, fq, rs8);
        const int cb = u.pn * 256 + wc * 32 + 8 * fq;
#pragma unroll
        for (int ai = 0; ai < 2; ++ai) {
#pragma unroll
            for (int m = 0; m < 4; ++m) { const int row = row0 + ai * 128 + m * 16; const float r_ = rs8[ai][m];
#pragma unroll
                for (int bj = 0; bj < 2; ++bj) { const f32x4 a = acc[ai][bj][m][0] * r_, b = acc[ai][bj][m][1] * r_; f32x4 oa, ob;
#pragma unroll
                    for (int j = 0; j < 4; ++j) { oa[j] = sigm(a[j]); ob[j] = sigm(b[j]); }
                    st8(G + (size_t)row * 1024 + cb + bj * 128, oa, ob); }
                EPI_FENCE(); } }
    }
};
struct EpiPleProj {
    static constexpr bool PERM = true, AFTER_DRAIN = false;
    bf16_t* hb; float* rowss; const bf16_t* G;
    __device__ __forceinline__ void operator()(const f32x4 (&acc)[2][2][4][2], const Unit& u, int wr, int wc, int fr, int fq) const {
        const int row0 = u.pm * 256 + wr * 64 + fr, cb = u.pn * 256 + wc * 32 + 8 * fq;
#pragma unroll
        for (int ai = 0; ai < 2; ++ai)
#pragma unroll
            for (int m = 0; m < 4; ++m) { const int row = row0 + ai * 128 + m * 16; float ss = 0.f;
#pragma unroll
                for (int bj = 0; bj < 2; ++bj) { const size_t off = (size_t)row * 1024 + cb + bj * 128; f32x4 a, b, ga, gb; ld8(hb + off, a, b); ld8(G + off, ga, gb);
                    a = a + acc[ai][bj][m][0] * ga; b = b + acc[ai][bj][m][1] * gb;
                    st8(hb + off, a, b); ss += ((a[0] * a[0] + a[1] * a[1]) + (a[2] * a[2] + a[3] * a[3])) + ((b[0] * b[0] + b[1] * b[1]) + (b[2] * b[2] + b[3] * b[3])); }
                ss = sum_fq(ss);
                if (fq == 0) rowss[(size_t)row * 16 + u.pn * 4 + wc] = ss;
                EPI_FENCE(); }
    }
};
struct EpiInOdd {
    static constexpr bool PERM = true, AFTER_DRAIN = false;
    const float* rowss; const float* cs; const float* sn; bf16_t *QO, *KC, *VC, *QI; float* KIRAW; float* WI;
    __device__ __forceinline__ void operator()(const f32x4 (&acc)[2][2][4][2], const Unit& u, int wr, int wc, int fr, int fq) const {
        const int row0 = u.pm * 256 + wr * 64 + fr; float rs8[2][4]; row_rstd8(rowss, row0, fq, rs8);
        const int pn = u.pn, cl = wc * 32 + 8 * fq; const bool ropew = (wc & 1) == 0;
#pragma unroll
        for (int ai = 0; ai < 2; ++ai) {
#pragma unroll
            for (int m = 0; m < 4; ++m) { const int row = row0 + ai * 128 + m * 16; const float r_ = rs8[ai][m];
#pragma unroll
                for (int bj = 0; bj < 2; ++bj) { const int c = cl + bj * 128; f32x4 a = acc[ai][bj][m][0] * r_, b = acc[ai][bj][m][1] * r_;
                    if (pn < 4) { if (ropew) rope8(a, b, cs, sn, row, fq); st8(QO + (size_t)row * 1024 + pn * 256 + c, a * QC2, b * QC2); }
                    else if (pn < 8) { if (ropew) rope8(a, b, cs, sn, row, fq); st8(KC + (size_t)row * 1024 + (pn - 4) * 256 + c, a, b); }
                    else if (pn < 12) { st8(VC + (size_t)row * 1024 + (pn - 8) * 256 + c, a, b); }
                    else if (pn < 14) { if (ropew) rope8(a, b, cs, sn, row, fq); st8(QI + (size_t)row * 512 + (pn - 12) * 256 + c, a, b); }
                    else { if (c < 64) { *(f32x4*)(KIRAW + (size_t)row * 64 + c) = a; *(f32x4*)(KIRAW + (size_t)row * 64 + c + 4) = b; }
                           else if (c == 64) { *(f32x4*)(WI + (size_t)row * 8) = a * 0.04419417382415922f; *(f32x4*)(WI + (size_t)row * 8 + 4) = b * 0.04419417382415922f; } } }
                EPI_FENCE(); } }
    }
};
}

__device__ __forceinline__ float wave_sum(float v) {
#pragma unroll
    for (int o = 1; o < 64; o <<= 1) v += __shfl_xor(v, o);
    return v;
}
constexpr int XP_SCR = 64 * 65;
template <int MODE>
__device__ __forceinline__ void xpose_item(const float* __restrict__ W, int K, int N, const float* __restrict__ g, bf16* __restrict__ WT, int off, LAS float* scr, int item, int lane) {
    const int nblk = (N + 63) / 64, kb = item / nblk, nb = item % nblk, k0 = 64 * kb, n0 = 64 * nb;
    const int nq = lane & 15, kr = lane >> 4; const int nn = n0 + 4 * nq; const bool ok = nn < N;
#pragma unroll 8
    for (int i = 0; i < 16; ++i) { const int kk = 4 * i + kr; f32x4 v = ok ? *(const f32x4*)(W + (size_t)(k0 + kk) * N + nn) : (f32x4){0.f, 0.f, 0.f, 0.f};
        if (g) v = v * g[k0 + kk];
        LAS float* d = scr + kk * 65 + 4 * nq; d[0] = v[0]; d[1] = v[1]; d[2] = v[2]; d[3] = v[3]; }
    LDS_WAIT(); asm volatile("" ::: "memory");
    const int c = lane & 7;
#pragma unroll
    for (int j = 0; j < 8; ++j) { const int n = (lane >> 3) + 8 * j; const LAS float* s = scr + (8 * c) * 65 + n;
        v4u o; o.x = pk2(s[0 * 65], s[1 * 65]); o.y = pk2(s[2 * 65], s[3 * 65]); o.z = pk2(s[4 * 65], s[5 * 65]); o.w = pk2(s[6 * 65], s[7 * 65]);
        const int ng = n0 + n;
        if (ng < N) { const int dr = (MODE == 0) ? (ng + off) : ((ng >> 7) * 256 + (ng & 127) + off); *(v4u*)(WT + (size_t)dr * K + k0 + 8 * c) = o; } }
    LDS_WAIT(); asm volatile("" ::: "memory");
}
__device__ __forceinline__ float bf2f(bf16 b) { return __uint_as_float(((unsigned)b) << 16); }

__device__ __forceinline__ void stagger_start(int nunits_total, int G, int bx, unsigned ticks) {
    const int rem = nunits_total % G;
    if (rem != 0 && bx >= rem) { const unsigned long long t0 = __builtin_amdgcn_s_memrealtime(); while (__builtin_amdgcn_s_memrealtime() - t0 < (unsigned long long)ticks) __builtin_amdgcn_s_sleep(32); }
}
template <int LM>
__device__ __forceinline__ void xp_run(KArgs ap, unsigned char* ws, LAS float* scr, int lane, int first, int stride) {
    const float *g_mix = ap->in[3], *w_in_even = ap->in[4], *w_out_even = ap->in[9], *w_in_odd = ap->in[10], *w_out_odd = ap->in[13], *g_ffn = ap->in[14], *w_gate = ap->in[15], *w_up = ap->in[16],
                *w_down = ap->in[17], *g_ple = ap->in[18], *w_pproj = ap->in[19], *w_pgate = ap->in[20];
    constexpr int I_IN0 = 16 * 40, I_SQ = 16 * 16, I_GU = 16 * 44, I_DN = 44 * 16, I_PP = 4 * 16, I_IN1 = 16 * 58;
    constexpr int N_L = I_SQ + 2 * I_GU + I_DN + I_SQ + I_PP;
    constexpr int NITEMS = ((LM & 1) ? I_IN0 : 0) + ((LM & 8) ? I_IN1 : 0) + ((LM & 2) ? N_L : 0) + ((LM & 4) ? N_L : 0);
#define XP(BIT, MODE, Wp, K_, N_, gp, OFFB, off_, NI) if (LM & (BIT)) { if (r < (NI)) { xpose_item<MODE>((Wp), (K_), (N_), (gp), (bf16*)(ws + (OFFB)), (off_), scr, r, lane); continue; } r -= (NI); }
    for (int it = first; it < NITEMS; it += stride) {
        int r = it;
        XP(1, 0, w_in_even, 1024, 2560, g_mix, WS_W_IN0, 0, I_IN0)
        XP(2, 0, w_out_even, 1024, 1024, (const float*)nullptr, WS_W_OUT0, 0, I_SQ)
        XP(2, 1, w_gate, 1024, DFF, g_ffn, WS_W_GU0, 0, I_GU)
        XP(2, 1, w_up, 1024, DFF, g_ffn, WS_W_GU0, 128, I_GU)
        XP(2, 0, w_down, DFF, 1024, (const float*)nullptr, WS_W_DN0, 0, I_DN)
        XP(2, 0, w_pgate, 1024, 1024, g_ple, WS_W_PG0, 0, I_SQ)
        XP(2, 0, w_pproj, 256, 1024, (const float*)nullptr, WS_W_PP0, 0, I_PP)
        XP(8, 0, w_in_odd, 1024, 3656, g_mix + 1024, WS_W_IN1, 0, I_IN1)
        XP(4, 0, w_out_odd, 1024, 1024, (const float*)nullptr, WS_W_OUT1, 0, I_SQ)
        XP(4, 1, w_gate + (size_t)1024 * DFF, 1024, DFF, g_ffn + 1024, WS_W_GU1, 0, I_GU)
        XP(4, 1, w_up + (size_t)1024 * DFF, 1024, DFF, g_ffn + 1024, WS_W_GU1, 128, I_GU)
        XP(4, 0, w_down + (size_t)DFF * 1024, DFF, 1024, (const float*)nullptr, WS_W_DN1, 0, I_DN)
        XP(4, 0, w_pgate + (size_t)1024 * 1024, 1024, 1024, g_ple + 1024, WS_W_PG1, 0, I_SQ)
        XP(4, 0, w_pproj + (size_t)256 * 1024, 256, 1024, (const float*)nullptr, WS_W_PP1, 0, I_PP)
    }
#undef XP
}
__device__ __forceinline__ void pb_convert(KArgs ap, unsigned char* ws, int gt, int NGT) {
    const f32x4* p4 = (const f32x4*)ap->in[1]; unsigned long long* o8 = (unsigned long long*)(ws + WS_PB); const int n4 = 2 * MROWS * 256 / 4;
    for (int i = gt; i < n4; i += NGT) { const f32x4 v = p4[i]; o8[i] = (unsigned long long)pk2(v[0], v[1]) | ((unsigned long long)pk2(v[2], v[3]) << 32); }
}
__device__ __forceinline__ void p0_prologue(KArgs ap, unsigned char* ws, LAS unsigned char* lds, int vcu, int G, int wave, int lane, int tid) {
    LAS float* scr = (LAS float*)lds + wave * XP_SCR;
    const int gw = vcu * NWAVES + wave, NGW = G * NWAVES, gt = vcu * (NWAVES * 64) + tid, NGT = G * NWAVES * 64;
    if (G == 256) xp_run<1>(ap, ws, scr, lane, gw, NGW); else xp_run<15>(ap, ws, scr, lane, gw, NGW);
    { v4u* z = (v4u*)(ws + WS_W_IN1 + (size_t)3656 * 1024 * 2); const int nz = (3840 - 3656) * 1024 * 2 / 16;
      for (int i = gt; i < nz; i += NGT) z[i] = (v4u){0u, 0u, 0u, 0u}; }
    { const float* x = ap->in[0]; bf16* hb = (bf16*)(ws + WS_HB); float* rowss = (float*)(ws + WS_ROWSS);
      for (int row = gw; row < MROWS; row += NGW) {
          const f32x4* xr = (const f32x4*)(x + (size_t)row * 1024) + lane; unsigned long long* o8 = (unsigned long long*)(hb + (size_t)row * 1024) + lane; float ss = 0.f;
#pragma unroll
          for (int j = 0; j < 4; ++j) { const f32x4 v = xr[64 * j]; ss += (v[0] * v[0] + v[1] * v[1]) + (v[2] * v[2] + v[3] * v[3]);
              o8[64 * j] = (unsigned long long)pk2(v[0], v[1]) | ((unsigned long long)pk2(v[2], v[3]) << 32); }
          ss = wave_sum(ss);
          if (lane < 16) rowss[(size_t)row * 16 + lane] = (lane == 0) ? ss : 0.f; } }
    pb_convert(ap, ws, gt, NGT);
    { const int* pos = (const int*)ap->in[2]; float* cs = (float*)(ws + WS_ROPE); float* sn = cs + MROWS * 8;
      for (int e = gt; e < MROWS * 8; e += NGT) { const int row = e >> 3, i = e & 7;
          const float f = (i == 0) ? ap->f0 : (i == 1) ? ap->f1 : (i == 2) ? ap->f2 : (i == 3) ? ap->f3 : (i == 4) ? ap->f4 : (i == 5) ? ap->f5 : (i == 6) ? ap->f6 : ap->f7;
          const float ang = (float)pos[row] * f; const double rev = (double)ang * 0.15915494309189533577; const float fr = (float)(rev - floor(rev));
          cs[e] = __builtin_amdgcn_cosf(fr); sn[e] = __builtin_amdgcn_sinf(fr); } }
}

__device__ __forceinline__ void kmean_unit(unsigned char* ws, int u, int lane) {
    const int bh = u >> 5, blk = u & 31; const bf16* kb = (const bf16*)(ws + WS_KB0) + ((size_t)(bh >> 3) * SEQ + blk * 256) * 512 + (bh & 7) * 64 + lane;
    float s0 = 0.f, s1 = 0.f, s2 = 0.f, s3 = 0.f;
#pragma unroll 4
    for (int r = 0; r < 256; r += 4) { s0 += bf2f(kb[(size_t)(r + 0) * 512]); s1 += bf2f(kb[(size_t)(r + 1) * 512]); s2 += bf2f(kb[(size_t)(r + 2) * 512]); s3 += bf2f(kb[(size_t)(r + 3) * 512]); }
    const float mean = ((s0 + s1) + (s2 + s3)) * (1.f / 256.f); const unsigned h = f2bf(mean); const float res = mean - __uint_as_float(h << 16);
    ((bf16*)(ws + WS_KMH))[u * 64 + lane] = (bf16)h; ((bf16*)(ws + WS_KML))[u * 64 + lane] = (bf16)f2bf(res);
}
__device__ __forceinline__ void sgu_unit(KArgs ap, unsigned char* ws, LAS unsigned char* lds, int cu, int g, int wave, int lane, int tid, bf16* YO) {
    constexpr int LTS = 136;
    LAS bf16* LT = (LAS bf16*)lds;
    const float *ln_g = ap->in[5], *ln_b = ap->in[6], *w_s = ap->in[7], *b_s = ap->in[8];
    bf16* UQ = (bf16*)(ws + WS_QO); const bf16* VA = (const bf16*)(ws + WS_VA);
    const int row0 = cu * 128;
    { const int s = tid >> 2, qd = tid & 3; const bf16* vp = VA + (size_t)(row0 + s) * 512 + g * 64 + qd * 16;
      const v4u w0 = *(const v4u*)vp, w1 = *(const v4u*)(vp + 8); float xv[16];
      xv[0] = __uint_as_float(w0.x << 16); xv[1] = __uint_as_float(w0.x & 0xffff0000u); xv[2] = __uint_as_float(w0.y << 16); xv[3] = __uint_as_float(w0.y & 0xffff0000u);
      xv[4] = __uint_as_float(w0.z << 16); xv[5] = __uint_as_float(w0.z & 0xffff0000u); xv[6] = __uint_as_float(w0.w << 16); xv[7] = __uint_as_float(w0.w & 0xffff0000u);
      xv[8] = __uint_as_float(w1.x << 16); xv[9] = __uint_as_float(w1.x & 0xffff0000u); xv[10] = __uint_as_float(w1.y << 16); xv[11] = __uint_as_float(w1.y & 0xffff0000u);
      xv[12] = __uint_as_float(w1.z << 16); xv[13] = __uint_as_float(w1.z & 0xffff0000u); xv[14] = __uint_as_float(w1.w << 16); xv[15] = __uint_as_float(w1.w & 0xffff0000u);
      float sm = 0.f;
#pragma unroll
      for (int e = 0; e < 16; ++e) sm += xv[e];
      sm += __shfl_xor(sm, 1); sm += __shfl_xor(sm, 2); const float mean = sm * (1.f / 64.f); float sq = 0.f;
#pragma unroll
      for (int e = 0; e < 16; ++e) { xv[e] -= mean; sq += xv[e] * xv[e]; }
      sq += __shfl_xor(sq, 1); sq += __shfl_xor(sq, 2); const float rstd = 1.0f / sqrtf(sq * (1.f / 64.f) + RMS_EPS);
#pragma unroll
      for (int e = 0; e < 16; ++e) { const int d = qd * 16 + e; const float y = xv[e] * rstd * ln_g[g * 64 + d] + ln_b[g * 64 + d]; LT[d * LTS + s] = (bf16)f2bf(y); } }
    __syncthreads();
    { const int r = lane & 15, kq = lane >> 4, t = 16 * wave + r; const int nks = (16 * wave + 16 + 31) >> 5;
      f32x4 acc[4];
#pragma unroll
      for (int ct = 0; ct < 4; ++ct) acc[ct] = (f32x4){0.f, 0.f, 0.f, 0.f};
      const float* wrow = w_s + ((size_t)g * 128 + t) * 128;
      for (int ks = 0; ks < nks; ++ks) { const int s0 = 32 * ks + 8 * kq; const f32x4 wa = *(const f32x4*)(wrow + s0), wb = *(const f32x4*)(wrow + s0 + 4);
          v4u af; af.x = pk2(s0 + 0 <= t ? wa[0] : 0.f, s0 + 1 <= t ? wa[1] : 0.f); af.y = pk2(s0 + 2 <= t ? wa[2] : 0.f, s0 + 3 <= t ? wa[3] : 0.f);
          af.z = pk2(s0 + 4 <= t ? wb[0] : 0.f, s0 + 5 <= t ? wb[1] : 0.f); af.w = pk2(s0 + 6 <= t ? wb[2] : 0.f, s0 + 7 <= t ? wb[3] : 0.f);
          const bf16x8 afr = __builtin_bit_cast(bf16x8, af);
#pragma unroll
          for (int ct = 0; ct < 4; ++ct) { const bf16x8 bfr = *(const LAS bf16x8*)(LT + (16 * ct + r) * LTS + s0); acc[ct] = __builtin_amdgcn_mfma_f32_16x16x32_bf16(afr, bfr, acc[ct], 0, 0, 0); } }
#pragma unroll
      for (int ct = 0; ct < 4; ++ct)
#pragma unroll
          for (int rg = 0; rg < 4; ++rg) { const int tt = 16 * wave + 4 * kq + rg, d = 16 * ct + r; const float mixed = acc[ct][rg] + b_s[g * 128 + tt];
              const size_t oi = (size_t)(row0 + tt) * 1024 + g * 64 + d; YO[oi] = (bf16)f2bf(bf2f(UQ[oi]) * mixed); } }
    __syncthreads();
}

__device__ __forceinline__ void kidx_rows(KArgs ap, unsigned char* ws, int gw, int NGW, int lane) {
    const float* kr = (const float*)(ws + WS_KIRAW); bf16* ki = (bf16*)(ws + WS_KI); const float* cs = (const float*)(ws + WS_ROPE); const float* sn = cs + MROWS * 8;
    const float gg = ap->in[11][lane], bb = ap->in[12][lane];
    for (int row = gw; row < MROWS; row += NGW) {
        const float x = kr[(size_t)row * 64 + lane]; const float mean = wave_sum(x) * (1.f / 64.f); const float xc = x - mean; const float var = wave_sum(xc * xc) * (1.f / 64.f);
        float y = xc * (1.0f / sqrtf(var + RMS_EPS)) * gg + bb; const float pr = __shfl_xor(y, 8);
        if (lane < 16) { const float c = cs[(size_t)row * 8 + (lane & 7)], s = sn[(size_t)row * 8 + (lane & 7)]; y = (lane < 8) ? (y * c - pr * s) : (y * c + pr * s); }
        ki[(size_t)(row >> 5) * 2048 + (lane >> 4) * 512 + ((lane >> 3) & 1) * 256 + (row & 31) * 8 + (lane & 7)] = (bf16)f2bf(y); }
}

typedef float f32x16 __attribute__((ext_vector_type(16)));
__device__ __forceinline__ unsigned raw2key(unsigned b) { return (b & 0x8000u) ? ((~b) & 0xffffu) : (b | 0x8000u); }
__device__ __forceinline__ unsigned f2raw16(float s) { const _Float16 h = (_Float16)(s + 0.0f); return (unsigned)__builtin_bit_cast(unsigned short, h); }
__device__ __forceinline__ void hist_find4(const v4u h, unsigned need, unsigned& bin, unsigned& above) {
    const unsigned c = h.x + h.y + h.z + h.w; unsigned long long nz = __ballot(c != 0u); unsigned cum = 0u; int L = 0; unsigned cl = 0u;
    while (nz) { L = 63 - (int)__builtin_clzll(nz); cl = (unsigned)__builtin_amdgcn_readlane((int)c, L); if (cum + cl >= need) break; cum += cl; nz &= ~(1ull << L); }
    const unsigned hw = (unsigned)__builtin_amdgcn_readlane((int)h.w, L), hz = (unsigned)__builtin_amdgcn_readlane((int)h.z, L), hy = (unsigned)__builtin_amdgcn_readlane((int)h.y, L);
    if (cum + hw >= need) { bin = 4 * L + 3; above = cum; } else { cum += hw; if (cum + hz >= need) { bin = 4 * L + 2; above = cum; } else { cum += hz; if (cum + hy >= need) { bin = 4 * L + 1; above = cum; } else { cum += hy; bin = 4 * L; above = cum; } } }
}
template <int VAR> __device__ __forceinline__ void dsa_index_unit(unsigned char* ws, LAS unsigned char* lds, int b, int q0, int wave, int lane, int tid) {
    LAS unsigned short* SC = (LAS unsigned short*)lds; LAS unsigned* HIST = (LAS unsigned*)(lds + 131072);
    const bf16* QI = (const bf16*)(ws + WS_QI); const bf16* KI = (const bf16*)(ws + WS_KI); const float* WI = (const float*)(ws + WS_WI);
    unsigned long long* MASK = (unsigned long long*)(ws + WS_MASK);
    const int r32 = lane & 31, hi = lane >> 5; const size_t rowb = (size_t)b * SEQ;
    for (int i = tid; i < 2048; i += NWAVES * 64) HIST[i] = 0u;
    bf16x8 af[2][4]; float sg[2][16];
#pragma unroll
    for (int rt = 0; rt < 2; ++rt) { const size_t qrow = rowb + q0 + 4 * rt + (r32 >> 3); const int ih = r32 & 7; const float w = WI[qrow * 8 + ih];
#pragma unroll
        for (int ks = 0; ks < 4; ++ks) { const v4u q4 = *(const v4u*)(QI + qrow * 512 + ih * 64 + 16 * ks + 8 * hi); v4u o;
            o.x = pk2(__uint_as_float(q4.x << 16) * w, __uint_as_float(q4.x & 0xffff0000u) * w); o.y = pk2(__uint_as_float(q4.y << 16) * w, __uint_as_float(q4.y & 0xffff0000u) * w);
            o.z = pk2(__uint_as_float(q4.z << 16) * w, __uint_as_float(q4.z & 0xffff0000u) * w); o.w = pk2(__uint_as_float(q4.w << 16) * w, __uint_as_float(q4.w & 0xffff0000u) * w);
            af[rt][ks] = __builtin_bit_cast(bf16x8, o); }
#pragma unroll
        for (int ql = 0; ql < 4; ++ql) { const f32x4 w4 = *(const f32x4*)(WI + (rowb + q0 + 4 * rt + ql) * 8 + 4 * hi);
#pragma unroll
            for (int e = 0; e < 4; ++e) sg[rt][4 * ql + e] = (w4[e] >= 0.f) ? INFINITY : -INFINITY; } }
    __syncthreads();
    const int nkt = ((q0 + 8 + 255) >> 8) << 3;
    const bf16* kbase = KI + rowb * 64 + hi * 256 + r32 * 8;
    bf16x8 b0[4], b1[4], b2[4];
#define IDX_LOAD(B, KT) do { const int kt_ = ((KT) < nkt) ? (KT) : wave; const bf16* kp = kbase + (size_t)kt_ * 32 * 64; \
        _Pragma("unroll") for (int ks = 0; ks < 4; ++ks) (B)[ks] = *(const bf16x8*)(kp + 512 * ks); } while (0)
#define IDX_TILE(B, KT) do { const int kti = (KT); \
        f32x16 d0 = f32x16{}, d1 = f32x16{}; \
        _Pragma("unroll") for (int ks = 0; ks < 4; ++ks) { d0 = __builtin_amdgcn_mfma_f32_32x32x16_bf16(af[0][ks], (B)[ks], d0, 0, 0, 0); d1 = __builtin_amdgcn_mfma_f32_32x32x16_bf16(af[1][ks], (B)[ks], d1, 0, 0, 0); } \
        const int key = kti * 32 + r32; const bool diag = (kti * 32 + 31 > q0); \
        const int pos = (key & ~255) + 4 * (key & 63) + ((key >> 6) & 3); \
        _Pragma("unroll") for (int p = 0; p < 4; ++p) { const int rt = p >> 1, qe = (2 * p) & 3, qo = qe + 1; float se = 0.f, so = 0.f; \
            _Pragma("unroll") for (int e = 0; e < 4; ++e) { const float le = rt ? d1[4 * qe + e] : d0[4 * qe + e], lo = rt ? d1[4 * qo + e] : d0[4 * qo + e]; \
                se += __builtin_amdgcn_fmed3f(le, 0.f, sg[rt][4 * qe + e]); so += __builtin_amdgcn_fmed3f(lo, 0.f, sg[rt][4 * qo + e]); } \
            auto sw = __builtin_amdgcn_permlane32_swap(__float_as_uint(se), __float_as_uint(so), false, false); \
            const float s = __uint_as_float(sw[0]) + __uint_as_float(sw[1]); const int qi = 2 * p + hi; \
            unsigned k16 = raw2key(f2raw16(s)); if (diag) k16 = (key <= q0 + qi) ? k16 : 0u; \
            SC[qi * 8192 + pos] = (unsigned short)k16; if (VAR != 1) __hip_atomic_fetch_add(HIST + qi * 256 + (k16 >> 8), 1u, __ATOMIC_RELAXED, __HIP_MEMORY_SCOPE_WORKGROUP); } } while (0)
    if (VAR != 4) {
        IDX_LOAD(b0, wave); IDX_LOAD(b1, wave + NWAVES); IDX_LOAD(b2, wave + 2 * NWAVES);
        for (int kt = wave; kt < nkt; kt += 3 * NWAVES) {
            IDX_TILE(b0, kt); IDX_LOAD(b0, kt + 3 * NWAVES);
            if (kt + NWAVES < nkt) { IDX_TILE(b1, kt + NWAVES); IDX_LOAD(b1, kt + 4 * NWAVES); }
            if (kt + 2 * NWAVES < nkt) { IDX_TILE(b2, kt + 2 * NWAVES); IDX_LOAD(b2, kt + 5 * NWAVES); }
        }
    }
#undef IDX_LOAD
#undef IDX_TILE
    __syncthreads();
    if (VAR != 2) { const int qi = wave, qpos = q0 + qi, nk = nkt * 32; const LAS unsigned short* row = SC + qi * 8192; LAS unsigned* hrow = HIST + qi * 256;
      unsigned thr = 1u, ties = 0u; bool tiepath = false;
      if (VAR != 5 && qpos + 1 > 256) {
          const v4u h = *(const LAS v4u*)(hrow + 4 * lane);
          unsigned b1, ab1; hist_find4(h, 256u, b1, ab1); const unsigned need2 = 256u - ab1;
          LDS_WAIT();
          *(LAS v4u*)(hrow + 4 * lane) = (v4u){0u, 0u, 0u, 0u};
          LDS_WAIT();
          for (int k = 8 * lane; k < nk; k += 512) { const v4u v = *(const LAS v4u*)(row + k);
#pragma unroll
              for (int e = 0; e < 4; ++e) { const unsigned w = (e == 0) ? v.x : (e == 1) ? v.y : (e == 2) ? v.z : v.w; const unsigned k0 = w & 0xffffu, k1 = w >> 16;
                  if ((k0 >> 8) == b1) __hip_atomic_fetch_add(hrow + (k0 & 255u), 1u, __ATOMIC_RELAXED, __HIP_MEMORY_SCOPE_WORKGROUP);
                  if ((k1 >> 8) == b1) __hip_atomic_fetch_add(hrow + (k1 & 255u), 1u, __ATOMIC_RELAXED, __HIP_MEMORY_SCOPE_WORKGROUP); } }
          LDS_WAIT();
          const v4u h2 = *(const LAS v4u*)(hrow + 4 * lane);
          unsigned b2, ab2; hist_find4(h2, need2, b2, ab2);
          thr = (b1 << 8) | b2; ties = need2 - ab2; tiepath = (hrow[b2] != ties);
      }
      const int nchunk = (qpos >> 8) + 1; unsigned tiecnt = 0u; int w0lo = 0, w0hi = 0, w1lo = 0, w1hi = 0;
#define EMIT_CHUNK(c, WLO, WHI) do { const unsigned long long kk = *(const LAS unsigned long long*)(row + 256 * (c) + 4 * lane); \
          _Pragma("unroll") for (int e = 0; e < 4; ++e) { const unsigned key = (unsigned)(kk >> (16 * e)) & 0xffffu; unsigned long long wv; \
              if (!tiepath) wv = __ballot(key >= thr); \
              else { const bool gt_ = key > thr, eq = (key == thr); const unsigned long long eqm = __ballot(eq); \
                     const unsigned before = (unsigned)__builtin_popcountll(eqm & ((1ull << lane) - 1ull)); \
                     wv = __ballot(gt_ || (eq && (tiecnt + before < ties))); tiecnt += (unsigned)__builtin_popcountll(eqm); } \
              const bool mine = (lane == ((4 * (c) + e) & 63)); WLO = mine ? (int)(unsigned)wv : WLO; WHI = mine ? (int)(unsigned)(wv >> 32) : WHI; } } while (0)
      { const int n0 = nchunk < 16 ? nchunk : 16; for (int c = 0; c < ((VAR == 6) ? 1 : n0); ++c) EMIT_CHUNK(c, w0lo, w0hi); for (int c = 16; c < ((VAR == 6) ? 0 : nchunk); ++c) EMIT_CHUNK(c, w1lo, w1hi); }
#undef EMIT_CHUNK
      const unsigned long long my0 = ((unsigned long long)(unsigned)w0hi << 32) | (unsigned)w0lo, my1 = ((unsigned long long)(unsigned)w1hi << 32) | (unsigned)w1lo;
      const int nwords = 4 * nchunk; unsigned long long* mrow = MASK + (rowb + qpos) * 128;
      if (lane < nwords) mrow[lane] = my0;
      if (64 + lane < nwords) mrow[64 + lane] = my1; }
    __syncthreads();
}

__device__ __forceinline__ void final_norm(KArgs ap, unsigned char* ws, int gw, int NGW, int lane) {
    const float* rowss = (const float*)(ws + WS_ROWSS); const f32x4* gf = (const f32x4*)ap->in[21] + lane; float* out = ap->out; const bf16* hb = (const bf16*)(ws + WS_HB);
    f32x4 g4[4];
#pragma unroll
    for (int j = 0; j < 4; ++j) g4[j] = gf[64 * j];
    for (int row = gw; row < MROWS; row += NGW) {
        const float ss = wave_sum(lane < 16 ? rowss[(size_t)row * 16 + lane] : 0.f); const float rstd = 1.0f / sqrtf(ss * (1.f / 1024.f) + RMS_EPS);
        f32x4* o = (f32x4*)(out + (size_t)row * 1024) + lane; const unsigned long long* h8 = (const unsigned long long*)(hb + (size_t)row * 1024) + lane;
#pragma unroll
        for (int j = 0; j < 4; ++j) { const unsigned long long w = h8[64 * j]; const unsigned lo = (unsigned)w, hi = (unsigned)(w >> 32);
            const f32x4 h = {__uint_as_float(lo << 16), __uint_as_float(lo & 0xffff0000u), __uint_as_float(hi << 16), __uint_as_float(hi & 0xffff0000u)};
            o[64 * j] = h * rstd * g4[j]; } }
}

#ifdef PROBE_STOP
#ifndef PROBE_OFF
#define PROBE_OFF WS_R
#endif
#ifndef PROBE_CHUNKS
#define PROBE_CHUNKS 0
#endif
#ifndef PROBE_LEN
#define PROBE_LEN (1ull << 40)
#endif
#ifdef PROBE_OWN_TILE
#define PROBE_AT(k) if ((k) == PROBE_STOP) { PHASE_ENV(); pg8::StaticOrder S_; S_.init(MROWS, 1024, G, bx); pg8::Unit u_; if (S_.next(0, u_)) { const bf16* src = (const bf16*)(ws + PROBE_OFF); \
      for (int e = tid; e < 256 * 256; e += 512) { const size_t i = (size_t)(u_.pm * 256 + (e >> 8)) * 1024 + u_.pn * 256 + (e & 255); float v_ = bf2f(src[i]); if (!(fabsf(v_) < 1e30f)) v_ = 12345.f; OUT[i] = v_; } } return; }
#else
#define PROBE_AT(k) if ((k) == PROBE_STOP) { PHASE_ENV(); if (PROBE_CHUNKS > 0) { const bf16* src = (const bf16*)(ws + PROBE_OFF); \
      for (size_t i = (size_t)bx * 512 + tid; i < (size_t)MROWS * 1024; i += (size_t)G * 512) { float acc_ = 0.f; \
          for (int j = 0; j < PROBE_CHUNKS; ++j) { float v_ = bf2f(src[(i + (size_t)j * MROWS * 1024) % (size_t)(PROBE_LEN)]); if (!(fabsf(v_) < 1e30f)) v_ = 12345.f; acc_ += v_; } OUT[i] = acc_; } } return; }
#endif
#else
#define PROBE_AT(k)
#endif

#ifdef PROBE_CHECK
__device__ __forceinline__ float wave_maxf(float v) {
#pragma unroll
    for (int o = 1; o < 64; o <<= 1) v = fmaxf(v, __shfl_xor(v, o));
    return v;
}
__device__ __forceinline__ float wave_minf(float v) {
#pragma unroll
    for (int o = 1; o < 64; o <<= 1) v = fminf(v, __shfl_xor(v, o));
    return v;
}
#ifndef CHK_TOL
#define CHK_TOL 0.04f
#define CHK_ABS 1e-4f
#define CHK_MTOL 0.02f
#endif
constexpr size_t CHK_FLAGS = 512 * 1024 + 256;
__device__ __forceinline__ void chk_copy(const bf16* src, bf16* dst, int gt, int NGT) {
    const v4u* s = (const v4u*)src; v4u* d = (v4u*)dst; const int n = MROWS * 1024 / 8;
    for (int i = gt; i < n; i += NGT) d[i] = s[i];
}
__device__ __forceinline__ void chk_moba(unsigned char* ws, const bf16* QC, LAS float* L, int sample, int lane) {
    const unsigned r = (unsigned)sample * 2654435761u + 12345u; const int b = (r >> 3) & 1, h = (r >> 4) & 7, q = (r >> 8) & 8191, qb = q >> 8;
    const bf16* KB = (const bf16*)(ws + WS_KB0) + (size_t)b * SEQ * 512 + h * 64; const bf16* VB = (const bf16*)(ws + WS_VB0) + (size_t)b * SEQ * 512 + h * 64;
    const bf16* O = (const bf16*)(ws + WS_QO) + ((size_t)b * SEQ + q) * 1024 + 512 + h * 64;
    LAS float* Lg = L; LAS float* Lq = L + 32; LAS float* Ls = L + 96;
    const float qv = bf2f(QC[((size_t)b * SEQ + q) * 1024 + 512 + h * 64 + lane]); Lq[lane] = qv;
    for (int j = 0; j < qb; ++j) { float km = 0.f; for (int rr = 0; rr < 256; ++rr) km += bf2f(KB[(size_t)(j * 256 + rr) * 512 + lane]); km *= (1.f / 256.f);
        const float g = wave_sum(qv * km); if (lane == 0) Lg[j] = g; }
    LDS_WAIT();
    float v1 = -INFINITY, v2 = -INFINITY, v3 = -INFINITY; int i1 = -1, i2 = -1, i3 = -1;
    for (int j = 0; j < qb; ++j) { const float g = Lg[j]; if (g > v1) { v3 = v2; i3 = i2; v2 = v1; i2 = i1; v1 = g; i1 = j; } else if (g > v2) { v3 = v2; i3 = i2; v2 = g; i2 = j; } else if (g > v3) { v3 = g; i3 = j; } }
    float mx = -INFINITY;
    for (int sl = 0; sl < 4; ++sl) { const int blk = (sl == 0) ? i1 : (sl == 1) ? i2 : (sl == 2) ? i3 : qb;
        for (int t = 0; t < 4; ++t) { const int kk = lane + 64 * t, key = blk * 256 + kk; float s = -INFINITY;
            if (blk >= 0 && key <= q) { s = 0.f; for (int d = 0; d < 64; ++d) s += Lq[d] * bf2f(KB[(size_t)key * 512 + d]); }
            Ls[sl * 256 + kk] = s; mx = fmaxf(mx, s); } }
    mx = wave_maxf(mx); LDS_WAIT();
    float lsum = 0.f; for (int i = lane; i < 1024; i += 64) { const float p = exp2f(Ls[i] - mx); Ls[i] = p; lsum += p; }
    lsum = wave_sum(lsum); LDS_WAIT();
    float o = 0.f;
    for (int sl = 0; sl < 4; ++sl) { const int blk = (sl == 0) ? i1 : (sl == 1) ? i2 : (sl == 2) ? i3 : qb; if (blk < 0) continue;
        for (int kk = 0; kk < 256; ++kk) { const float p = Ls[sl * 256 + kk]; if (p != 0.f) o += p * bf2f(VB[(size_t)(blk * 256 + kk) * 512 + lane]); } }
    o /= lsum;
    const float err = wave_maxf(fabsf(o - bf2f(O[lane]))), ref = wave_maxf(fabsf(o));
    if (lane == 0 && !(err <= CHK_TOL * ref + CHK_ABS)) atomicOr((unsigned*)(ws + CHK_FLAGS), 1u);
    LDS_WAIT();
}
__device__ __forceinline__ void chk_mask(unsigned char* ws, LAS float* L, int sample, int lane) {
    const unsigned r = (unsigned)sample * 2246822519u + 777u; const int b = (r >> 3) & 1; int q = (r >> 8) & 8191; if ((sample & 7) == 0) q &= 511;
    const bf16* QI = (const bf16*)(ws + WS_QI); const bf16* KI = (const bf16*)(ws + WS_KI); const float* WI = (const float*)(ws + WS_WI);
    const unsigned long long* MK = (const unsigned long long*)(ws + WS_MASK) + ((size_t)b * SEQ + q) * 128; const size_t rowb = (size_t)b * SEQ;
    LAS float* Lq = L;
    for (int i = lane; i < 512; i += 64) Lq[i] = bf2f(QI[(rowb + q) * 512 + i]);
    LDS_WAIT();
    float w[8];
#pragma unroll
    for (int i = 0; i < 8; ++i) w[i] = WI[(rowb + q) * 8 + i];
    const int kend = 256 * ((q >> 8) + 1); int cnt = 0; float minsel = INFINITY, maxuns = -INFINITY; int bad = 0;
    for (int key = lane; key < kend; key += 64) { const bool bit = (MK[key >> 6] >> (key & 63)) & 1ull;
        if (key > q) { if (bit) bad = 1; continue; }
        const size_t kr = rowb + key; const bf16* kp = KI + (kr >> 5) * 2048 + (kr & 31) * 8; float sc = 0.f;
#pragma unroll
        for (int i = 0; i < 8; ++i) { float l = 0.f; for (int d = 0; d < 64; ++d) l += Lq[i * 64 + d] * bf2f(kp[(d >> 4) * 512 + ((d >> 3) & 1) * 256 + (d & 7)]); sc += fmaxf(l, 0.f) * w[i]; }
        if (bit) { ++cnt; minsel = fminf(minsel, sc); } else maxuns = fmaxf(maxuns, sc); }
    const int tot = (int)wave_sum((float)cnt); const float ms = wave_minf(minsel), mu = wave_maxf(maxuns); const int anybad = (int)wave_sum((float)bad);
    const int want = (q + 1 < 256) ? q + 1 : 256;
    if (lane == 0 && (tot != want || anybad != 0 || (mu - ms) > CHK_MTOL)) atomicOr((unsigned*)(ws + CHK_FLAGS), 2u);
    LDS_WAIT();
}
__device__ __forceinline__ void chk_dsa(unsigned char* ws, const bf16* QC, LAS float* L, int sample, int lane) {
    const unsigned r = (unsigned)sample * 3266489917u + 4242u; const int b = (r >> 3) & 1, h = (r >> 4) & 15, q = (r >> 8) & 8191;
    const bf16* KC = (const bf16*)(ws + WS_KC) + (size_t)b * SEQ * 1024 + h * 64; const bf16* VC = (const bf16*)(ws + WS_VC) + (size_t)b * SEQ * 1024 + h * 64;
    const bf16* O = (const bf16*)(ws + WS_QO) + ((size_t)b * SEQ + q) * 1024 + h * 64;
    const unsigned long long* MK = (const unsigned long long*)(ws + WS_MASK) + ((size_t)b * SEQ + q) * 128;
    LAS float* Lq = L; LAS float* Ls = L + 64; LAS int* Lk = (LAS int*)(L + 64 + 320); LAS int* Ln = (LAS int*)(L + 64 + 640);
    Lq[lane] = bf2f(QC[((size_t)b * SEQ + q) * 1024 + h * 64 + lane]); if (lane == 0) Ln[0] = 0;
    LDS_WAIT();
    float mx = -INFINITY;
    for (int key = lane; key <= q; key += 64) { const bool bit = (MK[key >> 6] >> (key & 63)) & 1ull; if (!bit) continue;
        float s = 0.f; for (int d = 0; d < 64; ++d) s += Lq[d] * bf2f(KC[(size_t)key * 1024 + d]);
        const int slot = atomicAdd((int*)Ln, 1); if (slot < 320) { Ls[slot] = s; Lk[slot] = key; } mx = fmaxf(mx, s); }
    mx = wave_maxf(mx); LDS_WAIT();
    const int n = Ln[0] < 320 ? Ln[0] : 320; float lsum = 0.f, o = 0.f;
    for (int i = 0; i < n; ++i) { const float p = exp2f(Ls[i] - mx); lsum += p; o += p * bf2f(VC[(size_t)Lk[i] * 1024 + lane]); }
    o /= lsum;
    const float err = wave_maxf(fabsf(o - bf2f(O[lane]))), ref = wave_maxf(fabsf(o));
    if (lane == 0 && !(err <= CHK_TOL * ref + CHK_ABS)) atomicOr((unsigned*)(ws + CHK_FLAGS), 4u);
    LDS_WAIT();
}
__device__ __forceinline__ void chk_sincos(int pos, float f, float& c, float& s) {
    const double ang = (double)((float)pos * f); double t = ang * 0.15915494309189533577; t -= floor(t); const double x = (t - 0.5) * 6.283185307179586477;
    const double x2 = x * x; double sn = 0.0, cs = 0.0, term = x;
    for (int k = 1; k <= 23; k += 2) { sn += term; term *= -x2 / (double)((k + 1) * (k + 2)); }
    term = 1.0; for (int k = 0; k <= 24; k += 2) { cs += term; term *= -x2 / (double)((k + 1) * (k + 2)); }
    c = (float)(-cs); s = (float)(-sn);
}
__device__ __forceinline__ void chk_proj(KArgs ap, unsigned char* ws, int layer, int sample, int lane, float f0, float f1, float f2, float f3, float f4, float f5, float f6, float f7) {
    const unsigned r = (unsigned)sample * 2654435761u + 99u + (unsigned)layer * 7777u; const int row = (r >> 7) & 16383; int kind = (r >> 3) % (layer ? 5 : 3); const int hd = (r >> 22) & (layer ? 15 : 7);
    const bf16* hb = (layer ? (const bf16*)ap->out + (size_t)MROWS * 1024 : (const bf16*)(ws + WS_HB)) + (size_t)row * 1024; const float* rowss = (const float*)(ws + (layer ? WS_ROWSS2 : WS_ROWSS)) + (size_t)row * 16;
    float ss = 0.f; for (int i = 0; i < 16; ++i) ss += rowss[i]; const float rstd = 1.0f / sqrtf(ss * (1.f / 1024.f) + RMS_EPS);
    int col; const bf16* st = nullptr; const float* stf = nullptr; float scale = 1.f; bool rope = false;
    if (layer == 0) { if (kind == 0) { col = 1024 + hd * 64 + lane; st = (const bf16*)(ws + WS_QO) + (size_t)row * 1024 + 512 + hd * 64 + lane; scale = QC2; rope = true; }
                      else if (kind == 1) { col = 1536 + hd * 64 + lane; st = (const bf16*)(ws + WS_KB0) + (size_t)row * 512 + hd * 64 + lane; rope = true; }
                      else { col = 2048 + hd * 64 + lane; st = (const bf16*)(ws + WS_VB0) + (size_t)row * 512 + hd * 64 + lane; } }
    else { if (kind == 0) { col = hd * 64 + lane; st = (const bf16*)(ws + WS_QO) + (size_t)row * 1024 + hd * 64 + lane; scale = QC2; rope = true; }
           else if (kind == 1) { col = 1024 + hd * 64 + lane; st = (const bf16*)(ws + WS_KC) + (size_t)row * 1024 + hd * 64 + lane; rope = true; }
           else if (kind == 2) { col = 2048 + hd * 64 + lane; st = (const bf16*)(ws + WS_VC) + (size_t)row * 1024 + hd * 64 + lane; }
           else if (kind == 3) { col = 3072 + (hd & 7) * 64 + lane; st = (const bf16*)(ws + WS_QI) + (size_t)row * 512 + (hd & 7) * 64 + lane; rope = true; }
           else { col = 3584 + lane; stf = (const float*)(ws + WS_KIRAW) + (size_t)row * 64 + lane; } }
    const bf16* wrow = (const bf16*)(ws + (layer ? WS_W_IN1 : WS_W_IN0)) + (size_t)col * 1024;
    float z = 0.f; for (int k = 0; k < 1024; ++k) z += bf2f(hb[k]) * bf2f(wrow[k]);
    z *= rstd;
    float expect = z;
    if (rope) { const float pr = __shfl_xor(z, 8); const int i = lane & 7; const float f = (i == 0) ? f0 : (i == 1) ? f1 : (i == 2) ? f2 : (i == 3) ? f3 : (i == 4) ? f4 : (i == 5) ? f5 : (i == 6) ? f6 : f7;
        float c, s; chk_sincos(((const int*)ap->in[2])[row], f, c, s); if (lane < 16) expect = (lane < 8) ? (z * c - pr * s) : (z * c + pr * s); }
    expect *= scale;
    const float got = st ? bf2f(*st) : *stf; const float err = wave_maxf(fabsf(expect - got)), ref = wave_maxf(fabsf(expect));
    bool bad = !(err <= CHK_TOL * ref + 1e-3f);
    if (layer == 1 && kind == 4) {
        const bf16* w2 = (const bf16*)(ws + WS_W_IN1) + (size_t)(3648 + (lane & 7)) * 1024; float zz = 0.f; for (int k = 0; k < 1024; ++k) zz += bf2f(hb[k]) * bf2f(w2[k]);
        zz *= rstd * 0.04419417382415922f; const float g2 = ((const float*)(ws + WS_WI))[(size_t)row * 8 + (lane & 7)]; const float e2 = wave_maxf(fabsf(zz - g2)), r2 = wave_maxf(fabsf(zz)); bad = bad || !(e2 <= CHK_TOL * r2 + 1e-4f); }
    if (lane == 0 && bad) atomicOr((unsigned*)(ws + CHK_FLAGS), layer ? 16u : 8u);
}
__device__ __forceinline__ void chk_kidx(KArgs ap, unsigned char* ws, int sample, int lane, float f0, float f1, float f2, float f3, float f4, float f5, float f6, float f7) {
    const unsigned r = (unsigned)sample * 40503u + 31u; const int row = (r >> 2) & 16383;
    const float x = ((const float*)(ws + WS_KIRAW))[(size_t)row * 64 + lane]; const float mean = wave_sum(x) * (1.f / 64.f); const float xc = x - mean; const float var = wave_sum(xc * xc) * (1.f / 64.f);
    float y = xc / sqrtf(var + RMS_EPS) * ap->in[11][lane] + ap->in[12][lane]; const float pr = __shfl_xor(y, 8); const int i = lane & 7;
    const float f = (i == 0) ? f0 : (i == 1) ? f1 : (i == 2) ? f2 : (i == 3) ? f3 : (i == 4) ? f4 : (i == 5) ? f5 : (i == 6) ? f6 : f7;
    float c, s; chk_sincos(((const int*)ap->in[2])[row], f, c, s); if (lane < 16) y = (lane < 8) ? (y * c - pr * s) : (y * c + pr * s);
    const bf16* ki = (const bf16*)(ws + WS_KI); const float got = bf2f(ki[(size_t)(row >> 5) * 2048 + (lane >> 4) * 512 + ((lane >> 3) & 1) * 256 + (row & 31) * 8 + (lane & 7)]);
    const float err = wave_maxf(fabsf(y - got)), ref = wave_maxf(fabsf(y));
    if (lane == 0 && !(err <= CHK_TOL * ref + 1e-3f)) atomicOr((unsigned*)(ws + CHK_FLAGS), 32u);
}
#endif
__global__ void __launch_bounds__(NWAVES * 64, 2) trunk_fwd(Args args) {
    extern __shared__ __attribute__((aligned(16))) unsigned char lds_raw[];
    LAS unsigned char* lds = (LAS unsigned char*)lds_raw;
    volatile LAS unsigned* MISC = (volatile LAS unsigned*)(lds + LDSCTL_OFF);
    const int tid0 = threadIdx.x;
    const int G = gridDim.x; const int bx = blockIdx.x; const int vcu = (G % 8 == 0) ? (bx % 8) * (G / 8) + bx / 8 : bx;
    KArgs ap0 = (KArgs)__builtin_amdgcn_kernarg_segment_ptr();
    gu32* ctl = (gu32*)(ap0->ws + WS_CTL);
    for (int u = tid0; u < (LDS_BYTES - LDSCTL_OFF) / 4; u += NWAVES * 64) ((LAS unsigned*)(lds + LDSCTL_OFF))[u] = 0u;
    __syncthreads();
    XcdBarrier bar = xcd_barrier_post((unsigned*)(ctl + CW_BAR), MISC + 8);
#ifdef PROBE_TIME
    if (bx == 0 && tid0 == 0) *(unsigned long long*)(ap0->ws + 512 * 1024) = __builtin_amdgcn_s_memrealtime();
#endif
#define GRID_BAR() xcd_barrier(bar)
    const int NGW = G * NWAVES;
#define PHASE_ENV() KArgs ap = (KArgs)__builtin_amdgcn_kernarg_segment_ptr(); asm volatile("" : "+s"(ap)); unsigned char* ws = ap->ws; \
    int tid_p = threadIdx.x; asm volatile("" : "+v"(tid_p)); const int tid = tid_p, lane = tid & 63, wave = __builtin_amdgcn_readfirstlane(tid >> 6); const int gw = vcu * NWAVES + wave; (void)lane; (void)gw; \
    pg8::bf16_t* HBA = (pg8::bf16_t*)(ws + WS_HB); float* ROWSS = (float*)(ws + WS_ROWSS); float* ROWSS2 = (float*)(ws + WS_ROWSS2); const float* CS = (const float*)(ws + WS_ROPE); const float* SN = CS + MROWS * 8; float* OUT = ap->out; \
    pg8::bf16_t* PROJ = (pg8::bf16_t*)OUT; pg8::bf16_t* HBB = (pg8::bf16_t*)OUT + (size_t)MROWS * 1024;     \
    (void)HBA; (void)HBB; (void)PROJ; (void)ROWSS; (void)ROWSS2; (void)CS; (void)SN; (void)OUT;

    enum { PROBE_C0 = __COUNTER__ + 1 };
    for (int rep_ = 0; rep_ < NREP(0); ++rep_) { PHASE_ENV(); p0_prologue(ap, ws, lds, vcu, G, wave, lane, tid); }
    GRID_BAR(); PROBE_AT(__COUNTER__ - PROBE_C0);


#ifdef PROBE_GEMM2X
#ifndef PROBE_ALIGN
#define PROBE_ALIGN PG8_ALIGN
#endif
#ifndef PROBE_SP2
#define PROBE_SP2 PG8_SP2
#endif
    {
        for (int rep = 0; rep < 2; ++rep) {
            { PHASE_ENV(); pg8::Gemm g{HB, (const pg8::bf16_t*)(ws + WS_W_PG0), MROWS, 1024, 1024}; pg8::StaticOrder S; S.init(MROWS, 1024, G, bx);
              epi::EpiPleGate E{ROWSS, (pg8::bf16_t*)(ws + WS_R + (size_t)rep * 32 * MiB)};
              pg8::gemm_phase<epi::EpiPleGate, pg8::StaticOrder, PROBE_ALIGN, PROBE_SP2>(lds, g, S, E); }
            GRID_BAR();
        }
        { PHASE_ENV(); const bf16* g1 = (const bf16*)(ws + WS_R); const bf16* g2 = g1 + (size_t)MROWS * 1024; unsigned e = 0;
          for (size_t i = (size_t)bx * 512 + tid; i < (size_t)MROWS * 1024; i += (size_t)G * 512) e += (g1[i] != g2[i]);
          if (e) atomicAdd((unsigned*)(ws + 512 * 1024 + 128), e); }
        GRID_BAR();
        { PHASE_ENV(); const unsigned e = __hip_atomic_load((unsigned*)(ws + 512 * 1024 + 128), __ATOMIC_RELAXED, __HIP_MEMORY_SCOPE_AGENT);
          float c = e ? 3.f : 1.f;
          for (size_t i = (size_t)bx * 512 + tid; i < (size_t)MROWS * 1024 / 4; i += (size_t)G * 512) ((f32x4*)OUT)[i] = (f32x4){c, c, c, c}; }
        return;
    }
#endif
    for (int rep_ = 0; rep_ < NREP(1); ++rep_) {   PHASE_ENV();
        pg8::Gemm g{HBA, (const pg8::bf16_t*)(ws + WS_W_IN0), MROWS, 2560, 1024}; pg8::StaticOrder S; S.init(MROWS, 2560, G, bx);
        epi::EpiInEven E{ROWSS, CS, SN, (pg8::bf16_t*)(ws + WS_QO), (pg8::bf16_t*)(ws + WS_VA), (pg8::bf16_t*)(ws + WS_KB0), (pg8::bf16_t*)(ws + WS_VB0)};
        pg8::gemm_phase<epi::EpiInEven, pg8::StaticOrder, PG8_ALIGN, PG8_SP2>(lds, g, S, E);
        if (G == 256 && bx >= 128) { xp_run<10>(ap, ws, (LAS float*)lds + wave * XP_SCR, lane, (bx - 128) * NWAVES + wave, 128 * NWAVES); }
    }
    GRID_BAR(); PROBE_AT(__COUNTER__ - PROBE_C0);
#ifdef PROBE_CHECK
    { PHASE_ENV(); for (int s_ = gw; s_ < 2048; s_ += NGW) chk_proj(ap, ws, 0, s_, lane, ap->f0, ap->f1, ap->f2, ap->f3, ap->f4, ap->f5, ap->f6, ap->f7); }
#endif
    for (int rep_ = 0; rep_ < NREP(2); ++rep_) {   PHASE_ENV();
        for (int u = gw; u < 512; u += NGW) kmean_unit(ws, u, lane);
        for (int u = vcu; u < 1024; u += G) sgu_unit(ap, ws, lds, u >> 3, u & 7, wave, lane, tid, (rep_ == 0 && NREP(2) == 2) ? (bf16*)(ws + WS_R + 80 * MiB) : (bf16*)(ws + WS_QO));
    }
    GRID_BAR(); PROBE_AT(__COUNTER__ - PROBE_C0);
#ifdef PROBE_CHECK
    { PHASE_ENV(); chk_copy((const bf16*)(ws + WS_QO), (bf16*)(ws + WS_R + 80 * MiB), vcu * 512 + tid, G * 512); }
    GRID_BAR();
#endif
    for (int rep_ = 0; rep_ < NREP(3); ++rep_) {   PHASE_ENV();
        using attn_body::bf16;
        for (int p = vcu; p < 256; p += G) { const int bh = p >> 4, s = p & 15, b = bh >> 3, h = bh & 7;
            bf16* Qh = (bf16*)(ws + WS_QO) + (size_t)b * SEQ * 1024 + 512 + h * 64; const bf16* Kh = (const bf16*)(ws + WS_KB0) + (size_t)b * SEQ * 512 + h * 64;
            const bf16* Vh = (const bf16*)(ws + WS_VB0) + (size_t)b * SEQ * 512 + h * 64; const bf16* kmh = (const bf16*)(ws + WS_KMH) + bh * 32 * 64; const bf16* kml = (const bf16*)(ws + WS_KML) + bh * 32 * 64;
#ifndef SKIP_MOBA
            for (int i = 0; i < 2; ++i) { const int qb = i ? 31 - s : s; attn_body::moba_gates<1024>(qb, Qh, kmh, kml, (char*)lds_raw); attn_body::attn_unit<0, 8, 1024, 512>(qb, Qh, Kh, Vh, (rep_ == 0 && NREP(3) == 2) ? (bf16*)(ws + WS_R + 80 * MiB) + (size_t)b * SEQ * 1024 + h * 64 : Qh, kmh, kml, nullptr, (char*)lds_raw); }
#endif
        }
    }
    GRID_BAR(); PROBE_AT(__COUNTER__ - PROBE_C0);
#ifdef PROBE_CHECK
    { PHASE_ENV(); LAS float* Lw = (LAS float*)lds + wave * 1152; for (int s_ = gw; s_ < 2048; s_ += NGW) chk_moba(ws, (const bf16*)(ws + WS_R + 80 * MiB), Lw, s_, lane); }
    GRID_BAR();
#endif
    for (int rep_ = 0; rep_ < NREP(4); ++rep_) {   PHASE_ENV();
        pg8::Gemm g{(const pg8::bf16_t*)(ws + WS_QO), (const pg8::bf16_t*)(ws + WS_W_OUT0), MROWS, 1024, 1024}; pg8::StaticOrder S; S.init(MROWS, 1024, G, bx);
        epi::EpiResid E{HBA, ROWSS};
        pg8::gemm_phase<epi::EpiResid, pg8::StaticOrder, PG8_ALIGN1, PG8_SP2>(lds, g, S, E);
    }
    GRID_BAR(); PROBE_AT(__COUNTER__ - PROBE_C0);
#ifdef PROBE_SWAPA
#define PROBE_A7 ((const pg8::bf16_t*)(ws + WS_HID))
#else
#define PROBE_A7 HB
#endif
#ifdef PROBE_SWAPW
#define PROBE_WPG(x) WS_W_OUT0
#else
#define PROBE_WPG(x) (x)
#endif
#define FFN_PLE(WGU, WDN, WPG, WPP, PBOFF, HIN, HOUT, RIN, ROUT) \
    for (int rep_ = 0; rep_ < NREP(5); ++rep_) {   PHASE_ENV(); { pg8::Gemm g{HIN, (const pg8::bf16_t*)(ws + (WGU)), MROWS, 2 * DFF, 1024}; pg8::StaticOrder S; S.init(MROWS, 2 * DFF, G, bx); \
        epi::EpiSwiglu E{RIN, (pg8::bf16_t*)(ws + WS_HID)}; \
        pg8::gemm_phase<epi::EpiSwiglu, pg8::StaticOrder, PG8_ALIGN, PG8_SP2>(lds, g, S, E); } \
          \
        if (G == 256 ? (bx >= 128) : (bx == 0)) { int kpp = 256; asm volatile("" : "+s"(kpp)); pg8::Gemm g2{(const pg8::bf16_t*)(ws + WS_PB) + (PBOFF), (const pg8::bf16_t*)(ws + (WPP)), MROWS, 1024, kpp}; epi::EpiStore E2{PROJ}; \
            if (G == 256) { epi::PairOrder S2{2 * (bx - 128)}; pg8::gemm_phase<epi::EpiStore, epi::PairOrder, PG8_ALIGN1, PG8_SP2>(lds, g2, S2, E2); } \
            else { pg8::StaticOrder S2; S2.init(MROWS, 1024, 1, 0); pg8::gemm_phase<epi::EpiStore, pg8::StaticOrder, PG8_ALIGN1, PG8_SP2>(lds, g2, S2, E2); } } } \
    GRID_BAR(); PROBE_AT(__COUNTER__ - PROBE_C0); \
    for (int rep_ = 0; rep_ < NREP(6); ++rep_) {   PHASE_ENV(); pg8::Gemm g{(const pg8::bf16_t*)(ws + WS_HID), (const pg8::bf16_t*)(ws + (WDN)), MROWS, 1024, DFF}; pg8::StaticOrder S; S.init(MROWS, 1024, G, bx); \
        epi::EpiResid E{HIN, RIN}; \
        pg8::gemm_phase<epi::EpiResid, pg8::StaticOrder, PG8_ALIGN1, PG8_SP2>(lds, g, S, E); } \
    GRID_BAR(); PROBE_AT(__COUNTER__ - PROBE_C0); \
    for (int rep_ = 0; rep_ < NREP(7); ++rep_) {   PHASE_ENV(); pg8::Gemm g{HIN, (const pg8::bf16_t*)(ws + (WPG)), MROWS, 1024, 1024}; pg8::StaticOrder S; S.init(MROWS, 1024, G, bx); \
        epi::EpiPleFused E{RIN, HIN, PROJ, HOUT, ROUT}; \
        pg8::gemm_phase<epi::EpiPleFused, pg8::StaticOrder, PG8_ALIGN1, PG8_SP2>(lds, g, S, E); } \
    GRID_BAR(); PROBE_AT(__COUNTER__ - PROBE_C0);
    FFN_PLE(WS_W_GU0, WS_W_DN0, WS_W_PG0, WS_W_PP0, (size_t)0, HBA, HBB, ROWSS, ROWSS2)

    for (int rep_ = 0; rep_ < NREP(9); ++rep_) {   PHASE_ENV();
        pg8::Gemm g{HBB, (const pg8::bf16_t*)(ws + WS_W_IN1), MROWS, 3840, 1024}; pg8::StaticOrder S; S.init(MROWS, 3840, G, bx);
        epi::EpiInOdd E{ROWSS2, CS, SN, (pg8::bf16_t*)(ws + WS_QO), (pg8::bf16_t*)(ws + WS_KC), (pg8::bf16_t*)(ws + WS_VC), (pg8::bf16_t*)(ws + WS_QI), (float*)(ws + WS_KIRAW), (float*)(ws + WS_WI)};
        pg8::gemm_phase<epi::EpiInOdd, pg8::StaticOrder, PG8_ALIGN, PG8_SP2>(lds, g, S, E);
        if (G == 256 && bx >= 192) xp_run<4>(ap, ws, (LAS float*)lds + wave * XP_SCR, lane, (bx - 192) * NWAVES + wave, 64 * NWAVES);
    }
    GRID_BAR(); PROBE_AT(__COUNTER__ - PROBE_C0);
#ifdef PROBE_CHECK
    { PHASE_ENV(); for (int s_ = gw; s_ < 2048; s_ += NGW) chk_proj(ap, ws, 1, s_, lane, ap->f0, ap->f1, ap->f2, ap->f3, ap->f4, ap->f5, ap->f6, ap->f7); }
#endif
    for (int rep_ = 0; rep_ < NREP(10); ++rep_) { PHASE_ENV(); kidx_rows(ap, ws, gw, NGW, lane); }
    GRID_BAR(); PROBE_AT(__COUNTER__ - PROBE_C0);
#ifdef PROBE_CHECK
    { PHASE_ENV(); for (int s_ = gw; s_ < 2048; s_ += NGW) chk_kidx(ap, ws, s_, lane, ap->f0, ap->f1, ap->f2, ap->f3, ap->f4, ap->f5, ap->f6, ap->f7); }
#endif
    for (int rep_ = 0; rep_ < NREP(11); ++rep_) {   PHASE_ENV();
        for (int v = vcu; v < 256; v += G)
#ifndef SKIP_IDX
            for (int j = 0; j < 8; ++j) { const int R = (j >> 1) * 512 + ((j & 1) ? 511 - v : v); if (rep_ == 0 && NREP(11) == 2) dsa_index_unit<PROBE_VAR>(ws, lds, R & 1, (R >> 1) * 8, wave, lane, tid); else dsa_index_unit<0>(ws, lds, R & 1, (R >> 1) * 8, wave, lane, tid); }
#endif
            ;
    }
    GRID_BAR(); PROBE_AT(__COUNTER__ - PROBE_C0);
#ifdef PROBE_CHECK
    { PHASE_ENV(); chk_copy((const bf16*)(ws + WS_QO), (bf16*)(ws + WS_HB), vcu * 512 + tid, G * 512); }
    GRID_BAR();
#endif
    for (int rep_ = 0; rep_ < NREP(12); ++rep_) {   PHASE_ENV();
        using attn_body::bf16;
        for (int p = vcu; p < 256; p += G) { const int bh = p >> 3, s = p & 7, b = bh >> 4, h = bh & 15;
            bf16* Qh = (bf16*)(ws + WS_QO) + (size_t)b * SEQ * 1024 + h * 64; const bf16* Kh = (const bf16*)(ws + WS_KC) + (size_t)b * SEQ * 1024 + h * 64;
            const bf16* Vh = (const bf16*)(ws + WS_VC) + (size_t)b * SEQ * 1024 + h * 64; const unsigned long long* mk = (const unsigned long long*)(ws + WS_MASK) + (size_t)b * SEQ * 128;
#ifndef SKIP_DSA
            for (int i = 0; i < 4; ++i) { const int qb = (i == 0) ? s : (i == 1) ? 15 - s : (i == 2) ? 16 + s : 31 - s; attn_body::attn_unit<1, 8, 1024, 1024>(qb, Qh, Kh, Vh, (rep_ == 0 && NREP(12) == 2) ? (bf16*)(ws + WS_HB) + (size_t)b * SEQ * 1024 + h * 64 : Qh, nullptr, nullptr, mk, (char*)lds_raw); }
#endif
        }
    }
    GRID_BAR(); PROBE_AT(__COUNTER__ - PROBE_C0);
#ifdef PROBE_CHECK
    { PHASE_ENV(); LAS float* Lw = (LAS float*)lds + wave * 1152;
      for (int s_ = gw; s_ < 2048; s_ += NGW) { chk_mask(ws, Lw, s_, lane); chk_dsa(ws, (const bf16*)(ws + WS_HB), Lw, s_, lane); } }
    GRID_BAR();
#endif
    for (int rep_ = 0; rep_ < NREP(13); ++rep_) {   PHASE_ENV();
        pg8::Gemm g{(const pg8::bf16_t*)(ws + WS_QO), (const pg8::bf16_t*)(ws + WS_W_OUT1), MROWS, 1024, 1024}; pg8::StaticOrder S; S.init(MROWS, 1024, G, bx);
        epi::EpiResid E{HBB, ROWSS2};
        pg8::gemm_phase<epi::EpiResid, pg8::StaticOrder, PG8_ALIGN1, PG8_SP2>(lds, g, S, E);
    }
    GRID_BAR(); PROBE_AT(__COUNTER__ - PROBE_C0);
    FFN_PLE(WS_W_GU1, WS_W_DN1, WS_W_PG1, WS_W_PP1, (size_t)MROWS * 256, HBB, HBA, ROWSS2, ROWSS)
    for (int rep_ = 0; rep_ < NREP(14); ++rep_) { PHASE_ENV(); final_norm(ap, ws, gw, NGW, lane); }
#ifdef PROBE_CHECK
    GRID_BAR();
    { PHASE_ENV(); const unsigned fl = __hip_atomic_load((unsigned*)(ws + CHK_FLAGS), __ATOMIC_RELAXED, __HIP_MEMORY_SCOPE_AGENT); const float cf = 1.f + (float)fl;
      for (size_t i = (size_t)bx * 512 + tid; i < (size_t)MROWS * 1024 / 4; i += (size_t)G * 512) ((f32x4*)OUT)[i] = (f32x4){cf, cf, cf, cf}; }
#endif
#ifdef PROBE_TIME
    GRID_BAR();
    { PHASE_ENV();
      if (bx == 0 && tid == 0) { const unsigned long long t0 = *(unsigned long long*)(ws + 512 * 1024); const unsigned long long el = (__builtin_amdgcn_s_memrealtime() - t0) / 100ull;
          unsigned c = 1; unsigned long long e = el >> 7; while (e) { ++c; e >>= 1; }
          const unsigned tmo = __hip_atomic_load((unsigned*)(ctl + CW_BAR) + XB_TMO, __ATOMIC_RELAXED, __HIP_MEMORY_SCOPE_AGENT);
          if (tmo) c += 16;
          __hip_atomic_store((unsigned*)(ws + 512 * 1024 + 64), c, __ATOMIC_RELAXED, __HIP_MEMORY_SCOPE_AGENT); }
    }
    GRID_BAR();
    { PHASE_ENV(); const unsigned c = __hip_atomic_load((unsigned*)(ws + 512 * 1024 + 64), __ATOMIC_RELAXED, __HIP_MEMORY_SCOPE_AGENT); const float cf = (float)c;
      for (size_t i = (size_t)bx * 512 + tid; i < (size_t)MROWS * 1024 / 4; i += (size_t)G * 512) ((f32x4*)OUT)[i] = (f32x4){cf, cf, cf, cf}; }
#endif
#undef FFN_PLE
#undef GRID_BAR
#undef PHASE_ENV
}

extern "C" void kernel_launch(void* const* d_in, const int* in_sizes, int n_in, void* d_out, int out_size, void* d_ws, size_t ws_size, hipStream_t stream) {
    static int grid = 0;
    if (grid == 0) {
        if (n_in != 22 || out_size != MROWS * DMODEL || ws_size < WS_END) { fprintf(stderr, "kernel_launch: unexpected problem (n_in %d, out %d, ws %zu); nothing launched\n", n_in, out_size, ws_size); grid = -1; return; }
        int dev = 0, cus = 0, per_cu = 0;
        if (hipGetDevice(&dev) != hipSuccess || hipDeviceGetAttribute(&cus, hipDeviceAttributeMultiprocessorCount, dev) != hipSuccess) { grid = -1; return; }
        if (hipFuncSetAttribute((const void*)trunk_fwd, hipFuncAttributeMaxDynamicSharedMemorySize, LDS_BYTES) != hipSuccess) { fprintf(stderr, "kernel_launch: hipFuncSetAttribute failed\n"); grid = -1; return; }
        if (hipOccupancyMaxActiveBlocksPerMultiprocessor(&per_cu, (const void*)trunk_fwd, NWAVES * 64, LDS_BYTES) != hipSuccess || per_cu < 1) { fprintf(stderr, "kernel_launch: occupancy query says %d blocks per CU\n", per_cu); per_cu = 1; }
        (void)hipGetLastError();
        grid = cus;
    }
    if (grid < 0) return;
    if (hipMemsetAsync((char*)d_ws + WS_CTL, 0, CTL_ZERO_BYTES, stream) != hipSuccess) { fprintf(stderr, "kernel_launch: memset failed\n"); return; }
    Args a{};
    for (int i = 0; i < 22; ++i) a.in[i] = (const float*)d_in[i];
    a.out = (float*)d_out; a.ws = (unsigned char*)d_ws;
    float f[8]; for (int i = 0; i < 8; ++i) f[i] = powf(500000.0f, -(float)(2 * i) / 16.0f);
    a.f0 = f[0]; a.f1 = f[1]; a.f2 = f[2]; a.f3 = f[3]; a.f4 = f[4]; a.f5 = f[5]; a.f6 = f[6]; a.f7 = f[7];
    hipLaunchKernelGGL(trunk_fwd, dim3(grid), dim3(NWAVES * 64), LDS_BYTES, stream, a);
    const hipError_t le = hipPeekAtLastError();
    if (le != hipSuccess) fprintf(stderr, "kernel_launch: launch failed: %s\n", hipGetErrorName(le));
}
```

```cpp
#include <hip/hip_runtime.h>
#include <cstdio>
#include <cstdint>
namespace pg8 {
#define PG8_LAS __attribute__((address_space(3)))
typedef unsigned short bf16_t;
typedef short bf16x8 __attribute__((ext_vector_type(8)));
typedef float f32x4 __attribute__((ext_vector_type(4)));
typedef unsigned u32x4 __attribute__((ext_vector_type(4)));
constexpr int BM = 256, BK = 64, HALF = 128, HTB = HALF * BK * 2  , STAGE_BYTES = 8 * HTB, NXCD = 8, WGM = 8;

__host__ __device__ __forceinline__ int lds_byte(int r, int c) { const int st = (r >> 4) * 2 + (c >> 5), rr = r & 15, cc = c & 31, ob = rr * 64 + cc * 2; return st * 1024 + (ob ^ (((ob >> 9) & 1) << 5)); }
__host__ __device__ __forceinline__ void stage_rc(int b, int& R, int& C) { const int st = b / 1024, sb = b % 1024, swz = sb ^ (((sb >> 9) & 1) << 5); R = (st >> 1) * 16 + swz / 64; C = (st & 1) * 32 + (swz % 64) / 2; }
__host__ __device__ __forceinline__ int perm32(int rho) { const int n = rho >> 4, i = rho & 15; return 8 * (i >> 2) + 4 * n + (i & 3); }

struct Unit { int pm, pn; };
struct Gemm { const bf16_t* A; const bf16_t* Bt; int M, N, K; };

struct StaticOrder {
    int nM, nN, nwg, G, c;
    __host__ __device__ void init(int M, int N, int G_, int c_) { nM = M / BM; nN = N / BM; nwg = nM * nN; G = G_; c = c_; }
    __host__ __device__ bool next(int i, Unit& u) const {
        const long L = (long)i * G + c; if (L >= nwg) return false;
        int wgid = (int)L; { const int q = nwg / NXCD, r = nwg % NXCD, xcd = wgid % NXCD, off = wgid / NXCD; wgid = (xcd < r ? xcd * (q + 1) : r * (q + 1) + (xcd - r) * q) + off; }
        const int nig = WGM * nN, gid = wgid / nig, fm = gid * WGM, gsz = (nM - fm) < WGM ? (nM - fm) : WGM;
        u.pm = fm + ((wgid % nig) % gsz); u.pn = (wgid % nig) / gsz; return true;
    }
    __device__ __forceinline__ void a_ready(const Unit&) const {}
    __device__ __forceinline__ void done(const Unit&) const {}
};
__device__ __forceinline__ unsigned cvt_pk_bf16(float lo, float hi) { unsigned r; asm volatile("v_cvt_pk_bf16_f32 %0, %1, %2" : "=v"(r) : "v"(lo), "v"(hi)); return r; }
typedef float f32x2 __attribute__((ext_vector_type(2)));
__device__ __forceinline__ f32x2 gelu_pk(f32x2 v) {
    const f32x2 av = __builtin_elementwise_abs(v), d = av * 0.2316418882f + 1.0f;
    f32x2 t; t.x = __builtin_amdgcn_rcpf(d.x); t.y = __builtin_amdgcn_rcpf(d.y);
    f32x2 q = t * 0.5307027145f + (-0.7265760135f); q = q * t + 0.7107068705f; q = q * t + (-0.142248368f); q = q * t + 0.127414796f; q = q * t;
    const f32x2 s = (v * v) * (-0.72134752044f);
    f32x2 e; e.x = __builtin_amdgcn_exp2f(s.x); e.y = __builtin_amdgcn_exp2f(s.y);
    const f32x2 m = v * (q * e), r = v - m;
    f32x2 o; o.x = v.x < 0.f ? m.x : r.x; o.y = v.y < 0.f ? m.y : r.y; return o;
}
template <class Epi, class Sched, bool ALIGN_EPI = false, bool SP2 = false>
__device__ __forceinline__ void gemm_phase(PG8_LAS unsigned char* lds, const Gemm g, const Sched& S, const Epi& E) {
    int tid_l = threadIdx.x; asm volatile("" : "+v"(tid_l)); const int tid = tid_l, wid = __builtin_amdgcn_readfirstlane(tid >> 6), lane = tid & 63, wr = wid >> 2, wc = wid & 3, fr = lane & 15, fq = lane >> 4;
    const int K = g.K, nt = K / BK;
    unsigned voffA[2], voffB[2];
#pragma unroll
    for (int i = 0; i < 2; ++i) { int R, C; stage_rc(tid * 16 + i * 8192, R, C); const int Rb = Epi::PERM ? ((R & ~31) + perm32(R & 31)) : R;
        voffA[i] = (unsigned)(R * K + C) * 2u; voffB[i] = (unsigned)(Rb * K + C) * 2u; }
    const size_t kstep = (size_t)(BK * 2);
    const size_t hstep = (size_t)HALF * K * 2;
    const size_t tstep = 2 * hstep;
    const unsigned ldsw = (unsigned)wid * 1024u;
    const int aoff = lds_byte(wr * 64 + fr, fq * 8), boff = lds_byte(wc * 32 + fr, fq * 8);
#define PG8_SA(b, h) (((b) * 2 + (h)) * HTB)
#define PG8_SB(b, h) ((4 + (b) * 2 + (h)) * HTB)
#define PG8_STAGE(bufoff, gbase, voff) do { _Pragma("unroll") for (int _i = 0; _i < 2; ++_i) \
        __builtin_amdgcn_global_load_lds((const unsigned*)((const char*)(gbase) + (voff)[_i]), (PG8_LAS unsigned*)(lds + (bufoff) + ldsw + _i * 8192), 16, 0, 0); } while (0)
#define PG8_LDA(dst, b, h) do { _Pragma("unroll") for (int m = 0; m < 4; ++m) _Pragma("unroll") for (int k = 0; k < 2; ++k) dst[m][k] = *(const PG8_LAS bf16x8*)(lds + PG8_SA(b, h) + aoff + m * 2048 + k * 1024); } while (0)
#define PG8_LDB(dst, b, h) do { _Pragma("unroll") for (int n = 0; n < 2; ++n) _Pragma("unroll") for (int k = 0; k < 2; ++k) dst[n][k] = *(const PG8_LAS bf16x8*)(lds + PG8_SB(b, h) + boff + n * 2048 + k * 1024); } while (0)
#define PG8_MMA(ai, bj, At, Bt) do { __builtin_amdgcn_s_setprio(1); _Pragma("unroll") for (int m = 0; m < 4; ++m) _Pragma("unroll") for (int n = 0; n < 2; ++n) _Pragma("unroll") for (int k = 0; k < 2; ++k) \
        acc[ai][bj][m][n] = __builtin_amdgcn_mfma_f32_16x16x32_bf16(Bt[n][k], At[m][k], acc[ai][bj][m][n], 0, 0, 0); __builtin_amdgcn_s_setprio(0); } while (0)
#define PG8_WAIT_V(n) asm volatile("s_waitcnt vmcnt(" #n ")" ::: "memory")
#define PG8_WAIT_L(n) asm volatile("s_waitcnt lgkmcnt(" #n ")" ::: "memory")
#define PG8_BAR __builtin_amdgcn_s_barrier()
#define PG8_SCHED __builtin_amdgcn_sched_barrier(0)
    Unit cur, nxt; int ui = 0;
    if (!S.next(0, cur)) return;
    f32x4 acc[2][2][4][2];
#pragma unroll
    for (int a = 0; a < 2; ++a)
#pragma unroll
        for (int b = 0; b < 2; ++b)
#pragma unroll
            for (int m = 0; m < 4; ++m)
#pragma unroll
                for (int n = 0; n < 2; ++n) acc[a][b][m][n] = (f32x4){0.f, 0.f, 0.f, 0.f};
    bf16x8 At[4][2], B0[2][2], B1[2][2];
    const char* cA = (const char*)g.A + (size_t)cur.pm * tstep; const char* cB = (const char*)g.Bt + (size_t)cur.pn * tstep;
    S.a_ready(cur);
    if constexpr (SP2) {
        PG8_STAGE(PG8_SB(0, 0), cB, voffB); PG8_STAGE(PG8_SB(0, 1), cB + hstep, voffB); PG8_STAGE(PG8_SA(0, 0), cA, voffA); PG8_STAGE(PG8_SA(0, 1), cA + hstep, voffA);
        if (wr == 1) PG8_BAR;
        PG8_WAIT_V(2); PG8_BAR;
        PG8_STAGE(PG8_SB(1, 0), cB + kstep, voffB); PG8_STAGE(PG8_SA(1, 0), cA + kstep, voffA); PG8_STAGE(PG8_SB(1, 1), cB + hstep + kstep, voffB);
        PG8_WAIT_V(6); PG8_BAR;
    } else {
        PG8_STAGE(PG8_SB(0, 0), cB, voffB); PG8_STAGE(PG8_SA(0, 0), cA, voffA); PG8_STAGE(PG8_SB(0, 1), cB + hstep, voffB); PG8_STAGE(PG8_SA(0, 1), cA + hstep, voffA);
        if (wr == 1) PG8_BAR;
        PG8_WAIT_V(4); PG8_BAR;
        PG8_STAGE(PG8_SB(1, 0), cB + kstep, voffB); PG8_STAGE(PG8_SA(1, 0), cA + kstep, voffA); PG8_STAGE(PG8_SB(1, 1), cB + hstep + kstep, voffB);
        PG8_WAIT_V(6); PG8_BAR;
    }
    for (;;) {
        const bool has_next = S.next(ui + 1, nxt);
        const char* nA = has_next ? (const char*)g.A + (size_t)nxt.pm * tstep : cA; const char* nB = has_next ? (const char*)g.Bt + (size_t)nxt.pn * tstep : cB;
        for (int t = 0; t < nt; t += 2) {
            const bool last = (t == nt - 2);
            const char* a1 = cA + (size_t)(t + 1) * kstep;
            const char* a2 = last ? nA : cA + (size_t)(t + 2) * kstep; const char* b2 = last ? nB : cB + (size_t)(t + 2) * kstep;
            const char* a3 = a2 + kstep; const char* b3 = b2 + kstep;
            if (last && has_next) S.a_ready(nxt);
            if constexpr (SP2) {
            PG8_LDB(B0, 0, 0); PG8_LDB(B1, 0, 1); PG8_SCHED; PG8_LDA(At, 0, 0); PG8_STAGE(PG8_SA(1, 1), a1 + hstep, voffA);
            PG8_WAIT_V(8); PG8_WAIT_L(0); PG8_BAR; PG8_MMA(0, 0, At, B0); PG8_MMA(0, 1, At, B1); PG8_BAR; PG8_SCHED;
            PG8_LDA(At, 0, 1); PG8_STAGE(PG8_SB(0, 0), b2, voffB); PG8_STAGE(PG8_SB(0, 1), b2 + hstep, voffB); PG8_STAGE(PG8_SA(0, 0), a2, voffA);
            PG8_WAIT_V(8); PG8_WAIT_L(0); PG8_BAR; PG8_MMA(1, 0, At, B0); PG8_MMA(1, 1, At, B1); PG8_BAR; PG8_SCHED;
            PG8_LDB(B0, 1, 0); PG8_LDB(B1, 1, 1); PG8_SCHED; PG8_LDA(At, 1, 0); PG8_STAGE(PG8_SA(0, 1), a2 + hstep, voffA);
            PG8_WAIT_V(8); PG8_WAIT_L(0); PG8_BAR; PG8_MMA(0, 0, At, B0); PG8_MMA(0, 1, At, B1); PG8_BAR; PG8_SCHED;
            PG8_LDA(At, 1, 1); PG8_STAGE(PG8_SB(1, 0), b3, voffB); PG8_STAGE(PG8_SB(1, 1), b3 + hstep, voffB); PG8_STAGE(PG8_SA(1, 0), a3, voffA);
            PG8_WAIT_V(8); PG8_WAIT_L(0); PG8_BAR; PG8_MMA(1, 0, At, B0); PG8_MMA(1, 1, At, B1); PG8_BAR; PG8_SCHED;
            } else {
            PG8_LDB(B0, 0, 0); PG8_SCHED; PG8_LDA(At, 0, 0); PG8_STAGE(PG8_SA(1, 1), a1 + hstep, voffA);
            PG8_WAIT_L(8); PG8_BAR; PG8_WAIT_L(0); PG8_MMA(0, 0, At, B0); PG8_BAR; PG8_SCHED;
            PG8_LDB(B1, 0, 1); PG8_STAGE(PG8_SB(0, 0), b2, voffB);
            PG8_BAR; PG8_WAIT_L(0); PG8_MMA(0, 1, At, B1); PG8_BAR;
            PG8_LDA(At, 0, 1); PG8_STAGE(PG8_SA(0, 0), a2, voffA);
            PG8_BAR; PG8_WAIT_L(0); PG8_MMA(1, 0, At, B0); PG8_BAR; PG8_SCHED;
            PG8_STAGE(PG8_SB(0, 1), b2 + hstep, voffB);
            PG8_WAIT_V(6); PG8_BAR; PG8_MMA(1, 1, At, B1); PG8_BAR;
            PG8_LDB(B0, 1, 0); PG8_SCHED; PG8_LDA(At, 1, 0); PG8_STAGE(PG8_SA(0, 1), a2 + hstep, voffA);
            PG8_WAIT_L(8); PG8_BAR; PG8_WAIT_L(0); PG8_MMA(0, 0, At, B0); PG8_BAR; PG8_SCHED;
            PG8_LDB(B1, 1, 1); PG8_STAGE(PG8_SB(1, 0), b3, voffB);
            PG8_BAR; PG8_WAIT_L(0); PG8_MMA(0, 1, At, B1); PG8_BAR;
            PG8_LDA(At, 1, 1); PG8_STAGE(PG8_SA(1, 0), a3, voffA);
            PG8_BAR; PG8_WAIT_L(0); PG8_MMA(1, 0, At, B0); PG8_BAR; PG8_SCHED;
            PG8_STAGE(PG8_SB(1, 1), b3 + hstep, voffB);
            PG8_WAIT_V(6); PG8_BAR; PG8_MMA(1, 1, At, B1); PG8_BAR;
            }
        }
        if constexpr (ALIGN_EPI) { if (wr == 0) PG8_BAR; }
        if constexpr (!Epi::AFTER_DRAIN) { E(acc, cur, wr, wc, fr, fq); S.done(cur); }
        if (!has_next) break;
#pragma unroll
        for (int a = 0; a < 2; ++a)
#pragma unroll
            for (int b = 0; b < 2; ++b)
#pragma unroll
                for (int m = 0; m < 4; ++m)
#pragma unroll
                    for (int n = 0; n < 2; ++n) acc[a][b][m][n] = (f32x4){0.f, 0.f, 0.f, 0.f};
        cur = nxt; cA = nA; cB = nB; ++ui;
        if constexpr (ALIGN_EPI) { if (wr == 1) PG8_BAR; }
    }
    PG8_WAIT_V(0);
    if constexpr (!ALIGN_EPI) { if (wr == 0) PG8_BAR; }
    PG8_BAR;
    if constexpr (Epi::AFTER_DRAIN) { E.fused(acc, cur, wr, wc, fr, fq, lds, wid, lane); S.done(cur); }
#undef PG8_SA
#undef PG8_SB
#undef PG8_STAGE
#undef PG8_LDA
#undef PG8_LDB
#undef PG8_MMA
#undef PG8_WAIT_V
#undef PG8_WAIT_L
#undef PG8_BAR
#undef PG8_SCHED
}
}
#ifndef PG8_SP2
#define PG8_SP2 true
#endif
#ifndef PG8_ALIGN
#define PG8_ALIGN true
#endif
#include <hip/hip_bf16.h>
#include <cmath>
namespace attn_body {
using bf16=__hip_bfloat16;
using bf16x8=__attribute__((ext_vector_type(8)))short;
using s16x4=__attribute__((ext_vector_type(4)))short;
using f32x16=__attribute__((ext_vector_type(16)))float;
using u32x4=__attribute__((ext_vector_type(4)))unsigned;
constexpr int SEQ=8192,D=64;
constexpr int NW=8,QBLK=32,QB=QBLK*NW,KVBLK=64,NQB=SEQ/QB;
constexpr int ATTN_UNIT_ROWS=QB;
__device__ __forceinline__ int crow(int r,int hi){return (r&3)+8*(r>>2)+4*hi;}
#define SBAR() __builtin_amdgcn_sched_barrier(0)
__device__ __forceinline__ void cmask(f32x16&p0,f32x16&p1,int jb,int qrel,int hi){
  const float NEG=-INFINITY; int kb=64*jb+4*hi;
  #pragma unroll
  for(int r=0;r<16;++r){int kv=kb+(r&3)+8*(r>>2); if(kv>qrel)p0[r]=NEG; if(kv+32>qrel)p1[r]=NEG;}
}

constexpr int SEL_OFF=86016;
template<int MODE,bool BAND> __device__ __forceinline__ void apply_mask(f32x16&p0,f32x16&p1,int t,int NT,int qrel,int hi,unsigned selmask,unsigned long long mw,float mhat){
  const float NEG=-INFINITY;
  if(MODE==0&&!BAND){
    const float sub=(((selmask>>(t>>2))&1u)!=0u)?mhat:INFINITY;
    #pragma unroll
    for(int r=0;r<16;++r){ p0[r]-=sub; p1[r]-=sub; }
    return;
  }
  if(MODE==0){
    const int jb=t-(NT-4);
    if(BAND&&jb>=0){ const int dq=qrel-64*jb; mw=(dq>=63)?~0ull:((dq<0)?0ull:((2ull<<dq)-1ull)); }
    else mw=(((selmask>>(t>>2))&1u)!=0u)?~0ull:0ull;
  }
  if(MODE==1){
    unsigned t0=(((unsigned)mw)>>(4*hi))<<4, t1=(((unsigned)(mw>>32))>>(4*hi))<<4; const float neg=NEG;
    asm volatile("s_nop 15\n\ts_nop 3":"+v"(p0),"+v"(p1));
    #pragma unroll
    for(int g=3;g>=0;--g){
      #pragma unroll
      for(int e=3;e>=0;--e){ const int r=4*g+e;
        asm volatile("v_add_co_u32 %0, vcc, %0, %0\n\tv_cndmask_b32 %1, %2, %1, vcc":"+v"(t0),"+v"(p0[r]):"v"(neg):"vcc");
        asm volatile("v_add_co_u32 %0, vcc, %0, %0\n\tv_cndmask_b32 %1, %2, %1, vcc":"+v"(t1),"+v"(p1[r]):"v"(neg):"vcc"); }
      t0<<=4; t1<<=4; }
    return;
  }
  {
    const unsigned lo=((unsigned)mw)>>(4*hi), hw=((unsigned)(mw>>32))>>(4*hi);
    #pragma unroll
    for(int r=0;r<16;++r){ const int bt=(r&3)+8*(r>>2); p0[r]=((lo>>bt)&1u)?(p0[r]-mhat):NEG; p1[r]=((hw>>bt)&1u)?(p1[r]-mhat):NEG; }
  }
}
constexpr int NSLOT=3, SLOTB=8192;
constexpr int LDS_K=0, LDS_V=NSLOT*SLOTB, LDS_WS=2*NSLOT*SLOTB, LDS_OST=LDS_WS+NW*64*4, LDS_BYTES=LDS_OST+NW*4096;
constexpr float C2=0.125f*1.4426950408889634f;
__device__ __forceinline__ void glds16(const void*gsrc,unsigned lds_dst){unsigned keep;
  asm volatile("s_mov_b32 %0, m0\n\ts_mov_b32 m0, %2\n\ts_nop 0\n\tglobal_load_lds_dwordx4 %1, off\n\ts_mov_b32 m0, %0":"=&s"(keep):"v"(gsrc),"s"(lds_dst):"memory");}
__device__ __forceinline__ float max3f(float a,float b,float c){float r;asm("v_max3_f32 %0, %1, %2, %3":"=v"(r):"v"(a),"v"(b),"v"(c));return r;}
__device__ __forceinline__ float max2f(float a,float b){float r;asm("v_max_f32_e32 %0, %1, %2":"=v"(r):"v"(a),"v"(b));return r;}
__device__ __forceinline__ float fadd_s(float a,float b){float r;asm("v_add_f32_e32 %0, %1, %2":"=v"(r):"v"(a),"v"(b));return r;}
__device__ __forceinline__ float fsub_s(float a,float b){float r;asm("v_sub_f32_e32 %0, %1, %2":"=v"(r):"v"(a),"v"(b));return r;}
typedef float f32x2_t __attribute__((ext_vector_type(2))); typedef __bf16 bf16x2_t __attribute__((ext_vector_type(2)));
__device__ __forceinline__ unsigned cvtpk_s(float lo,float hi){f32x2_t v={lo,hi};bf16x2_t b=__builtin_convertvector(v,bf16x2_t);return __builtin_bit_cast(unsigned,b);}
#define WAIT_BAR(N) asm volatile("s_waitcnt vmcnt(" #N ") lgkmcnt(0)\n\ts_barrier":::"memory")

__device__ __forceinline__ void qkt(f32x16&p0,f32x16&p1,const char*Kslot,const bf16x8*qr,const f32x16&negm,int r32,int hi){
  const char*kb=Kslot+hi*1024+r32*16;
  #pragma unroll
  for(int d0=0;d0<4;++d0){
    const bf16x8 b0=*reinterpret_cast<const bf16x8*>(kb+d0*2048);
    const bf16x8 b1=*reinterpret_cast<const bf16x8*>(kb+d0*2048+512);
    if(d0==0){p0=__builtin_amdgcn_mfma_f32_32x32x16_bf16(b0,qr[0],negm,0,0,0);p1=__builtin_amdgcn_mfma_f32_32x32x16_bf16(b1,qr[0],negm,0,0,0);}
    else{p0=__builtin_amdgcn_mfma_f32_32x32x16_bf16(b0,qr[d0],p0,0,0,0);p1=__builtin_amdgcn_mfma_f32_32x32x16_bf16(b1,qr[d0],p1,0,0,0);}}
}
typedef __attribute__((address_space(3))) const char* lds_cptr;
typedef short v4i16_t __attribute__((ext_vector_type(4)));
__device__ __forceinline__ void kload8(bf16x8*kf,lds_cptr kp){
  kf[0]=*(const __attribute__((address_space(3))) bf16x8*)(kp);      kf[1]=*(const __attribute__((address_space(3))) bf16x8*)(kp+512);
  kf[2]=*(const __attribute__((address_space(3))) bf16x8*)(kp+2048); kf[3]=*(const __attribute__((address_space(3))) bf16x8*)(kp+2560);
  kf[4]=*(const __attribute__((address_space(3))) bf16x8*)(kp+4096); kf[5]=*(const __attribute__((address_space(3))) bf16x8*)(kp+4608);
  kf[6]=*(const __attribute__((address_space(3))) bf16x8*)(kp+6144); kf[7]=*(const __attribute__((address_space(3))) bf16x8*)(kp+6656);
}
__device__ __forceinline__ void kload2(bf16x8*kf,lds_cptr kp,int j){ kf[2*j]=*(const __attribute__((address_space(3))) bf16x8*)(kp+j*2048); kf[2*j+1]=*(const __attribute__((address_space(3))) bf16x8*)(kp+j*2048+512); }
__device__ __forceinline__ s16x4 vtr(lds_cptr p){ return __builtin_bit_cast(s16x4,__builtin_amdgcn_ds_read_tr16_b64_v4i16((__attribute__((address_space(3))) v4i16_t*)p)); }
__device__ __forceinline__ float rowmax(const f32x16&p0,const f32x16&p1){
  float a=max3f(p0[0],p0[1],p1[0]),b=max3f(p0[2],p0[3],p1[1]);a=max3f(a,p1[2],p1[3]);
  #pragma unroll
  for(int r=4;r<16;r+=4){a=max3f(a,p0[r],p0[r+1]);b=max3f(b,p0[r+2],p0[r+3]);a=max3f(a,p1[r],p1[r+1]);b=max3f(b,p1[r+2],p1[r+3]);}
  const float m=max2f(a,b);
  auto rr=__builtin_amdgcn_permlane32_swap(__float_as_uint(m),__float_as_uint(m),false,false);
  return max2f(__uint_as_float(rr[0]),__uint_as_float(rr[1]));
}
__device__ __forceinline__ void pv(f32x16*o,int vb,bf16x8 pa0,bf16x8 pa1,bf16x8 pa2,bf16x8 pa3){
  #pragma unroll
  for(int d0=0;d0<2;++d0){s16x4 lo[4],hi[4];
    #pragma unroll
    for(int ks=0;ks<4;++ks){
      asm volatile("ds_read_b64_tr_b16 %0,%1 offset:%c2":"=&v"(lo[ks]):"v"(vb),"i"(d0*4096+ks*1024):"memory");
      asm volatile("ds_read_b64_tr_b16 %0,%1 offset:%c2":"=&v"(hi[ks]):"v"(vb),"i"(d0*4096+ks*1024+512):"memory");}
    asm volatile("s_waitcnt lgkmcnt(0)":::"memory");SBAR();
    #define PK(k) (bf16x8){lo[k][0],lo[k][1],lo[k][2],lo[k][3],hi[k][0],hi[k][1],hi[k][2],hi[k][3]}
    o[d0]=__builtin_amdgcn_mfma_f32_32x32x16_bf16(pa0,PK(0),o[d0],0,0,0);
    o[d0]=__builtin_amdgcn_mfma_f32_32x32x16_bf16(pa1,PK(1),o[d0],0,0,0);
    o[d0]=__builtin_amdgcn_mfma_f32_32x32x16_bf16(pa2,PK(2),o[d0],0,0,0);
    o[d0]=__builtin_amdgcn_mfma_f32_32x32x16_bf16(pa3,PK(3),o[d0],0,0,0);
    #undef PK
  }
}

#ifndef ATTN_STORE16
#define ATTN_STORE16(p,v) (*(u32x4*)(p)=(v))
#endif
template<int MODE,int THRL,int QP,int KP> __device__ __forceinline__ void attn_unit(int qb,const bf16*Qh,const bf16*__restrict__ Kh,const bf16*__restrict__ Vh,bf16*Oh,const bf16*__restrict__ kmh,const bf16*__restrict__ kml,const unsigned long long*__restrict__ maskb,char*shm){
  int tid_l=threadIdx.x; asm volatile("":"+v"(tid_l)); const int tid=tid_l,lane=tid&63,r32=lane&31,hi=lane>>5; const int wid=__builtin_amdgcn_readfirstlane(tid>>6);
  const int q0=qb*QB;
  const bf16*Qw=Qh+(long)(q0+wid*QBLK)*QP;
  const unsigned lds0=(unsigned)(uintptr_t)shm;
  float*wsf=(float*)(shm+LDS_WS)+wid*64;
  const bf16*ksrc=Kh+(long)lane*KP+wid*8;
  const bf16*vsrc=Vh+(long)(16*(wid&3)+(lane>>2))*KP+(wid>>2)*32+(lane&3)*8;
  const unsigned kdst=lds0+LDS_K+wid*1024, vdst=lds0+LDS_V+wid*1024;
  #define DMA_K(t,slot) glds16(ksrc+(long)(t)*KVBLK*KP,(unsigned)__builtin_amdgcn_readfirstlane(kdst+(slot)))
  #define DMA_V(t,slot) glds16(vsrc+(long)(t)*KVBLK*KP,(unsigned)__builtin_amdgcn_readfirstlane(vdst+(slot)))
  const int vb0=(int)(lds0+LDS_V)+((lane>>4)&1)*32+(lane&3)*8+(4*hi+((lane&15)>>2))*64;
  const char*Kbase=shm+LDS_K; bf16x8 kf[8];
  const lds_cptr shm3=(lds_cptr)shm; const lds_cptr kp0=shm3+LDS_K+hi*1024+r32*16; const lds_cptr vp0=shm3+LDS_V+((lane>>4)&1)*32+(lane&3)*8+(4*hi+((lane&15)>>2))*64;
  const int NT=(q0+QB)/KVBLK;
  DMA_K(0,0);DMA_V(0,0);DMA_K(1,SLOTB);
  bf16x8 qr[4];
  #pragma unroll
  for(int d0=0;d0<4;++d0)qr[d0]=*reinterpret_cast<const bf16x8*>(&Qw[(long)r32*QP+d0*16+hi*8]);
  unsigned selmask=0u; unsigned long long mw0=0ull,mw_c=0ull,mw_n=0ull; const unsigned long long*mq=maskb;
  if(MODE==1){ mq=maskb+(long)(q0+wid*QBLK+r32)*128; mw0=mq[0]; mw_c=mq[1]; }
  if(MODE==0){ selmask=((const unsigned*)(shm+SEL_OFF))[wid*QBLK+r32]; }
  float mhat=0.f,l_reg=0.f;f32x16 o[2];o[0]=f32x16{};o[1]=f32x16{};f32x16 negm=f32x16{}; if(MODE==1){asm volatile("":"+v"(negm));} const f32x16 zero16=f32x16{};
  const int qrel=wid*QBLK+r32;
  #define CMASK(P0,P1,t) apply_mask<MODE,true>(P0,P1,(t),NT,qrel,hi,selmask,mw_c,mhat)
  bool resc=false;
  #define START(P0,P1) do{ const float rm=rowmax(P0,P1); resc=false; \
    { const float dl=(rm>-1e30f)?rm:0.f; mhat=fadd_s(mhat,dl); \
      _Pragma("unroll") for(int r=0;r<16;++r){P0[r]=fsub_s(P0[r],dl);P1[r]=fsub_s(P1[r],dl);} \
      if(MODE==1){ _Pragma("unroll") for(int r=0;r<16;++r)negm[r]=-mhat; asm volatile("":"+v"(negm)); } } \
    _Pragma("unroll") for(int r=0;r<16;++r)P0[r]=__builtin_amdgcn_exp2f(P0[r]); }while(0)
  #define RESC() do{ if(resc){ asm volatile("s_waitcnt lgkmcnt(0)":::"memory"); \
      _Pragma("unroll") for(int d_=0;d_<2;++d_) _Pragma("unroll") for(int r=0;r<16;++r)o[d_][r]*=wsf[crow(r,hi)]; } }while(0)
  f32x16 pA0,pA1,pB0,pB1;
  int sl_prev=0,sl_cur=0,sl_next=SLOTB;
  #define ROT() do{sl_prev=sl_cur;sl_cur=sl_next;sl_next=(sl_next==(NSLOT-1)*SLOTB)?0:sl_next+SLOTB;}while(0)
  DMA_K(2,2*SLOTB);
  WAIT_BAR(3);
  qkt(pA0,pA1,Kbase,qr,(MODE==1?negm:zero16),r32,hi);asm volatile("s_nop 15\n\ts_nop 7":"+v"(pA0),"+v"(pA1));apply_mask<MODE,true>(pA0,pA1,0,NT,qrel,hi,selmask,mw0,0.f);
  START(pA0,pA1);
  _Pragma("unroll") for(int r=0;r<16;++r)pA1[r]=__builtin_amdgcn_exp2f(pA1[r]);
  WAIT_BAR(0);
  DMA_K(3,0);DMA_V(1,SLOTB);
  ROT();
  kload8(kf,kp0+sl_cur);
  WAIT_BAR(2);
  s16x4 vlo[8],vhi[8]; u32x4 pw0,pw1,pw2,pw3;
  #define PKW(P,B) cvtpk_s(P[B],P[B+1])
  #define PAF(k) __builtin_bit_cast(bf16x8,pw##k)
  #define VFR(i) (bf16x8){vlo[i][0],vlo[i][1],vlo[i][2],vlo[i][3],vhi[i][0],vhi[i][1],vhi[i][2],vhi[i][3]}
  #define PIN(x) asm volatile("":"+v"(x))
  #define MX3(a,b,c) __builtin_fmaxf(__builtin_fmaxf((a),(b)),(c))
  #define GAPA(MF,A0,A1,A2,A3,W0,W1,PW) do{ MF; sacc+=A0; sacc+=A1; sacc+=A2; sacc+=A3; PIN(sacc); W0; W1; PIN(PW); SBAR(); }while(0)
  #define EX(v) __builtin_amdgcn_exp2f(v)
  #define GAPB(MF,X,B) do{ MF; X[B]=EX(X[B]); X[B+1]=EX(X[B+1]); X[B+2]=EX(X[B+2]); X[B+3]=EX(X[B+3]); PIN(X); SBAR(); }while(0)
  #define VRD(i) do{ vlo[i]=vtr(vp_+(((i)>>2)*4096+((i)&3)*1024)); vhi[i]=vtr(vp_+(((i)>>2)*4096+((i)&3)*1024+512)); }while(0)
  #define KRD(G,j) do{ if(G){ kload2(kf,kp0+sl_next,j); SBAR(); } }while(0)
  #define STEP(C0,C1,P0,P1,t,GK,GV,GL) do{ SBAR(); if(MODE==1){ mw_n=((t)+1<NT)?mq[(t)+1]:0ull; } \
    const lds_cptr vp_=vp0+sl_prev; \
    VRD(0); SBAR(); float sacc=(P0[0]+P0[1]); \
    GAPA(C0=__builtin_amdgcn_mfma_f32_32x32x16_bf16(kf[0],qr[0],(MODE==1?negm:zero16),0,0,0), P0[2],P0[3],P0[4],P0[5],     pw0[0]=PKW(P0,0), pw0[1]=PKW(P0,2), pw0); \
    VRD(4); SBAR(); GAPA(C1=__builtin_amdgcn_mfma_f32_32x32x16_bf16(kf[1],qr[0],(MODE==1?negm:zero16),0,0,0), P0[6],P0[7],P0[8],P0[9],     pw0[2]=PKW(P0,4), pw0[3]=PKW(P0,6), pw0); \
    VRD(1); SBAR(); GAPA(C0=__builtin_amdgcn_mfma_f32_32x32x16_bf16(kf[2],qr[1],C0,0,0,0),   P0[10],P0[11],P0[12],P0[13], pw1[0]=PKW(P0,8), pw1[1]=PKW(P0,10), pw1); \
    VRD(5); SBAR(); GAPA(C1=__builtin_amdgcn_mfma_f32_32x32x16_bf16(kf[3],qr[1],C1,0,0,0),   P0[14],P0[15],P1[0],P1[1],   pw1[2]=PKW(P0,12),pw1[3]=PKW(P0,14), pw1); \
    VRD(2); SBAR(); GAPA(C0=__builtin_amdgcn_mfma_f32_32x32x16_bf16(kf[4],qr[2],C0,0,0,0),   P1[2],P1[3],P1[4],P1[5],     pw2[0]=PKW(P1,0), pw2[1]=PKW(P1,2), pw2); \
    VRD(6); SBAR(); GAPA(C1=__builtin_amdgcn_mfma_f32_32x32x16_bf16(kf[5],qr[2],C1,0,0,0),   P1[6],P1[7],P1[8],P1[9],     pw2[2]=PKW(P1,4), pw2[3]=PKW(P1,6), pw2); \
    VRD(3); SBAR(); GAPA(C0=__builtin_amdgcn_mfma_f32_32x32x16_bf16(kf[6],qr[3],C0,0,0,0),   P1[10],P1[11],P1[12],P1[13], pw3[0]=PKW(P1,8), pw3[1]=PKW(P1,10), pw3); \
    VRD(7); SBAR(); GAPA(C1=__builtin_amdgcn_mfma_f32_32x32x16_bf16(kf[7],qr[3],C1,0,0,0),   P1[14],P1[15],0.f,0.f,       pw3[2]=PKW(P1,12),pw3[3]=PKW(P1,14), pw3); \
    l_reg+=sacc; \
    CMASK(C0,C1,t); if(MODE==1){ mw_c=mw_n; } \
    if(GK){DMA_K((t)+3,sl_cur);} if(GV){DMA_V((t)+1,sl_next);} \
    { float a=MX3(C0[0],C0[1],C1[0]),b=MX3(C0[2],C0[3],C1[1]); a=MX3(a,C1[2],C1[3]); \
      _Pragma("unroll") for(int r=4;r<16;r+=4){a=MX3(a,C0[r],C0[r+1]);b=MX3(b,C0[r+2],C0[r+3]);a=MX3(a,C1[r],C1[r+1]);b=MX3(b,C1[r+2],C1[r+3]);} \
      float rm=__builtin_fmaxf(a,b); { auto rr=__builtin_amdgcn_permlane32_swap(__float_as_uint(rm),__float_as_uint(rm),false,false); rm=__builtin_fmaxf(__uint_as_float(rr[0]),__uint_as_float(rr[1])); } \
      resc=false; \
      if(__builtin_expect(__any(rm>(float)THRL),0)){ const float dl=__builtin_fmaxf(rm,0.f); mhat+=dl; \
        _Pragma("unroll") for(int r=0;r<16;++r){C0[r]-=dl;C1[r]-=dl;} \
        if(MODE==1){ _Pragma("unroll") for(int r=0;r<16;++r)negm[r]=-mhat; asm volatile("":"+v"(negm)); } \
        const float f=__builtin_amdgcn_exp2f(-dl); l_reg*=f; if(hi==0)wsf[r32]=f; resc=true; } } \
    SBAR(); \
    GAPB(o[0]=__builtin_amdgcn_mfma_f32_32x32x16_bf16(PAF(0),VFR(0),o[0],0,0,0), C0,0); \
    GAPB(o[1]=__builtin_amdgcn_mfma_f32_32x32x16_bf16(PAF(0),VFR(4),o[1],0,0,0), C0,4); \
    KRD(GL,0); GAPB(o[0]=__builtin_amdgcn_mfma_f32_32x32x16_bf16(PAF(1),VFR(1),o[0],0,0,0), C0,8); \
    KRD(GL,1); GAPB(o[1]=__builtin_amdgcn_mfma_f32_32x32x16_bf16(PAF(1),VFR(5),o[1],0,0,0), C0,12); \
    KRD(GL,2); GAPB(o[0]=__builtin_amdgcn_mfma_f32_32x32x16_bf16(PAF(2),VFR(2),o[0],0,0,0), C1,0); \
    KRD(GL,3); GAPB(o[1]=__builtin_amdgcn_mfma_f32_32x32x16_bf16(PAF(2),VFR(6),o[1],0,0,0), C1,4); \
    GAPB(o[0]=__builtin_amdgcn_mfma_f32_32x32x16_bf16(PAF(3),VFR(3),o[0],0,0,0), C1,8); \
    GAPB(o[1]=__builtin_amdgcn_mfma_f32_32x32x16_bf16(PAF(3),VFR(7),o[1],0,0,0), C1,12); \
    }while(0)
  int t=1;
  #undef CMASK
  #define CMASK(P0,P1,t) apply_mask<MODE,false>(P0,P1,(t),NT,qrel,hi,selmask,mw_c,mhat)
  for(;t+5<NT;t+=2){
    STEP(pB0,pB1,pA0,pA1,t,true,true,true);     WAIT_BAR(2); RESC(); ROT();
    STEP(pA0,pA1,pB0,pB1,t+1,true,true,true);   WAIT_BAR(2); RESC(); ROT();
  }
  #undef CMASK
  #define CMASK(P0,P1,t) apply_mask<MODE,true>(P0,P1,(t),NT,qrel,hi,selmask,mw_c,mhat)
  #define ENDW(tt) do{ if((tt)+3<NT){WAIT_BAR(2);} else if((tt)+2<NT){WAIT_BAR(1);} else {WAIT_BAR(0);} }while(0)
  for(;t+1<NT;t+=2){
    STEP(pB0,pB1,pA0,pA1,t,(t+3<NT),(t+1<NT),(t+1<NT));       ENDW(t);   RESC(); ROT();
    STEP(pA0,pA1,pB0,pB1,t+1,(t+4<NT),(t+2<NT),(t+2<NT));     ENDW(t+1); RESC(); ROT();
  }
  STEP(pB0,pB1,pA0,pA1,NT-1,false,false,false); RESC();
  { float sacc=pB0[0]+pB0[1]; _Pragma("unroll") for(int r=2;r<16;++r)sacc+=pB0[r]; _Pragma("unroll") for(int r=0;r<16;++r)sacc+=pB1[r]; l_reg+=sacc;
    pw0=(u32x4){PKW(pB0,0),PKW(pB0,2),PKW(pB0,4),PKW(pB0,6)};pw1=(u32x4){PKW(pB0,8),PKW(pB0,10),PKW(pB0,12),PKW(pB0,14)};pw2=(u32x4){PKW(pB1,0),PKW(pB1,2),PKW(pB1,4),PKW(pB1,6)};pw3=(u32x4){PKW(pB1,8),PKW(pB1,10),PKW(pB1,12),PKW(pB1,14)};
    SBAR(); pv(o,vb0+sl_cur,PAF(0),PAF(1),PAF(2),PAF(3)); }
  #undef PKW
  #undef PAF
  #undef VFR
  #undef PIN
  #undef MX3
  #undef GAPA
  #undef GAPB
  #undef EX
  #undef VRD
  #undef KRD
  #undef STEP
  #undef ENDW
  {auto rr=__builtin_amdgcn_permlane32_swap(__float_as_uint(l_reg),__float_as_uint(l_reg),false,false);l_reg=__uint_as_float(rr[0])+__uint_as_float(rr[1]);}
  if(hi==0)wsf[32+r32]=l_reg;asm volatile("s_waitcnt lgkmcnt(0)":::"memory");
  float rli[16];
  #pragma unroll
  for(int r=0;r<16;++r)rli[r]=__builtin_amdgcn_rcpf(wsf[32+crow(r,hi)]);
  bf16*Ow=Oh+(long)(q0+wid*QBLK)*QP;
  { bf16*stg=(bf16*)(shm+LDS_OST)+wid*2048;
    #pragma unroll
    for(int r=0;r<16;++r){const int orow=crow(r,hi);
      #pragma unroll
      for(int d0=0;d0<2;++d0)stg[orow*64+d0*32+r32]=__float2bfloat16(o[d0][r]*rli[r]);}
    asm volatile("s_waitcnt lgkmcnt(0)":::"memory");
    #pragma unroll
    for(int i=0;i<4;++i){const int row=i*8+(lane>>3),ch=lane&7; const u32x4 v=*(const u32x4*)(stg+row*64+ch*8); ATTN_STORE16(Ow+(long)row*QP+ch*8,v);} }
  asm volatile("s_waitcnt lgkmcnt(0)\n\ts_barrier":::"memory");
  #undef DMA_K
  #undef DMA_V
  #undef CMASK
  #undef START
  #undef RESC
  #undef ROT
}
constexpr int ATTN_LDS_BYTES=LDS_BYTES;

static_assert(SEL_OFF>=LDS_BYTES,"selection words above the attention body's own LDS use");
template<int QP> __device__ __forceinline__ void moba_gates(int qb,const bf16*Qh,const bf16*__restrict__ kmh,const bf16*__restrict__ kml,char*shm){
  int tid_l=threadIdx.x; asm volatile("":"+v"(tid_l)); const int tid=tid_l,lane=tid&63,r32=lane&31,hi=lane>>5; const int wid=__builtin_amdgcn_readfirstlane(tid>>6);
  const int q0=qb*QB; const bf16*Qw=Qh+(long)(q0+wid*QBLK)*QP;
  bf16x8 qr[4];
  #pragma unroll
  for(int d0=0;d0<4;++d0)qr[d0]=*reinterpret_cast<const bf16x8*>(&Qw[(long)r32*QP+d0*16+hi*8]);
  unsigned selmask=0u;
  {
    f32x16 g=f32x16{};
    #pragma unroll
    for(int d0=0;d0<4;++d0){
      const bf16x8 ah=*reinterpret_cast<const bf16x8*>(&kmh[r32*64+d0*16+hi*8]);
      const bf16x8 al=*reinterpret_cast<const bf16x8*>(&kml[r32*64+d0*16+hi*8]);
      g=__builtin_amdgcn_mfma_f32_32x32x16_bf16(ah,qr[d0],g,0,0,0);
      g=__builtin_amdgcn_mfma_f32_32x32x16_bf16(al,qr[d0],g,0,0,0);}
    float v1=-INFINITY,v2=-INFINITY,v3=-INFINITY; int i1=64,i2=64,i3=64;
    #define TOP3_INS(vv,ii) do{ const float v_=(vv); const int i_=(ii); \
      const bool b1=(v_>v1)||(v_==v1&&i_<i1), b2=(v_>v2)||(v_==v2&&i_<i2), b3=(v_>v3)||(v_==v3&&i_<i3); \
      if(b1){v3=v2;i3=i2;v2=v1;i2=i1;v1=v_;i1=i_;} else if(b2){v3=v2;i3=i2;v2=v_;i2=i_;} else if(b3){v3=v_;i3=i_;} }while(0)
    #pragma unroll
    for(int r=0;r<16;++r){ const int j=crow(r,hi); const float gv=(j<qb)?g[r]:-INFINITY; TOP3_INS(gv,(j<qb)?j:64); }
    { const float pv1=__shfl_xor(v1,32),pv2=__shfl_xor(v2,32),pv3=__shfl_xor(v3,32); const int pi1=__shfl_xor(i1,32),pi2=__shfl_xor(i2,32),pi3=__shfl_xor(i3,32);
      TOP3_INS(pv1,pi1); TOP3_INS(pv2,pi2); TOP3_INS(pv3,pi3); }
    #undef TOP3_INS
    if(i1<32)selmask|=1u<<i1; if(i2<32)selmask|=1u<<i2; if(i3<32)selmask|=1u<<i3;
  }
  if(hi==0)((unsigned*)(shm+SEL_OFF))[wid*QBLK+r32]=selmask;
}
#undef SBAR
#undef WAIT_BAR
}
#define GAS __attribute__((address_space(1)))
#define LAS __attribute__((address_space(3)))
typedef unsigned short bf16;
typedef unsigned v4u __attribute__((ext_vector_type(4)));
typedef float f32x4 __attribute__((ext_vector_type(4)));
typedef short bf16x8 __attribute__((ext_vector_type(8)));
typedef GAS unsigned gu32;
typedef GAS unsigned long long gu64;
#define RLX_AGENT __ATOMIC_RELAXED, __HIP_MEMORY_SCOPE_AGENT
#define LDS_WAIT() asm volatile("s_waitcnt lgkmcnt(0)" ::: "memory")
#define VM_WAIT() asm volatile("s_waitcnt vmcnt(0)" ::: "memory")
__device__ __forceinline__ unsigned long long rt() { return __builtin_amdgcn_s_memrealtime(); }
__device__ __forceinline__ unsigned f2bf(float f) { unsigned u = __builtin_bit_cast(unsigned, f); return (u + 0x7fffu + ((u >> 16) & 1u)) >> 16; }
__device__ __forceinline__ unsigned pk2(float lo, float hi) { return f2bf(lo) | (f2bf(hi) << 16); }

#define XB_TMO      128
#define XB_XCNT(j)  (256  + 64 * (j))
#define XB_XSUB(j)  (1280 + 64 * (j))
#define XB_XGEN(j)  (2304 + 64 * (j))
#define XB_TOP      3328
#define XB_TOPGEN   3392
#define XCD_BAR_WORDS 3456
#define XB_SPIN_CAP (1u << 18)

__device__ __forceinline__ unsigned xb_ld(unsigned* p)              { return __hip_atomic_load(p, __ATOMIC_RELAXED, __HIP_MEMORY_SCOPE_AGENT); }
__device__ __forceinline__ unsigned xb_add(unsigned* p, unsigned v) { return __hip_atomic_fetch_add(p, v, __ATOMIC_RELAXED, __HIP_MEMORY_SCOPE_AGENT); }
__device__ __forceinline__ unsigned xb_xcc_id() { return (unsigned)__builtin_amdgcn_s_getreg((3 << 11) | 20) & 0xFu; }
#define XB_SPIN(cond, bar) do { unsigned _sp = 0; while (cond) { __builtin_amdgcn_s_sleep(1); \
    if ((++_sp & 255u) == 0u) { if (xb_ld(&(bar)[XB_TMO])) break; if (_sp > XB_SPIN_CAP) { atomicAdd(&(bar)[XB_TMO], 1u); break; } } } } while (0)

struct XcdBarrier {
    unsigned* bar; unsigned x;
    volatile LAS unsigned* st;
};

__device__ __forceinline__ XcdBarrier xcd_barrier_post(unsigned* bar, volatile LAS unsigned* st) {
    XcdBarrier b; b.bar = bar; b.x = xb_xcc_id(); b.st = st;
    if (threadIdx.x == 0) (void)xb_add(&bar[XB_XCNT(b.x)], 1u);
    return b;
}
__device__ __forceinline__ void xcd_barrier_complete(unsigned* bar, unsigned x, unsigned& nloc, unsigned& nx) {
    const unsigned G = gridDim.x * gridDim.y * gridDim.z;
    unsigned sum, cnt, mine, sp = 0u;
    for (;;) {
        sum = 0u; cnt = 0u; mine = 0u;
#pragma unroll
        for (unsigned j = 0; j < 16; ++j) { const unsigned c = xb_ld(&bar[XB_XCNT(j)]); sum += c; cnt += (c > 0u) ? 1u : 0u; mine = (j == x) ? c : mine; }
        if (sum == G) break;
        __builtin_amdgcn_s_sleep(1);
        if ((++sp & 255u) == 0u) { if (xb_ld(&bar[XB_TMO])) break; if (sp > XB_SPIN_CAP) { atomicAdd(&bar[XB_TMO], 1u); break; } }
    }
    nloc = mine > 0u ? mine : 1u; nx = cnt > 0u ? cnt : 1u;
}

__device__ __forceinline__ void xcd_barrier(const XcdBarrier& b) {
    asm volatile("s_waitcnt vmcnt(0)" ::: "memory");
    __syncthreads();
    if (threadIdx.x == 0) {
        unsigned* bar = b.bar;
        __builtin_amdgcn_s_waitcnt(0);
        unsigned nloc = b.st[0], nx = b.st[1];
        if (nloc == 0u) { xcd_barrier_complete(bar, b.x, nloc, nx); b.st[0] = nloc; b.st[1] = nx; }
        const unsigned old = xb_add(&bar[XB_XSUB(b.x)], 1u);
        const unsigned gen = old / nloc;
        if (old + 1u == (gen + 1u) * nloc) {
            __builtin_amdgcn_fence(__ATOMIC_RELEASE, "agent");
            asm volatile("s_waitcnt vmcnt(0)" ::: "memory");
            const unsigned og = xb_add(&bar[XB_TOP], 1u);
            const unsigned tg = og / nx;
            if (og + 1u == (tg + 1u) * nx) xb_add(&bar[XB_TOPGEN], 1u);
            else XB_SPIN(xb_ld(&bar[XB_TOPGEN]) == tg, bar);
            __builtin_amdgcn_fence(__ATOMIC_ACQUIRE, "agent");
            xb_add(&bar[XB_XGEN(b.x)], 1u);
            asm volatile("s_waitcnt vmcnt(0)" ::: "memory");
        } else {
            XB_SPIN(xb_ld(&bar[XB_XGEN(b.x)]) == gen, bar);
            __builtin_amdgcn_fence(__ATOMIC_ACQUIRE, "agent");
            asm volatile("s_waitcnt vmcnt(0)" ::: "memory");
        }
    }
    __syncthreads();
}

constexpr int NWAVES = 8;
#ifndef STAG_TICKS
#define STAG_TICKS 0u
#endif
#ifndef PG8_ALIGN1
#define PG8_ALIGN1 true
#endif
constexpr int SEQ = 8192, DMODEL = 1024, MROWS = 16384, DFF = 2816;
constexpr float RMS_EPS = 1e-6f;
constexpr float QC2 = 0.125f * 1.4426950408889634f;
constexpr size_t MiB = 1u << 20;
constexpr size_t WS_CTL = 0, CTL_ZERO_BYTES = 1 * MiB;
constexpr size_t WS_W_IN0 = 1 * MiB, WS_W_OUT0 = 6 * MiB, WS_W_GU0 = 8 * MiB, WS_W_DN0 = 19 * MiB, WS_W_PG0 = 25 * MiB, WS_W_PP0 = 27 * MiB;
constexpr size_t WS_W_IN1 = 28 * MiB, WS_W_OUT1 = 36 * MiB, WS_W_GU1 = 38 * MiB, WS_W_DN1 = 49 * MiB, WS_W_PG1 = 55 * MiB, WS_W_PP1 = 57 * MiB;
constexpr size_t WS_ROPE = 58 * MiB;
constexpr size_t WS_ROWSS = 59 * MiB;
constexpr size_t WS_KMH = 60 * MiB, WS_KML = 60 * MiB + 64 * 1024, WS_WI = 60 * MiB + 512 * 1024;
constexpr size_t WS_KIRAW = 61 * MiB, WS_KI = 65 * MiB;
constexpr size_t WS_HB = 68 * MiB, WS_PB = 100 * MiB, WS_MASK = 116 * MiB, WS_R = 132 * MiB;
constexpr size_t WS_QO = WS_R, WS_VA = WS_R + 32 * MiB, WS_KB0 = WS_R + 48 * MiB, WS_VB0 = WS_R + 64 * MiB;
constexpr size_t WS_KC = WS_R + 32 * MiB, WS_VC = WS_R + 64 * MiB, WS_QI = WS_R + 96 * MiB;
constexpr size_t WS_ROWSS2 = 244 * MiB;
constexpr size_t WS_HID = WS_R,
#ifdef PROBE_G_ELSEWHERE
 WS_G = 100 * MiB,
#else
 WS_G = WS_R,
#endif
 WS_END = 256 * MiB;
static_assert(WS_QI + 16 * MiB <= WS_END && WS_HID + (size_t)MROWS * DFF * 2 <= WS_END, "ws map");
constexpr int CW_BAR = 4096;
constexpr int PHASE_LDS = 147456, LDSCTL_OFF = PHASE_LDS, LDS_BYTES = PHASE_LDS + 1024;

#ifndef PHMASK
#define PHMASK 0xffffffffu
#endif
#define RUNPH(k) (((PHMASK) >> (k)) & 1u)
#ifndef DUPMASK
#define DUPMASK 0u
#endif
#ifndef PROBE_VAR
#define PROBE_VAR 0
#endif
#define NREP(k) ((int)(RUNPH(k) * (1u + (((DUPMASK) >> (k)) & 1u))))
struct Args { const float* in[22]; float* out; unsigned char* ws; float f0, f1, f2, f3, f4, f5, f6, f7; };
typedef const __attribute__((address_space(4))) Args* KArgs;

namespace epi {
using pg8::f32x4; using pg8::f32x2; using pg8::Unit; using pg8::bf16_t;
typedef unsigned u32x2 __attribute__((ext_vector_type(2)));
typedef __bf16 bf16x2_t __attribute__((ext_vector_type(2)));
__device__ __forceinline__ unsigned cvtpk(float lo, float hi) { const f32x2 v = {lo, hi}; const bf16x2_t b = __builtin_convertvector(v, bf16x2_t); return __builtin_bit_cast(unsigned, b); }
__device__ __forceinline__ void st4(bf16_t* p, f32x4 v) { u32x2 w; w.x = cvtpk(v[0], v[1]); w.y = cvtpk(v[2], v[3]); *(u32x2*)p = w; }
__device__ __forceinline__ f32x4 ld4(const bf16_t* p) { const u32x2 w = *(const u32x2*)p; f32x4 v; v[0] = __uint_as_float(w.x << 16); v[1] = __uint_as_float(w.x & 0xffff0000u); v[2] = __uint_as_float(w.y << 16); v[3] = __uint_as_float(w.y & 0xffff0000u); return v; }
__device__ __forceinline__ f32x4 gelu4(f32x4 v) { const f32x2 a = pg8::gelu_pk((f32x2){v[0], v[1]}), b = pg8::gelu_pk((f32x2){v[2], v[3]}); return (f32x4){a.x, a.y, b.x, b.y}; }
__device__ __forceinline__ float sigm(float x) { return __builtin_amdgcn_rcpf(1.f + __builtin_amdgcn_exp2f(-1.4426950408889634f * x)); }
__device__ __forceinline__ float sum_fq(float s) {
    auto a = __builtin_amdgcn_permlane16_swap(__float_as_uint(s), __float_as_uint(s), false, false); s = __uint_as_float(a[0]) + __uint_as_float(a[1]);
    auto b = __builtin_amdgcn_permlane32_swap(__float_as_uint(s), __float_as_uint(s), false, false); return __uint_as_float(b[0]) + __uint_as_float(b[1]);
}
__device__ __forceinline__ float xor32(float v, int fq) {
    auto b = __builtin_amdgcn_permlane32_swap(__float_as_uint(v), __float_as_uint(v), false, false); return __uint_as_float(fq < 2 ? b[1] : b[0]);
}
__device__ __forceinline__ void row_rstd8(const float* rowss, int row0, int fq, float (&rs)[2][4]) {
    f32x4 v[2][4];
#pragma unroll
    for (int ai = 0; ai < 2; ++ai)
#pragma unroll
        for (int m = 0; m < 4; ++m) v[ai][m] = *(const f32x4*)(rowss + (size_t)(row0 + ai * 128 + m * 16) * 16 + 4 * fq);
#pragma unroll
    for (int ai = 0; ai < 2; ++ai)
#pragma unroll
        for (int m = 0; m < 4; ++m) { const float s = sum_fq((v[ai][m][0] + v[ai][m][1]) + (v[ai][m][2] + v[ai][m][3])); rs[ai][m] = 1.0f / sqrtf(s * (1.f / 1024.f) + RMS_EPS); }
}
#define EPI_FENCE() asm volatile("" ::: "memory")
typedef unsigned u32x4e __attribute__((ext_vector_type(4)));
__device__ __forceinline__ void st8(bf16_t* p, f32x4 a, f32x4 b) { u32x4e w; w.x = cvtpk(a[0], a[1]); w.y = cvtpk(a[2], a[3]); w.z = cvtpk(b[0], b[1]); w.w = cvtpk(b[2], b[3]); *(u32x4e*)p = w; }
__device__ __forceinline__ void ld8(const bf16_t* p, f32x4& a, f32x4& b) { const u32x4e w = *(const u32x4e*)p;
    a[0] = __uint_as_float(w.x << 16); a[1] = __uint_as_float(w.x & 0xffff0000u); a[2] = __uint_as_float(w.y << 16); a[3] = __uint_as_float(w.y & 0xffff0000u);
    b[0] = __uint_as_float(w.z << 16); b[1] = __uint_as_float(w.z & 0xffff0000u); b[2] = __uint_as_float(w.w << 16); b[3] = __uint_as_float(w.w & 0xffff0000u); }
__device__ __forceinline__ float xor16(float v, int fq) {
    auto a = __builtin_amdgcn_permlane16_swap(__float_as_uint(v), __float_as_uint(v), false, false); return __uint_as_float((fq & 1) ? a[0] : a[1]);
}
__device__ __forceinline__ void rope8(f32x4& a, f32x4& b, const float* cs, const float* sn, int row, int fq) {
    const f32x4 c0 = *(const f32x4*)(cs + (size_t)row * 8), c1 = *(const f32x4*)(cs + (size_t)row * 8 + 4), s0 = *(const f32x4*)(sn + (size_t)row * 8), s1 = *(const f32x4*)(sn + (size_t)row * 8 + 4);
    f32x4 pa, pb;
#pragma unroll
    for (int j = 0; j < 4; ++j) { pa[j] = xor16(a[j], fq); pb[j] = xor16(b[j], fq); }
    if (fq < 2) {
#pragma unroll
        for (int j = 0; j < 4; ++j) { a[j] = (fq == 0) ? (a[j] * c0[j] - pa[j] * s0[j]) : (a[j] * c0[j] + pa[j] * s0[j]); b[j] = (fq == 0) ? (b[j] * c1[j] - pb[j] * s1[j]) : (b[j] * c1[j] + pb[j] * s1[j]); } }
}
struct EpiInEven {
    static constexpr bool PERM = true, AFTER_DRAIN = false;
    const float* rowss; const float* cs; const float* sn; bf16_t *UQ, *VA, *KB, *VB;
    __device__ __forceinline__ void operator()(const f32x4 (&acc)[2][2][4][2], const Unit& u, int wr, int wc, int fr, int fq) const {
        const int row0 = u.pm * 256 + wr * 64 + fr; float rs8[2][4]; row_rstd8(rowss, row0, fq, rs8);
        const int sec = u.pn >> 1, cb = (u.pn & 1) * 256 + wc * 32 + 8 * fq; const bool ropew = (wc & 1) == 0;
#pragma unroll
        for (int ai = 0; ai < 2; ++ai) {
#pragma unroll
            for (int m = 0; m < 4; ++m) { const int row = row0 + ai * 128 + m * 16; const float r_ = rs8[ai][m];
#pragma unroll
                for (int bj = 0; bj < 2; ++bj) { const int c = cb + bj * 128; f32x4 a = acc[ai][bj][m][0] * r_, b = acc[ai][bj][m][1] * r_;
                    if (sec == 0) { st8(UQ + (size_t)row * 1024 + c, gelu4(a), gelu4(b)); }
                    else if (sec == 1) { st8(VA + (size_t)row * 512 + c, gelu4(a), gelu4(b)); }
                    else if (sec == 2) { if (ropew) rope8(a, b, cs, sn, row, fq); st8(UQ + (size_t)row * 1024 + 512 + c, a * QC2, b * QC2); }
                    else if (sec == 3) { if (ropew) rope8(a, b, cs, sn, row, fq); st8(KB + (size_t)row * 512 + c, a, b); }
                    else { st8(VB + (size_t)row * 512 + c, a, b); } }
                EPI_FENCE(); } }
    }
};
struct EpiResid {
    static constexpr bool PERM = true, AFTER_DRAIN = false;
    bf16_t* hb; float* rowss;
    __device__ __forceinline__ void operator()(const f32x4 (&acc)[2][2][4][2], const Unit& u, int wr, int wc, int fr, int fq) const {
        const int row0 = u.pm * 256 + wr * 64 + fr, cb = u.pn * 256 + wc * 32 + 8 * fq;
#pragma unroll
        for (int ai = 0; ai < 2; ++ai)
#pragma unroll
            for (int m = 0; m < 4; ++m) { const int row = row0 + ai * 128 + m * 16; float ss = 0.f;
#pragma unroll
                for (int bj = 0; bj < 2; ++bj) { const size_t off = (size_t)row * 1024 + cb + bj * 128; f32x4 a, b; ld8(hb + off, a, b); a = a + acc[ai][bj][m][0]; b = b + acc[ai][bj][m][1];
                    st8(hb + off, a, b); ss += ((a[0] * a[0] + a[1] * a[1]) + (a[2] * a[2] + a[3] * a[3])) + ((b[0] * b[0] + b[1] * b[1]) + (b[2] * b[2] + b[3] * b[3])); }
                ss = sum_fq(ss);
                if (fq == 0) rowss[(size_t)row * 16 + u.pn * 4 + wc] = ss;
                EPI_FENCE(); }
    }
};
struct EpiSwiglu {
    static constexpr bool PERM = true, AFTER_DRAIN = false;
    const float* rowss; bf16_t* HID;
    __device__ __forceinline__ void operator()(const f32x4 (&acc)[2][2][4][2], const Unit& u, int wr, int wc, int fr, int fq) const {
        const int row0 = u.pm * 256 + wr * 64 + fr; float rs8[2][4]; row_rstd8(rowss, row0, fq, rs8);
        const int cb = u.pn * 128 + wc * 32 + 8 * fq;
#pragma unroll
        for (int ai = 0; ai < 2; ++ai) {
#pragma unroll
            for (int m = 0; m < 4; ++m) { const int row = row0 + ai * 128 + m * 16; const float r_ = rs8[ai][m]; f32x4 o[2];
#pragma unroll
                for (int n = 0; n < 2; ++n) { const f32x4 g = acc[ai][0][m][n] * r_, up = acc[ai][1][m][n] * r_;
#pragma unroll
                    for (int j = 0; j < 4; ++j) o[n][j] = g[j] * up[j] * sigm(g[j]); }
                st8(HID + (size_t)row * DFF + cb, o[0], o[1]);
                EPI_FENCE(); } }
    }
};
struct EpiStore {
    static constexpr bool PERM = true, AFTER_DRAIN = false;
    bf16_t* O;
    __device__ __forceinline__ void operator()(const f32x4 (&acc)[2][2][4][2], const Unit& u, int wr, int wc, int fr, int fq) const {
        const int row0 = u.pm * 256 + wr * 64 + fr, cb = u.pn * 256 + wc * 32 + 8 * fq;
#pragma unroll
        for (int ai = 0; ai < 2; ++ai)
#pragma unroll
            for (int m = 0; m < 4; ++m) { const int row = row0 + ai * 128 + m * 16;
#pragma unroll
                for (int bj = 0; bj < 2; ++bj) st8(O + (size_t)row * 1024 + cb + bj * 128, acc[ai][bj][m][0], acc[ai][bj][m][1]); }
    }
};
struct EpiPleFused {
    static constexpr bool PERM = true, AFTER_DRAIN = false;
    const float* rowss; const bf16_t* hin; const bf16_t* proj; bf16_t* hout; float* rowss_out;
    __device__ __forceinline__ void operator()(const f32x4 (&acc)[2][2][4][2], const Unit& u, int wr, int wc, int fr, int fq) const {
        const int row0 = u.pm * 256 + wr * 64 + fr, cb = u.pn * 256 + wc * 32 + 8 * fq; float rs8[2][4]; row_rstd8(rowss, row0, fq, rs8);
#pragma unroll
        for (int ai = 0; ai < 2; ++ai)
#pragma unroll
            for (int m = 0; m < 4; ++m) { const int row = row0 + ai * 128 + m * 16; const float r_ = rs8[ai][m]; float ss = 0.f;
#pragma unroll
                for (int bj = 0; bj < 2; ++bj) { const size_t off = (size_t)row * 1024 + cb + bj * 128; f32x4 a, b, pa, pb; ld8(hin + off, a, b); ld8(proj + off, pa, pb);
                    const f32x4 ga = acc[ai][bj][m][0] * r_, gb = acc[ai][bj][m][1] * r_;
#pragma unroll
                    for (int j = 0; j < 4; ++j) { a[j] += pa[j] * sigm(ga[j]); b[j] += pb[j] * sigm(gb[j]); }
                    st8(hout + off, a, b); ss += ((a[0] * a[0] + a[1] * a[1]) + (a[2] * a[2] + a[3] * a[3])) + ((b[0] * b[0] + b[1] * b[1]) + (b[2] * b[2] + b[3] * b[3])); }
                ss = sum_fq(ss);
                if (fq == 0) rowss_out[(size_t)row * 16 + u.pn * 4 + wc] = ss;
                EPI_FENCE(); }
    }
};
struct PairOrder {
    int first;
    __device__ __forceinline__ bool next(int i, Unit& u) const { if (i >= 2) return false; const int t = first + i; u.pm = t >> 2; u.pn = t & 3; return true; }
    __device__ __forceinline__ void a_ready(const Unit&) const {}
    __device__ __forceinline__ void done(const Unit&) const {}
};
struct EpiPleGate {
    static constexpr bool PERM = true, AFTER_DRAIN = false;
    const float* rowss; bf16_t* G;
    __device__ __forceinline__ void operator()(const f32x4 (&acc)[2][2][4][2], const Unit& u, int wr, int wc, int fr, int fq) const {
        const int row0 = u.pm * 256 + wr * 64 + fr; float rs8[2][4]; row_rstd8(rowss, row0, fq, rs8);
        const int cb = u.pn * 256 + wc * 32 + 8 * fq;
#pragma unroll
        for (int ai = 0; ai < 2; ++ai) {
#pragma unroll
            for (int m = 0; m < 4; ++m) { const int row = row0 + ai * 128 + m * 16; const float r_ = rs8[ai][m];
#pragma unroll
                for (int bj = 0; bj < 2; ++bj) { const f32x4 a = acc[ai][bj][m][0] * r_, b = acc[ai][bj][m][1] * r_; f32x4 oa, ob;
#pragma unroll
                    for (int j = 0; j < 4; ++j) { oa[j] = sigm(a[j]); ob[j] = sigm(b[j]); }
                    st8(G + (size_t)row * 1024 + cb + bj * 128, oa, ob); }
                EPI_FENCE(); } }
    }
};
struct EpiPleProj {
    static constexpr bool PERM = true, AFTER_DRAIN = false;
    bf16_t* hb; float* rowss; const bf16_t* G;
    __device__ __forceinline__ void operator()(const f32x4 (&acc)[2][2][4][2], const Unit& u, int wr, int wc, int fr, int fq) const {
        const int row0 = u.pm * 256 + wr * 64 + fr, cb = u.pn * 256 + wc * 32 + 8 * fq;
#pragma unroll
        for (int ai = 0; ai < 2; ++ai)
#pragma unroll
            for (int m = 0; m < 4; ++m) { const int row = row0 + ai * 128 + m * 16; float ss = 0.f;
#pragma unroll
                for (int bj = 0; bj < 2; ++bj) { const size_t off = (size_t)row * 1024 + cb + bj * 128; f32x4 a, b, ga, gb; ld8(hb + off, a, b); ld8(G + off, ga, gb);
                    a = a + acc[ai][bj][m][0] * ga; b = b + acc[ai][bj][m][1] * gb;
                    st8(hb + off, a, b); ss += ((a[0] * a[0] + a[1] * a[1]) + (a[2] * a[2] + a[3] * a[3])) + ((b[0] * b[0] + b[1] * b[1]) + (b[2] * b[2] + b[3] * b[3])); }
                ss = sum_fq(ss);
                if (fq == 0) rowss[(size_t)row * 16 + u.pn * 4 + wc] = ss;
                EPI_FENCE(); }
    }
};
struct EpiInOdd {
    static constexpr bool PERM = true, AFTER_DRAIN = false;
    const float* rowss; const float* cs; const float* sn; bf16_t *QO, *KC, *VC, *QI; float* KIRAW; float* WI;
    __device__ __forceinline__ void operator()(const f32x4 (&acc)[2][2][4][2], const Unit& u, int wr, int wc, int fr, int fq) const {
        const int row0 = u.pm * 256 + wr * 64 + fr; float rs8[2][4]; row_rstd8(rowss, row0, fq, rs8);
        const int pn = u.pn, cl = wc * 32 + 8 * fq; const bool ropew = (wc & 1) == 0;
#pragma unroll
        for (int ai = 0; ai < 2; ++ai) {
#pragma unroll
            for (int m = 0; m < 4; ++m) { const int row = row0 + ai * 128 + m * 16; const float r_ = rs8[ai][m];
#pragma unroll
                for (int bj = 0; bj < 2; ++bj) { const int c = cl + bj * 128; f32x4 a = acc[ai][bj][m][0] * r_, b = acc[ai][bj][m][1] * r_;
                    if (pn < 4) { if (ropew) rope8(a, b, cs, sn, row, fq); st8(QO + (size_t)row * 1024 + pn * 256 + c, a * QC2, b * QC2); }
                    else if (pn < 8) { if (ropew) rope8(a, b, cs, sn, row, fq); st8(KC + (size_t)row * 1024 + (pn - 4) * 256 + c, a, b); }
                    else if (pn < 12) { st8(VC + (size_t)row * 1024 + (pn - 8) * 256 + c, a, b); }
                    else if (pn < 14) { if (ropew) rope8(a, b, cs, sn, row, fq); st8(QI + (size_t)row * 512 + (pn - 12) * 256 + c, a, b); }
                    else { if (c < 64) { *(f32x4*)(KIRAW + (size_t)row * 64 + c) = a; *(f32x4*)(KIRAW + (size_t)row * 64 + c + 4) = b; }
                           else if (c == 64) { *(f32x4*)(WI + (size_t)row * 8) = a * 0.04419417382415922f; *(f32x4*)(WI + (size_t)row * 8 + 4) = b * 0.04419417382415922f; } } }
                EPI_FENCE(); } }
    }
};
}

__device__ __forceinline__ float wave_sum(float v) {
#pragma unroll
    for (int o = 1; o < 64; o <<= 1) v += __shfl_xor(v, o);
    return v;
}
constexpr int XP_SCR = 64 * 65;
template <int MODE>
__device__ __forceinline__ void xpose_item(const float* __restrict__ W, int K, int N, const float* __restrict__ g, bf16* __restrict__ WT, int off, LAS float* scr, int item, int lane) {
    const int nblk = (N + 63) / 64, kb = item / nblk, nb = item % nblk, k0 = 64 * kb, n0 = 64 * nb;
    const int nq = lane & 15, kr = lane >> 4; const int nn = n0 + 4 * nq; const bool ok = nn < N;
#pragma unroll 8
    for (int i = 0; i < 16; ++i) { const int kk = 4 * i + kr; f32x4 v = ok ? *(const f32x4*)(W + (size_t)(k0 + kk) * N + nn) : (f32x4){0.f, 0.f, 0.f, 0.f};
        if (g) v = v * g[k0 + kk];
        LAS float* d = scr + kk * 65 + 4 * nq; d[0] = v[0]; d[1] = v[1]; d[2] = v[2]; d[3] = v[3]; }
    LDS_WAIT(); asm volatile("" ::: "memory");
    const int c = lane & 7;
#pragma unroll
    for (int j = 0; j < 8; ++j) { const int n = (lane >> 3) + 8 * j; const LAS float* s = scr + (8 * c) * 65 + n;
        v4u o; o.x = pk2(s[0 * 65], s[1 * 65]); o.y = pk2(s[2 * 65], s[3 * 65]); o.z = pk2(s[4 * 65], s[5 * 65]); o.w = pk2(s[6 * 65], s[7 * 65]);
        const int ng = n0 + n;
        if (ng < N) { const int dr = (MODE == 0) ? (ng + off) : ((ng >> 7) * 256 + (ng & 127) + off); *(v4u*)(WT + (size_t)dr * K + k0 + 8 * c) = o; } }
    LDS_WAIT(); asm volatile("" ::: "memory");
}
__device__ __forceinline__ float bf2f(bf16 b) { return __uint_as_float(((unsigned)b) << 16); }

__device__ __forceinline__ void stagger_start(int nunits_total, int G, int bx, unsigned ticks) {
    const int rem = nunits_total % G;
    if (rem != 0 && bx >= rem) { const unsigned long long t0 = __builtin_amdgcn_s_memrealtime(); while (__builtin_amdgcn_s_memrealtime() - t0 < (unsigned long long)ticks) __builtin_amdgcn_s_sleep(32); }
}
template <int LM>
__device__ __forceinline__ void xp_run(KArgs ap, unsigned char* ws, LAS float* scr, int lane, int first, int stride) {
    const float *g_mix = ap->in[3], *w_in_even = ap->in[4], *w_out_even = ap->in[9], *w_in_odd = ap->in[10], *w_out_odd = ap->in[13], *g_ffn = ap->in[14], *w_gate = ap->in[15], *w_up = ap->in[16],
                *w_down = ap->in[17], *g_ple = ap->in[18], *w_pproj = ap->in[19], *w_pgate = ap->in[20];
    constexpr int I_IN0 = 16 * 40, I_SQ = 16 * 16, I_GU = 16 * 44, I_DN = 44 * 16, I_PP = 4 * 16, I_IN1 = 16 * 58;
    constexpr int N_L = I_SQ + 2 * I_GU + I_DN + I_SQ + I_PP;
    constexpr int NITEMS = ((LM & 1) ? I_IN0 : 0) + ((LM & 8) ? I_IN1 : 0) + ((LM & 2) ? N_L : 0) + ((LM & 4) ? N_L : 0);
#define XP(BIT, MODE, Wp, K_, N_, gp, OFFB, off_, NI) if (LM & (BIT)) { if (r < (NI)) { xpose_item<MODE>((Wp), (K_), (N_), (gp), (bf16*)(ws + (OFFB)), (off_), scr, r, lane); continue; } r -= (NI); }
    for (int it = first; it < NITEMS; it += stride) {
        int r = it;
        XP(1, 0, w_in_even, 1024, 2560, g_mix, WS_W_IN0, 0, I_IN0)
        XP(2, 0, w_out_even, 1024, 1024, (const float*)nullptr, WS_W_OUT0, 0, I_SQ)
        XP(2, 1, w_gate, 1024, DFF, g_ffn, WS_W_GU0, 0, I_GU)
        XP(2, 1, w_up, 1024, DFF, g_ffn, WS_W_GU0, 128, I_GU)
        XP(2, 0, w_down, DFF, 1024, (const float*)nullptr, WS_W_DN0, 0, I_DN)
        XP(2, 0, w_pgate, 1024, 1024, g_ple, WS_W_PG0, 0, I_SQ)
        XP(2, 0, w_pproj, 256, 1024, (const float*)nullptr, WS_W_PP0, 0, I_PP)
        XP(8, 0, w_in_odd, 1024, 3656, g_mix + 1024, WS_W_IN1, 0, I_IN1)
        XP(4, 0, w_out_odd, 1024, 1024, (const float*)nullptr, WS_W_OUT1, 0, I_SQ)
        XP(4, 1, w_gate + (size_t)1024 * DFF, 1024, DFF, g_ffn + 1024, WS_W_GU1, 0, I_GU)
        XP(4, 1, w_up + (size_t)1024 * DFF, 1024, DFF, g_ffn + 1024, WS_W_GU1, 128, I_GU)
        XP(4, 0, w_down + (size_t)DFF * 1024, DFF, 1024, (const float*)nullptr, WS_W_DN1, 0, I_DN)
        XP(4, 0, w_pgate + (size_t)1024 * 1024, 1024, 1024, g_ple + 1024, WS_W_PG1, 0, I_SQ)
        XP(4, 0, w_pproj + (size_t)256 * 1024, 256, 1024, (const float*)nullptr, WS_W_PP1, 0, I_PP)
    }
#undef XP
}
__device__ __forceinline__ void pb_convert(KArgs ap, unsigned char* ws, int gt, int NGT) {
    const f32x4* p4 = (const f32x4*)ap->in[1]; unsigned long long* o8 = (unsigned long long*)(ws + WS_PB); const int n4 = 2 * MROWS * 256 / 4;
    for (int i = gt; i < n4; i += NGT) { const f32x4 v = p4[i]; o8[i] = (unsigned long long)pk2(v[0], v[1]) | ((unsigned long long)pk2(v[2], v[3]) << 32); }
}
__device__ __forceinline__ void p0_prologue(KArgs ap, unsigned char* ws, LAS unsigned char* lds, int vcu, int G, int wave, int lane, int tid) {
    LAS float* scr = (LAS float*)lds + wave * XP_SCR;
    const int gw = vcu * NWAVES + wave, NGW = G * NWAVES, gt = vcu * (NWAVES * 64) + tid, NGT = G * NWAVES * 64;
    if (G == 256) xp_run<1>(ap, ws, scr, lane, gw, NGW); else xp_run<15>(ap, ws, scr, lane, gw, NGW);
    { v4u* z = (v4u*)(ws + WS_W_IN1 + (size_t)3656 * 1024 * 2); const int nz = (3840 - 3656) * 1024 * 2 / 16;
      for (int i = gt; i < nz; i += NGT) z[i] = (v4u){0u, 0u, 0u, 0u}; }
    { const float* x = ap->in[0]; bf16* hb = (bf16*)(ws + WS_HB); float* rowss = (float*)(ws + WS_ROWSS);
      for (int row = gw; row < MROWS; row += NGW) {
          const f32x4* xr = (const f32x4*)(x + (size_t)row * 1024) + lane; unsigned long long* o8 = (unsigned long long*)(hb + (size_t)row * 1024) + lane; float ss = 0.f;
#pragma unroll
          for (int j = 0; j < 4; ++j) { const f32x4 v = xr[64 * j]; ss += (v[0] * v[0] + v[1] * v[1]) + (v[2] * v[2] + v[3] * v[3]);
              o8[64 * j] = (unsigned long long)pk2(v[0], v[1]) | ((unsigned long long)pk2(v[2], v[3]) << 32); }
          ss = wave_sum(ss);
          if (lane < 16) rowss[(size_t)row * 16 + lane] = (lane == 0) ? ss : 0.f; } }
    pb_convert(ap, ws, gt, NGT);
    { const int* pos = (const int*)ap->in[2]; float* cs = (float*)(ws + WS_ROPE); float* sn = cs + MROWS * 8;
      for (int e = gt; e < MROWS * 8; e += NGT) { const int row = e >> 3, i = e & 7;
          const float f = (i == 0) ? ap->f0 : (i == 1) ? ap->f1 : (i == 2) ? ap->f2 : (i == 3) ? ap->f3 : (i == 4) ? ap->f4 : (i == 5) ? ap->f5 : (i == 6) ? ap->f6 : ap->f7;
          const float ang = (float)pos[row] * f; const double rev = (double)ang * 0.15915494309189533577; const float fr = (float)(rev - floor(rev));
          cs[e] = __builtin_amdgcn_cosf(fr); sn[e] = __builtin_amdgcn_sinf(fr); } }
}

__device__ __forceinline__ void kmean_unit(unsigned char* ws, int u, int lane) {
    const int bh = u >> 5, blk = u & 31, c = lane & 7, ro = lane >> 3;
    const bf16* kb = (const bf16*)(ws + WS_KB0) + ((size_t)(bh >> 3) * SEQ + blk * 256 + ro) * 512 + (bh & 7) * 64 + 8 * c;
    float s[8];
#pragma unroll
    for (int e = 0; e < 8; ++e) s[e] = 0.f;
#pragma unroll 8
    for (int r = 0; r < 32; ++r) { const v4u w = *(const v4u*)(kb + (size_t)r * 8 * 512);
        s[0] += __uint_as_float(w.x << 16); s[1] += __uint_as_float(w.x & 0xffff0000u); s[2] += __uint_as_float(w.y << 16); s[3] += __uint_as_float(w.y & 0xffff0000u);
        s[4] += __uint_as_float(w.z << 16); s[5] += __uint_as_float(w.z & 0xffff0000u); s[6] += __uint_as_float(w.w << 16); s[7] += __uint_as_float(w.w & 0xffff0000u); }
    unsigned hh[8], ll[8];
#pragma unroll
    for (int e = 0; e < 8; ++e) { float t = s[e]; t += __shfl_xor(t, 8); t += __shfl_xor(t, 16); t += __shfl_xor(t, 32);
        const float mean = t * (1.f / 256.f); hh[e] = f2bf(mean); ll[e] = f2bf(mean - __uint_as_float(hh[e] << 16)); }
    if (lane < 8) { const v4u vh = {hh[0] | (hh[1] << 16), hh[2] | (hh[3] << 16), hh[4] | (hh[5] << 16), hh[6] | (hh[7] << 16)}, vl = {ll[0] | (ll[1] << 16), ll[2] | (ll[3] << 16), ll[4] | (ll[5] << 16), ll[6] | (ll[7] << 16)};
        *(v4u*)((bf16*)(ws + WS_KMH) + u * 64 + 8 * c) = vh; *(v4u*)((bf16*)(ws + WS_KML) + u * 64 + 8 * c) = vl; }
}
__device__ __forceinline__ void sgu_unit(KArgs ap, unsigned char* ws, LAS unsigned char* lds, int cu, int g, int wave, int lane, int tid, bf16* YO) {
    constexpr int LTS = 136;
    LAS bf16* LT = (LAS bf16*)lds;
    const float *ln_g = ap->in[5], *ln_b = ap->in[6], *w_s = ap->in[7], *b_s = ap->in[8];
    bf16* UQ = (bf16*)(ws + WS_QO); const bf16* VA = (const bf16*)(ws + WS_VA);
    const int row0 = cu * 128;
    { const int s = tid >> 2, qd = tid & 3; const bf16* vp = VA + (size_t)(row0 + s) * 512 + g * 64 + qd * 16;
      const v4u w0 = *(const v4u*)vp, w1 = *(const v4u*)(vp + 8); float xv[16];
      xv[0] = __uint_as_float(w0.x << 16); xv[1] = __uint_as_float(w0.x & 0xffff0000u); xv[2] = __uint_as_float(w0.y << 16); xv[3] = __uint_as_float(w0.y & 0xffff0000u);
      xv[4] = __uint_as_float(w0.z << 16); xv[5] = __uint_as_float(w0.z & 0xffff0000u); xv[6] = __uint_as_float(w0.w << 16); xv[7] = __uint_as_float(w0.w & 0xffff0000u);
      xv[8] = __uint_as_float(w1.x << 16); xv[9] = __uint_as_float(w1.x & 0xffff0000u); xv[10] = __uint_as_float(w1.y << 16); xv[11] = __uint_as_float(w1.y & 0xffff0000u);
      xv[12] = __uint_as_float(w1.z << 16); xv[13] = __uint_as_float(w1.z & 0xffff0000u); xv[14] = __uint_as_float(w1.w << 16); xv[15] = __uint_as_float(w1.w & 0xffff0000u);
      float sm = 0.f;
#pragma unroll
      for (int e = 0; e < 16; ++e) sm += xv[e];
      sm += __shfl_xor(sm, 1); sm += __shfl_xor(sm, 2); const float mean = sm * (1.f / 64.f); float sq = 0.f;
#pragma unroll
      for (int e = 0; e < 16; ++e) { xv[e] -= mean; sq += xv[e] * xv[e]; }
      sq += __shfl_xor(sq, 1); sq += __shfl_xor(sq, 2); const float rstd = 1.0f / sqrtf(sq * (1.f / 64.f) + RMS_EPS);
#pragma unroll
      for (int e = 0; e < 16; ++e) { const int d = qd * 16 + e; const float y = xv[e] * rstd * ln_g[g * 64 + d] + ln_b[g * 64 + d]; LT[d * LTS + s] = (bf16)f2bf(y); } }
    __syncthreads();
    { const int r = lane & 15, kq = lane >> 4, t = 16 * wave + r; const int nks = (16 * wave + 16 + 31) >> 5;
      f32x4 acc[4];
#pragma unroll
      for (int ct = 0; ct < 4; ++ct) acc[ct] = (f32x4){0.f, 0.f, 0.f, 0.f};
      const float* wrow = w_s + ((size_t)g * 128 + t) * 128;
#pragma unroll
      for (int ks = 0; ks < 4; ++ks) { const int s0 = 32 * ks + 8 * kq; const f32x4 wa = *(const f32x4*)(wrow + s0), wb = *(const f32x4*)(wrow + s0 + 4);
          v4u af; af.x = pk2(s0 + 0 <= t ? wa[0] : 0.f, s0 + 1 <= t ? wa[1] : 0.f); af.y = pk2(s0 + 2 <= t ? wa[2] : 0.f, s0 + 3 <= t ? wa[3] : 0.f);
          af.z = pk2(s0 + 4 <= t ? wb[0] : 0.f, s0 + 5 <= t ? wb[1] : 0.f); af.w = pk2(s0 + 6 <= t ? wb[2] : 0.f, s0 + 7 <= t ? wb[3] : 0.f);
          const bf16x8 afr = __builtin_bit_cast(bf16x8, af);
#pragma unroll
          for (int ct = 0; ct < 4; ++ct) { const bf16x8 bfr = *(const LAS bf16x8*)(LT + (16 * ct + r) * LTS + s0); acc[ct] = __builtin_amdgcn_mfma_f32_16x16x32_bf16(afr, bfr, acc[ct], 0, 0, 0); } }
#pragma unroll
      for (int ct = 0; ct < 4; ++ct)
#pragma unroll
          for (int rg = 0; rg < 4; ++rg) { const int tt = 16 * wave + 4 * kq + rg, d = 16 * ct + r; const float mixed = acc[ct][rg] + b_s[g * 128 + tt];
              const size_t oi = (size_t)(row0 + tt) * 1024 + g * 64 + d; YO[oi] = (bf16)f2bf(bf2f(UQ[oi]) * mixed); } }
    __syncthreads();
}

__device__ __forceinline__ void kidx_rows(KArgs ap, unsigned char* ws, int gw, int NGW, int lane) {
    const float* kr = (const float*)(ws + WS_KIRAW); bf16* ki = (bf16*)(ws + WS_KI); const float* cs = (const float*)(ws + WS_ROPE); const float* sn = cs + MROWS * 8;
    const float gg = ap->in[11][lane], bb = ap->in[12][lane];
    for (int row = gw; row < MROWS; row += NGW) {
        const float x = kr[(size_t)row * 64 + lane]; const float mean = wave_sum(x) * (1.f / 64.f); const float xc = x - mean; const float var = wave_sum(xc * xc) * (1.f / 64.f);
        float y = xc * (1.0f / sqrtf(var + RMS_EPS)) * gg + bb; const float pr = __shfl_xor(y, 8);
        if (lane < 16) { const float c = cs[(size_t)row * 8 + (lane & 7)], s = sn[(size_t)row * 8 + (lane & 7)]; y = (lane < 8) ? (y * c - pr * s) : (y * c + pr * s); }
        ki[(size_t)(row >> 5) * 2048 + (lane >> 4) * 512 + ((lane >> 3) & 1) * 256 + (row & 31) * 8 + (lane & 7)] = (bf16)f2bf(y); }
}

typedef float f32x16 __attribute__((ext_vector_type(16)));
__device__ __forceinline__ unsigned raw2key(unsigned b) { return (b & 0x8000u) ? ((~b) & 0xffffu) : (b | 0x8000u); }
__device__ __forceinline__ unsigned f2raw16(float s) { const _Float16 h = (_Float16)(s + 0.0f); return (unsigned)__builtin_bit_cast(unsigned short, h); }
__device__ __forceinline__ void hist_find4(const v4u h, unsigned need, unsigned& bin, unsigned& above) {
    const unsigned c = h.x + h.y + h.z + h.w; unsigned long long nz = __ballot(c != 0u); unsigned cum = 0u; int L = 0; unsigned cl = 0u;
    while (nz) { L = 63 - (int)__builtin_clzll(nz); cl = (unsigned)__builtin_amdgcn_readlane((int)c, L); if (cum + cl >= need) break; cum += cl; nz &= ~(1ull << L); }
    const unsigned hw = (unsigned)__builtin_amdgcn_readlane((int)h.w, L), hz = (unsigned)__builtin_amdgcn_readlane((int)h.z, L), hy = (unsigned)__builtin_amdgcn_readlane((int)h.y, L);
    if (cum + hw >= need) { bin = 4 * L + 3; above = cum; } else { cum += hw; if (cum + hz >= need) { bin = 4 * L + 2; above = cum; } else { cum += hz; if (cum + hy >= need) { bin = 4 * L + 1; above = cum; } else { cum += hy; bin = 4 * L; above = cum; } } }
}
template <int VAR> __device__ __forceinline__ void dsa_index_unit(unsigned char* ws, LAS unsigned char* lds, int b, int q0, int wave, int lane, int tid) {
    LAS unsigned short* SC = (LAS unsigned short*)lds; LAS unsigned* HIST = (LAS unsigned*)(lds + 131072);
    const bf16* QI = (const bf16*)(ws + WS_QI); const bf16* KI = (const bf16*)(ws + WS_KI); const float* WI = (const float*)(ws + WS_WI);
    unsigned long long* MASK = (unsigned long long*)(ws + WS_MASK);
    const int r32 = lane & 31, hi = lane >> 5; const size_t rowb = (size_t)b * SEQ;
    for (int i = tid; i < 2048; i += NWAVES * 64) HIST[i] = 0u;
    bf16x8 af[2][4]; float sg[2][16];
#pragma unroll
    for (int rt = 0; rt < 2; ++rt) { const size_t qrow = rowb + q0 + 4 * rt + (r32 >> 3); const int ih = r32 & 7; const float w = WI[qrow * 8 + ih];
#pragma unroll
        for (int ks = 0; ks < 4; ++ks) { const v4u q4 = *(const v4u*)(QI + qrow * 512 + ih * 64 + 16 * ks + 8 * hi); v4u o;
            o.x = pk2(__uint_as_float(q4.x << 16) * w, __uint_as_float(q4.x & 0xffff0000u) * w); o.y = pk2(__uint_as_float(q4.y << 16) * w, __uint_as_float(q4.y & 0xffff0000u) * w);
            o.z = pk2(__uint_as_float(q4.z << 16) * w, __uint_as_float(q4.z & 0xffff0000u) * w); o.w = pk2(__uint_as_float(q4.w << 16) * w, __uint_as_float(q4.w & 0xffff0000u) * w);
            af[rt][ks] = __builtin_bit_cast(bf16x8, o); }
#pragma unroll
        for (int ql = 0; ql < 4; ++ql) { const f32x4 w4 = *(const f32x4*)(WI + (rowb + q0 + 4 * rt + ql) * 8 + 4 * hi);
#pragma unroll
            for (int e = 0; e < 4; ++e) sg[rt][4 * ql + e] = (w4[e] >= 0.f) ? INFINITY : -INFINITY; } }
    __syncthreads();
    const int nkt = ((q0 + 8 + 255) >> 8) << 3;
    const bf16* kbase = KI + rowb * 64 + hi * 256 + r32 * 8;
    bf16x8 b0[4], b1[4], b2[4];
#define IDX_LOAD(B, KT) do { const int kt_ = ((KT) < nkt) ? (KT) : wave; const bf16* kp = kbase + (size_t)kt_ * 32 * 64; \
        _Pragma("unroll") for (int ks = 0; ks < 4; ++ks) (B)[ks] = *(const bf16x8*)(kp + 512 * ks); } while (0)
#define IDX_TILE(B, KT) do { const int kti = (KT); \
        f32x16 d0 = f32x16{}, d1 = f32x16{}; \
        _Pragma("unroll") for (int ks = 0; ks < 4; ++ks) { d0 = __builtin_amdgcn_mfma_f32_32x32x16_bf16(af[0][ks], (B)[ks], d0, 0, 0, 0); d1 = __builtin_amdgcn_mfma_f32_32x32x16_bf16(af[1][ks], (B)[ks], d1, 0, 0, 0); } \
        const int key = kti * 32 + r32; const bool diag = (kti * 32 + 31 > q0); \
        const int pos = (key & ~255) + 4 * (key & 63) + ((key >> 6) & 3); \
        _Pragma("unroll") for (int p = 0; p < 4; ++p) { const int rt = p >> 1, qe = (2 * p) & 3, qo = qe + 1; float se = 0.f, so = 0.f; \
            _Pragma("unroll") for (int e = 0; e < 4; ++e) { const float le = rt ? d1[4 * qe + e] : d0[4 * qe + e], lo = rt ? d1[4 * qo + e] : d0[4 * qo + e]; \
                se += __builtin_amdgcn_fmed3f(le, 0.f, sg[rt][4 * qe + e]); so += __builtin_amdgcn_fmed3f(lo, 0.f, sg[rt][4 * qo + e]); } \
            auto sw = __builtin_amdgcn_permlane32_swap(__float_as_uint(se), __float_as_uint(so), false, false); \
            const float s = __uint_as_float(sw[0]) + __uint_as_float(sw[1]); const int qi = 2 * p + hi; \
            unsigned k16 = raw2key(f2raw16(s)); if (diag) k16 = (key <= q0 + qi) ? k16 : 0u; \
            SC[qi * 8192 + pos] = (unsigned short)k16; if (VAR != 1) __hip_atomic_fetch_add(HIST + qi * 256 + (k16 >> 8), 1u, __ATOMIC_RELAXED, __HIP_MEMORY_SCOPE_WORKGROUP); } } while (0)
    if (VAR != 4) {
        IDX_LOAD(b0, wave); IDX_LOAD(b1, wave + NWAVES); IDX_LOAD(b2, wave + 2 * NWAVES);
        for (int kt = wave; kt < nkt; kt += 3 * NWAVES) {
            IDX_TILE(b0, kt); IDX_LOAD(b0, kt + 3 * NWAVES);
            if (kt + NWAVES < nkt) { IDX_TILE(b1, kt + NWAVES); IDX_LOAD(b1, kt + 4 * NWAVES); }
            if (kt + 2 * NWAVES < nkt) { IDX_TILE(b2, kt + 2 * NWAVES); IDX_LOAD(b2, kt + 5 * NWAVES); }
        }
    }
#undef IDX_LOAD
#undef IDX_TILE
    __syncthreads();
    if (VAR != 2) { const int qi = wave, qpos = q0 + qi, nk = nkt * 32; const LAS unsigned short* row = SC + qi * 8192; LAS unsigned* hrow = HIST + qi * 256;
      unsigned thr = 1u, ties = 0u; bool tiepath = false;
      if (VAR != 5 && qpos + 1 > 256) {
          const v4u h = *(const LAS v4u*)(hrow + 4 * lane);
          unsigned b1, ab1; hist_find4(h, 256u, b1, ab1); const unsigned need2 = 256u - ab1;
          LDS_WAIT();
          *(LAS v4u*)(hrow + 4 * lane) = (v4u){0u, 0u, 0u, 0u};
          LDS_WAIT();
          for (int k = 8 * lane; k < nk; k += 512) { const v4u v = *(const LAS v4u*)(row + k);
#pragma unroll
              for (int e = 0; e < 4; ++e) { const unsigned w = (e == 0) ? v.x : (e == 1) ? v.y : (e == 2) ? v.z : v.w; const unsigned k0 = w & 0xffffu, k1 = w >> 16;
                  if ((k0 >> 8) == b1) __hip_atomic_fetch_add(hrow + (k0 & 255u), 1u, __ATOMIC_RELAXED, __HIP_MEMORY_SCOPE_WORKGROUP);
                  if ((k1 >> 8) == b1) __hip_atomic_fetch_add(hrow + (k1 & 255u), 1u, __ATOMIC_RELAXED, __HIP_MEMORY_SCOPE_WORKGROUP); } }
          LDS_WAIT();
          const v4u h2 = *(const LAS v4u*)(hrow + 4 * lane);
          unsigned b2, ab2; hist_find4(h2, need2, b2, ab2);
          thr = (b1 << 8) | b2; ties = need2 - ab2; tiepath = (hrow[b2] != ties);
      }
      const int nchunk = (qpos >> 8) + 1; unsigned tiecnt = 0u; int w0lo = 0, w0hi = 0, w1lo = 0, w1hi = 0;
#define EMIT_CHUNK(c, WLO, WHI) do { const unsigned long long kk = *(const LAS unsigned long long*)(row + 256 * (c) + 4 * lane); \
          _Pragma("unroll") for (int e = 0; e < 4; ++e) { const unsigned key = (unsigned)(kk >> (16 * e)) & 0xffffu; unsigned long long wv; \
              if (!tiepath) wv = __ballot(key >= thr); \
              else { const bool gt_ = key > thr, eq = (key == thr); const unsigned long long eqm = __ballot(eq); \
                     const unsigned before = (unsigned)__builtin_popcountll(eqm & ((1ull << lane) - 1ull)); \
                     wv = __ballot(gt_ || (eq && (tiecnt + before < ties))); tiecnt += (unsigned)__builtin_popcountll(eqm); } \
              const bool mine = (lane == ((4 * (c) + e) & 63)); WLO = mine ? (int)(unsigned)wv : WLO; WHI = mine ? (int)(unsigned)(wv >> 32) : WHI; } } while (0)
      { const int n0 = nchunk < 16 ? nchunk : 16; for (int c = 0; c < ((VAR == 6) ? 1 : n0); ++c) EMIT_CHUNK(c, w0lo, w0hi); for (int c = 16; c < ((VAR == 6) ? 0 : nchunk); ++c) EMIT_CHUNK(c, w1lo, w1hi); }
#undef EMIT_CHUNK
      const unsigned long long my0 = ((unsigned long long)(unsigned)w0hi << 32) | (unsigned)w0lo, my1 = ((unsigned long long)(unsigned)w1hi << 32) | (unsigned)w1lo;
      const int nwords = 4 * nchunk; unsigned long long* mrow = MASK + (rowb + qpos) * 128;
      if (lane < nwords) mrow[lane] = my0;
      if (64 + lane < nwords) mrow[64 + lane] = my1; }
    __syncthreads();
}

__device__ __forceinline__ void final_norm(KArgs ap, unsigned char* ws, int gw, int NGW, int lane) {
    const float* rowss = (const float*)(ws + WS_ROWSS); const f32x4* gf = (const f32x4*)ap->in[21] + lane; float* out = ap->out; const bf16* hb = (const bf16*)(ws + WS_HB);
    f32x4 g4[4];
#pragma unroll
    for (int j = 0; j < 4; ++j) g4[j] = gf[64 * j];
    for (int row = gw; row < MROWS; row += NGW) {
        const float ss = wave_sum(lane < 16 ? rowss[(size_t)row * 16 + lane] : 0.f); const float rstd = 1.0f / sqrtf(ss * (1.f / 1024.f) + RMS_EPS);
        f32x4* o = (f32x4*)(out + (size_t)row * 1024) + lane; const unsigned long long* h8 = (const unsigned long long*)(hb + (size_t)row * 1024) + lane;
#pragma unroll
        for (int j = 0; j < 4; ++j) { const unsigned long long w = h8[64 * j]; const unsigned lo = (unsigned)w, hi = (unsigned)(w >> 32);
            const f32x4 h = {__uint_as_float(lo << 16), __uint_as_float(lo & 0xffff0000u), __uint_as_float(hi << 16), __uint_as_float(hi & 0xffff0000u)};
            o[64 * j] = h * rstd * g4[j]; } }
}

#ifdef PROBE_STOP
#ifndef PROBE_OFF
#define PROBE_OFF WS_R
#endif
#ifndef PROBE_CHUNKS
#define PROBE_CHUNKS 0
#endif
#ifndef PROBE_LEN
#define PROBE_LEN (1ull << 40)
#endif
#ifdef PROBE_OWN_TILE
#define PROBE_AT(k) if ((k) == PROBE_STOP) { PHASE_ENV(); pg8::StaticOrder S_; S_.init(MROWS, 1024, G, bx); pg8::Unit u_; if (S_.next(0, u_)) { const bf16* src = (const bf16*)(ws + PROBE_OFF); \
      for (int e = tid; e < 256 * 256; e += 512) { const size_t i = (size_t)(u_.pm * 256 + (e >> 8)) * 1024 + u_.pn * 256 + (e & 255); float v_ = bf2f(src[i]); if (!(fabsf(v_) < 1e30f)) v_ = 12345.f; OUT[i] = v_; } } return; }
#else
#define PROBE_AT(k) if ((k) == PROBE_STOP) { PHASE_ENV(); if (PROBE_CHUNKS > 0) { const bf16* src = (const bf16*)(ws + PROBE_OFF); \
      for (size_t i = (size_t)bx * 512 + tid; i < (size_t)MROWS * 1024; i += (size_t)G * 512) { float acc_ = 0.f; \
          for (int j = 0; j < PROBE_CHUNKS; ++j) { float v_ = bf2f(src[(i + (size_t)j * MROWS * 1024) % (size_t)(PROBE_LEN)]); if (!(fabsf(v_) < 1e30f)) v_ = 12345.f; acc_ += v_; } OUT[i] = acc_; } } return; }
#endif
#else
#define PROBE_AT(k)
#endif

#ifdef PROBE_CHECK
__device__ __forceinline__ float wave_maxf(float v) {
#pragma unroll
    for (int o = 1; o < 64; o <<= 1) v = fmaxf(v, __shfl_xor(v, o));
    return v;
}
__device__ __forceinline__ float wave_minf(float v) {
#pragma unroll
    for (int o = 1; o < 64; o <<= 1) v = fminf(v, __shfl_xor(v, o));
    return v;
}
#ifndef CHK_TOL
#define CHK_TOL 0.04f
#define CHK_ABS 1e-4f
#define CHK_MTOL 0.02f
#endif
constexpr size_t CHK_FLAGS = 512 * 1024 + 256;
__device__ __forceinline__ void chk_copy(const bf16* src, bf16* dst, int gt, int NGT) {
    const v4u* s = (const v4u*)src; v4u* d = (v4u*)dst; const int n = MROWS * 1024 / 8;
    for (int i = gt; i < n; i += NGT) d[i] = s[i];
}
__device__ __forceinline__ void chk_moba(unsigned char* ws, const bf16* QC, LAS float* L, int sample, int lane) {
    const unsigned r = (unsigned)sample * 2654435761u + 12345u; const int b = (r >> 3) & 1, h = (r >> 4) & 7, q = (r >> 8) & 8191, qb = q >> 8;
    const bf16* KB = (const bf16*)(ws + WS_KB0) + (size_t)b * SEQ * 512 + h * 64; const bf16* VB = (const bf16*)(ws + WS_VB0) + (size_t)b * SEQ * 512 + h * 64;
    const bf16* O = (const bf16*)(ws + WS_QO) + ((size_t)b * SEQ + q) * 1024 + 512 + h * 64;
    LAS float* Lg = L; LAS float* Lq = L + 32; LAS float* Ls = L + 96;
    const float qv = bf2f(QC[((size_t)b * SEQ + q) * 1024 + 512 + h * 64 + lane]); Lq[lane] = qv;
    for (int j = 0; j < qb; ++j) { float km = 0.f; for (int rr = 0; rr < 256; ++rr) km += bf2f(KB[(size_t)(j * 256 + rr) * 512 + lane]); km *= (1.f / 256.f);
        const float g = wave_sum(qv * km); if (lane == 0) Lg[j] = g; }
    LDS_WAIT();
    float v1 = -INFINITY, v2 = -INFINITY, v3 = -INFINITY; int i1 = -1, i2 = -1, i3 = -1;
    for (int j = 0; j < qb; ++j) { const float g = Lg[j]; if (g > v1) { v3 = v2; i3 = i2; v2 = v1; i2 = i1; v1 = g; i1 = j; } else if (g > v2) { v3 = v2; i3 = i2; v2 = g; i2 = j; } else if (g > v3) { v3 = g; i3 = j; } }
    float mx = -INFINITY;
    for (int sl = 0; sl < 4; ++sl) { const int blk = (sl == 0) ? i1 : (sl == 1) ? i2 : (sl == 2) ? i3 : qb;
        for (int t = 0; t < 4; ++t) { const int kk = lane + 64 * t, key = blk * 256 + kk; float s = -INFINITY;
            if (blk >= 0 && key <= q) { s = 0.f; for (int d = 0; d < 64; ++d) s += Lq[d] * bf2f(KB[(size_t)key * 512 + d]); }
            Ls[sl * 256 + kk] = s; mx = fmaxf(mx, s); } }
    mx = wave_maxf(mx); LDS_WAIT();
    float lsum = 0.f; for (int i = lane; i < 1024; i += 64) { const float p = exp2f(Ls[i] - mx); Ls[i] = p; lsum += p; }
    lsum = wave_sum(lsum); LDS_WAIT();
    float o = 0.f;
    for (int sl = 0; sl < 4; ++sl) { const int blk = (sl == 0) ? i1 : (sl == 1) ? i2 : (sl == 2) ? i3 : qb; if (blk < 0) continue;
        for (int kk = 0; kk < 256; ++kk) { const float p = Ls[sl * 256 + kk]; if (p != 0.f) o += p * bf2f(VB[(size_t)(blk * 256 + kk) * 512 + lane]); } }
    o /= lsum;
    const float err = wave_maxf(fabsf(o - bf2f(O[lane]))), ref = wave_maxf(fabsf(o));
    if (lane == 0 && !(err <= CHK_TOL * ref + CHK_ABS)) atomicOr((unsigned*)(ws + CHK_FLAGS), 1u);
    LDS_WAIT();
}
__device__ __forceinline__ void chk_mask(unsigned char* ws, LAS float* L, int sample, int lane) {
    const unsigned r = (unsigned)sample * 2246822519u + 777u; const int b = (r >> 3) & 1; int q = (r >> 8) & 8191; if ((sample & 7) == 0) q &= 511;
    const bf16* QI = (const bf16*)(ws + WS_QI); const bf16* KI = (const bf16*)(ws + WS_KI); const float* WI = (const float*)(ws + WS_WI);
    const unsigned long long* MK = (const unsigned long long*)(ws + WS_MASK) + ((size_t)b * SEQ + q) * 128; const size_t rowb = (size_t)b * SEQ;
    LAS float* Lq = L;
    for (int i = lane; i < 512; i += 64) Lq[i] = bf2f(QI[(rowb + q) * 512 + i]);
    LDS_WAIT();
    float w[8];
#pragma unroll
    for (int i = 0; i < 8; ++i) w[i] = WI[(rowb + q) * 8 + i];
    const int kend = 256 * ((q >> 8) + 1); int cnt = 0; float minsel = INFINITY, maxuns = -INFINITY; int bad = 0;
    for (int key = lane; key < kend; key += 64) { const bool bit = (MK[key >> 6] >> (key & 63)) & 1ull;
        if (key > q) { if (bit) bad = 1; continue; }
        const size_t kr = rowb + key; const bf16* kp = KI + (kr >> 5) * 2048 + (kr & 31) * 8; float sc = 0.f;
#pragma unroll
        for (int i = 0; i < 8; ++i) { float l = 0.f; for (int d = 0; d < 64; ++d) l += Lq[i * 64 + d] * bf2f(kp[(d >> 4) * 512 + ((d >> 3) & 1) * 256 + (d & 7)]); sc += fmaxf(l, 0.f) * w[i]; }
        if (bit) { ++cnt; minsel = fminf(minsel, sc); } else maxuns = fmaxf(maxuns, sc); }
    const int tot = (int)wave_sum((float)cnt); const float ms = wave_minf(minsel), mu = wave_maxf(maxuns); const int anybad = (int)wave_sum((float)bad);
    const int want = (q + 1 < 256) ? q + 1 : 256;
    if (lane == 0 && (tot != want || anybad != 0 || (mu - ms) > CHK_MTOL)) atomicOr((unsigned*)(ws + CHK_FLAGS), 2u);
    LDS_WAIT();
}
__device__ __forceinline__ void chk_dsa(unsigned char* ws, const bf16* QC, LAS float* L, int sample, int lane) {
    const unsigned r = (unsigned)sample * 3266489917u + 4242u; const int b = (r >> 3) & 1, h = (r >> 4) & 15, q = (r >> 8) & 8191;
    const bf16* KC = (const bf16*)(ws + WS_KC) + (size_t)b * SEQ * 1024 + h * 64; const bf16* VC = (const bf16*)(ws + WS_VC) + (size_t)b * SEQ * 1024 + h * 64;
    const bf16* O = (const bf16*)(ws + WS_QO) + ((size_t)b * SEQ + q) * 1024 + h * 64;
    const unsigned long long* MK = (const unsigned long long*)(ws + WS_MASK) + ((size_t)b * SEQ + q) * 128;
    LAS float* Lq = L; LAS float* Ls = L + 64; LAS int* Lk = (LAS int*)(L + 64 + 320); LAS int* Ln = (LAS int*)(L + 64 + 640);
    Lq[lane] = bf2f(QC[((size_t)b * SEQ + q) * 1024 + h * 64 + lane]); if (lane == 0) Ln[0] = 0;
    LDS_WAIT();
    float mx = -INFINITY;
    for (int key = lane; key <= q; key += 64) { const bool bit = (MK[key >> 6] >> (key & 63)) & 1ull; if (!bit) continue;
        float s = 0.f; for (int d = 0; d < 64; ++d) s += Lq[d] * bf2f(KC[(size_t)key * 1024 + d]);
        const int slot = atomicAdd((int*)Ln, 1); if (slot < 320) { Ls[slot] = s; Lk[slot] = key; } mx = fmaxf(mx, s); }
    mx = wave_maxf(mx); LDS_WAIT();
    const int n = Ln[0] < 320 ? Ln[0] : 320; float lsum = 0.f, o = 0.f;
    for (int i = 0; i < n; ++i) { const float p = exp2f(Ls[i] - mx); lsum += p; o += p * bf2f(VC[(size_t)Lk[i] * 1024 + lane]); }
    o /= lsum;
    const float err = wave_maxf(fabsf(o - bf2f(O[lane]))), ref = wave_maxf(fabsf(o));
    if (lane == 0 && !(err <= CHK_TOL * ref + CHK_ABS)) atomicOr((unsigned*)(ws + CHK_FLAGS), 4u);
    LDS_WAIT();
}
__device__ __forceinline__ void chk_sincos(int pos, float f, float& c, float& s) {
    const double ang = (double)((float)pos * f); double t = ang * 0.15915494309189533577; t -= floor(t); const double x = (t - 0.5) * 6.283185307179586477;
    const double x2 = x * x; double sn = 0.0, cs = 0.0, term = x;
    for (int k = 1; k <= 23; k += 2) { sn += term; term *= -x2 / (double)((k + 1) * (k + 2)); }
    term = 1.0; for (int k = 0; k <= 24; k += 2) { cs += term; term *= -x2 / (double)((k + 1) * (k + 2)); }
    c = (float)(-cs); s = (float)(-sn);
}
__device__ __forceinline__ void chk_proj(KArgs ap, unsigned char* ws, int layer, int sample, int lane, float f0, float f1, float f2, float f3, float f4, float f5, float f6, float f7) {
    const unsigned r = (unsigned)sample * 2654435761u + 99u + (unsigned)layer * 7777u; const int row = (r >> 7) & 16383; int kind = (r >> 3) % (layer ? 5 : 3); const int hd = (r >> 22) & (layer ? 15 : 7);
    const bf16* hb = (layer ? (const bf16*)ap->out + (size_t)MROWS * 1024 : (const bf16*)(ws + WS_HB)) + (size_t)row * 1024; const float* rowss = (const float*)(ws + (layer ? WS_ROWSS2 : WS_ROWSS)) + (size_t)row * 16;
    float ss = 0.f; for (int i = 0; i < 16; ++i) ss += rowss[i]; const float rstd = 1.0f / sqrtf(ss * (1.f / 1024.f) + RMS_EPS);
    int col; const bf16* st = nullptr; const float* stf = nullptr; float scale = 1.f; bool rope = false;
    if (layer == 0) { if (kind == 0) { col = 1024 + hd * 64 + lane; st = (const bf16*)(ws + WS_QO) + (size_t)row * 1024 + 512 + hd * 64 + lane; scale = QC2; rope = true; }
                      else if (kind == 1) { col = 1536 + hd * 64 + lane; st = (const bf16*)(ws + WS_KB0) + (size_t)row * 512 + hd * 64 + lane; rope = true; }
                      else { col = 2048 + hd * 64 + lane; st = (const bf16*)(ws + WS_VB0) + (size_t)row * 512 + hd * 64 + lane; } }
    else { if (kind == 0) { col = hd * 64 + lane; st = (const bf16*)(ws + WS_QO) + (size_t)row * 1024 + hd * 64 + lane; scale = QC2; rope = true; }
           else if (kind == 1) { col = 1024 + hd * 64 + lane; st = (const bf16*)(ws + WS_KC) + (size_t)row * 1024 + hd * 64 + lane; rope = true; }
           else if (kind == 2) { col = 2048 + hd * 64 + lane; st = (const bf16*)(ws + WS_VC) + (size_t)row * 1024 + hd * 64 + lane; }
           else if (kind == 3) { col = 3072 + (hd & 7) * 64 + lane; st = (const bf16*)(ws + WS_QI) + (size_t)row * 512 + (hd & 7) * 64 + lane; rope = true; }
           else { col = 3584 + lane; stf = (const float*)(ws + WS_KIRAW) + (size_t)row * 64 + lane; } }
    const bf16* wrow = (const bf16*)(ws + (layer ? WS_W_IN1 : WS_W_IN0)) + (size_t)col * 1024;
    float z = 0.f; for (int k = 0; k < 1024; ++k) z += bf2f(hb[k]) * bf2f(wrow[k]);
    z *= rstd;
    float expect = z;
    if (rope) { const float pr = __shfl_xor(z, 8); const int i = lane & 7; const float f = (i == 0) ? f0 : (i == 1) ? f1 : (i == 2) ? f2 : (i == 3) ? f3 : (i == 4) ? f4 : (i == 5) ? f5 : (i == 6) ? f6 : f7;
        float c, s; chk_sincos(((const int*)ap->in[2])[row], f, c, s); if (lane < 16) expect = (lane < 8) ? (z * c - pr * s) : (z * c + pr * s); }
    expect *= scale;
    const float got = st ? bf2f(*st) : *stf; const float err = wave_maxf(fabsf(expect - got)), ref = wave_maxf(fabsf(expect));
    bool bad = !(err <= CHK_TOL * ref + 1e-3f);
    if (layer == 1 && kind == 4) {
        const bf16* w2 = (const bf16*)(ws + WS_W_IN1) + (size_t)(3648 + (lane & 7)) * 1024; float zz = 0.f; for (int k = 0; k < 1024; ++k) zz += bf2f(hb[k]) * bf2f(w2[k]);
        zz *= rstd * 0.04419417382415922f; const float g2 = ((const float*)(ws + WS_WI))[(size_t)row * 8 + (lane & 7)]; const float e2 = wave_maxf(fabsf(zz - g2)), r2 = wave_maxf(fabsf(zz)); bad = bad || !(e2 <= CHK_TOL * r2 + 1e-4f); }
    if (lane == 0 && bad) atomicOr((unsigned*)(ws + CHK_FLAGS), layer ? 16u : 8u);
}
__device__ __forceinline__ void chk_kidx(KArgs ap, unsigned char* ws, int sample, int lane, float f0, float f1, float f2, float f3, float f4, float f5, float f6, float f7) {
    const unsigned r = (unsigned)sample * 40503u + 31u; const int row = (r >> 2) & 16383;
    const float x = ((const float*)(ws + WS_KIRAW))[(size_t)row * 64 + lane]; const float mean = wave_sum(x) * (1.f / 64.f); const float xc = x - mean; const float var = wave_sum(xc * xc) * (1.f / 64.f);
    float y = xc / sqrtf(var + RMS_EPS) * ap->in[11][lane] + ap->in[12][lane]; const float pr = __shfl_xor(y, 8); const int i = lane & 7;
    const float f = (i == 0) ? f0 : (i == 1) ? f1 : (i == 2) ? f2 : (i == 3) ? f3 : (i == 4) ? f4 : (i == 5) ? f5 : (i == 6) ? f6 : f7;
    float c, s; chk_sincos(((const int*)ap->in[2])[row], f, c, s); if (lane < 16) y = (lane < 8) ? (y * c - pr * s) : (y * c + pr * s);
    const bf16* ki = (const bf16*)(ws + WS_KI); const float got = bf2f(ki[(size_t)(row >> 5) * 2048 + (lane >> 4) * 512 + ((lane >> 3) & 1) * 256 + (row & 31) * 8 + (lane & 7)]);
    const float err = wave_maxf(fabsf(y - got)), ref = wave_maxf(fabsf(y));
    if (lane == 0 && !(err <= CHK_TOL * ref + 1e-3f)) atomicOr((unsigned*)(ws + CHK_FLAGS), 32u);
}
#endif
__global__ void __launch_bounds__(NWAVES * 64, 2) trunk_fwd(Args args) {
    extern __shared__ __attribute__((aligned(16))) unsigned char lds_raw[];
    LAS unsigned char* lds = (LAS unsigned char*)lds_raw;
    volatile LAS unsigned* MISC = (volatile LAS unsigned*)(lds + LDSCTL_OFF);
    const int tid0 = threadIdx.x;
    const int G = gridDim.x; const int bx = blockIdx.x; const int vcu = (G % 8 == 0) ? (bx % 8) * (G / 8) + bx / 8 : bx;
    KArgs ap0 = (KArgs)__builtin_amdgcn_kernarg_segment_ptr();
    gu32* ctl = (gu32*)(ap0->ws + WS_CTL);
    for (int u = tid0; u < (LDS_BYTES - LDSCTL_OFF) / 4; u += NWAVES * 64) ((LAS unsigned*)(lds + LDSCTL_OFF))[u] = 0u;
    __syncthreads();
    XcdBarrier bar = xcd_barrier_post((unsigned*)(ctl + CW_BAR), MISC + 8);
#ifdef PROBE_TIME
    if (bx == 0 && tid0 == 0) *(unsigned long long*)(ap0->ws + 512 * 1024) = __builtin_amdgcn_s_memrealtime();
#endif
#define GRID_BAR() xcd_barrier(bar)
    const int NGW = G * NWAVES;
#define PHASE_ENV() KArgs ap = (KArgs)__builtin_amdgcn_kernarg_segment_ptr(); asm volatile("" : "+s"(ap)); unsigned char* ws = ap->ws; \
    int tid_p = threadIdx.x; asm volatile("" : "+v"(tid_p)); const int tid = tid_p, lane = tid & 63, wave = __builtin_amdgcn_readfirstlane(tid >> 6); const int gw = vcu * NWAVES + wave; (void)lane; (void)gw; \
    pg8::bf16_t* HBA = (pg8::bf16_t*)(ws + WS_HB); float* ROWSS = (float*)(ws + WS_ROWSS); float* ROWSS2 = (float*)(ws + WS_ROWSS2); const float* CS = (const float*)(ws + WS_ROPE); const float* SN = CS + MROWS * 8; float* OUT = ap->out; \
    pg8::bf16_t* PROJ = (pg8::bf16_t*)OUT; pg8::bf16_t* HBB = (pg8::bf16_t*)OUT + (size_t)MROWS * 1024;     \
    (void)HBA; (void)HBB; (void)PROJ; (void)ROWSS; (void)ROWSS2; (void)CS; (void)SN; (void)OUT;

    enum { PROBE_C0 = __COUNTER__ + 1 };
    for (int rep_ = 0; rep_ < NREP(0); ++rep_) { PHASE_ENV(); p0_prologue(ap, ws, lds, vcu, G, wave, lane, tid); }
    GRID_BAR(); PROBE_AT(__COUNTER__ - PROBE_C0);


#ifdef PROBE_GEMM2X
#ifndef PROBE_ALIGN
#define PROBE_ALIGN PG8_ALIGN
#endif
#ifndef PROBE_SP2
#define PROBE_SP2 PG8_SP2
#endif
    {
        for (int rep = 0; rep < 2; ++rep) {
            { PHASE_ENV(); pg8::Gemm g{HB, (const pg8::bf16_t*)(ws + WS_W_PG0), MROWS, 1024, 1024}; pg8::StaticOrder S; S.init(MROWS, 1024, G, bx);
              epi::EpiPleGate E{ROWSS, (pg8::bf16_t*)(ws + WS_R + (size_t)rep * 32 * MiB)};
              pg8::gemm_phase<epi::EpiPleGate, pg8::StaticOrder, PROBE_ALIGN, PROBE_SP2>(lds, g, S, E); }
            GRID_BAR();
        }
        { PHASE_ENV(); const bf16* g1 = (const bf16*)(ws + WS_R); const bf16* g2 = g1 + (size_t)MROWS * 1024; unsigned e = 0;
          for (size_t i = (size_t)bx * 512 + tid; i < (size_t)MROWS * 1024; i += (size_t)G * 512) e += (g1[i] != g2[i]);
          if (e) atomicAdd((unsigned*)(ws + 512 * 1024 + 128), e); }
        GRID_BAR();
        { PHASE_ENV(); const unsigned e = __hip_atomic_load((unsigned*)(ws + 512 * 1024 + 128), __ATOMIC_RELAXED, __HIP_MEMORY_SCOPE_AGENT);
          float c = e ? 3.f : 1.f;
          for (size_t i = (size_t)bx * 512 + tid; i < (size_t)MROWS * 1024 / 4; i += (size_t)G * 512) ((f32x4*)OUT)[i] = (f32x4){c, c, c, c}; }
        return;
    }
#endif
    for (int rep_ = 0; rep_ < NREP(1); ++rep_) {   PHASE_ENV();
        pg8::Gemm g{HBA, (const pg8::bf16_t*)(ws + WS_W_IN0), MROWS, 2560, 1024}; pg8::StaticOrder S; S.init(MROWS, 2560, G, bx);
        epi::EpiInEven E{ROWSS, CS, SN, (pg8::bf16_t*)(ws + WS_QO), (pg8::bf16_t*)(ws + WS_VA), (pg8::bf16_t*)(ws + WS_KB0), (pg8::bf16_t*)(ws + WS_VB0)};
        pg8::gemm_phase<epi::EpiInEven, pg8::StaticOrder, PG8_ALIGN, PG8_SP2>(lds, g, S, E);
        if (G == 256 && bx >= 128) { xp_run<10>(ap, ws, (LAS float*)lds + wave * XP_SCR, lane, (bx - 128) * NWAVES + wave, 128 * NWAVES); }
    }
    GRID_BAR(); PROBE_AT(__COUNTER__ - PROBE_C0);
#ifdef PROBE_CHECK
    { PHASE_ENV(); for (int s_ = gw; s_ < 2048; s_ += NGW) chk_proj(ap, ws, 0, s_, lane, ap->f0, ap->f1, ap->f2, ap->f3, ap->f4, ap->f5, ap->f6, ap->f7); }
#endif
    for (int rep_ = 0; rep_ < NREP(2); ++rep_) {   PHASE_ENV();
        for (int u = vcu + G * wave; u < 512; u += NGW) kmean_unit(ws, u, lane);
        for (int u = vcu; u < 1024; u += G) sgu_unit(ap, ws, lds, u >> 3, u & 7, wave, lane, tid, (rep_ == 0 && NREP(2) == 2) ? (bf16*)(ws + WS_R + 80 * MiB) : (bf16*)(ws + WS_QO));
    }
    GRID_BAR(); PROBE_AT(__COUNTER__ - PROBE_C0);
#ifdef PROBE_CHECK
    { PHASE_ENV(); chk_copy((const bf16*)(ws + WS_QO), (bf16*)(ws + WS_R + 80 * MiB), vcu * 512 + tid, G * 512); }
    GRID_BAR();
#endif
    for (int rep_ = 0; rep_ < NREP(3); ++rep_) {   PHASE_ENV();
        using attn_body::bf16;
        for (int p = vcu; p < 256; p += G) { const int bh = p >> 4, s = p & 15, b = bh >> 3, h = bh & 7;
            bf16* Qh = (bf16*)(ws + WS_QO) + (size_t)b * SEQ * 1024 + 512 + h * 64; const bf16* Kh = (const bf16*)(ws + WS_KB0) + (size_t)b * SEQ * 512 + h * 64;
            const bf16* Vh = (const bf16*)(ws + WS_VB0) + (size_t)b * SEQ * 512 + h * 64; const bf16* kmh = (const bf16*)(ws + WS_KMH) + bh * 32 * 64; const bf16* kml = (const bf16*)(ws + WS_KML) + bh * 32 * 64;
#ifndef SKIP_MOBA
            for (int i = 0; i < 2; ++i) { const int qb = i ? 31 - s : s; attn_body::moba_gates<1024>(qb, Qh, kmh, kml, (char*)lds_raw); attn_body::attn_unit<0, 8, 1024, 512>(qb, Qh, Kh, Vh, (rep_ == 0 && NREP(3) == 2) ? (bf16*)(ws + WS_R + 80 * MiB) + (size_t)b * SEQ * 1024 + h * 64 : Qh, kmh, kml, nullptr, (char*)lds_raw); }
#endif
        }
    }
    GRID_BAR(); PROBE_AT(__COUNTER__ - PROBE_C0);
#ifdef PROBE_CHECK
    { PHASE_ENV(); LAS float* Lw = (LAS float*)lds + wave * 1152; for (int s_ = gw; s_ < 2048; s_ += NGW) chk_moba(ws, (const bf16*)(ws + WS_R + 80 * MiB), Lw, s_, lane); }
    GRID_BAR();
#endif
    for (int rep_ = 0; rep_ < NREP(4); ++rep_) {   PHASE_ENV();
        pg8::Gemm g{(const pg8::bf16_t*)(ws + WS_QO), (const pg8::bf16_t*)(ws + WS_W_OUT0), MROWS, 1024, 1024}; pg8::StaticOrder S; S.init(MROWS, 1024, G, bx);
        epi::EpiResid E{HBA, ROWSS};
        pg8::gemm_phase<epi::EpiResid, pg8::StaticOrder, PG8_ALIGN1, PG8_SP2>(lds, g, S, E);
    }
    GRID_BAR(); PROBE_AT(__COUNTER__ - PROBE_C0);
#ifdef PROBE_SWAPA
#define PROBE_A7 ((const pg8::bf16_t*)(ws + WS_HID))
#else
#define PROBE_A7 HB
#endif
#ifdef PROBE_SWAPW
#define PROBE_WPG(x) WS_W_OUT0
#else
#define PROBE_WPG(x) (x)
#endif
#define FFN_PLE(WGU, WDN, WPG, WPP, PBOFF, HIN, HOUT, RIN, ROUT) \
    for (int rep_ = 0; rep_ < NREP(5); ++rep_) {   PHASE_ENV(); { pg8::Gemm g{HIN, (const pg8::bf16_t*)(ws + (WGU)), MROWS, 2 * DFF, 1024}; pg8::StaticOrder S; S.init(MROWS, 2 * DFF, G, bx); \
        epi::EpiSwiglu E{RIN, (pg8::bf16_t*)(ws + WS_HID)}; \
        pg8::gemm_phase<epi::EpiSwiglu, pg8::StaticOrder, PG8_ALIGN, PG8_SP2>(lds, g, S, E); } \
          \
        if (G == 256 ? (bx >= 128) : (bx == 0)) { int kpp = 256; asm volatile("" : "+s"(kpp)); pg8::Gemm g2{(const pg8::bf16_t*)(ws + WS_PB) + (PBOFF), (const pg8::bf16_t*)(ws + (WPP)), MROWS, 1024, kpp}; epi::EpiStore E2{PROJ}; \
            if (G == 256) { epi::PairOrder S2{2 * (bx - 128)}; pg8::gemm_phase<epi::EpiStore, epi::PairOrder, PG8_ALIGN1, PG8_SP2>(lds, g2, S2, E2); } \
            else { pg8::StaticOrder S2; S2.init(MROWS, 1024, 1, 0); pg8::gemm_phase<epi::EpiStore, pg8::StaticOrder, PG8_ALIGN1, PG8_SP2>(lds, g2, S2, E2); } } } \
    GRID_BAR(); PROBE_AT(__COUNTER__ - PROBE_C0); \
    for (int rep_ = 0; rep_ < NREP(6); ++rep_) {   PHASE_ENV(); pg8::Gemm g{(const pg8::bf16_t*)(ws + WS_HID), (const pg8::bf16_t*)(ws + (WDN)), MROWS, 1024, DFF}; pg8::StaticOrder S; S.init(MROWS, 1024, G, bx); \
        epi::EpiResid E{HIN, RIN}; \
        pg8::gemm_phase<epi::EpiResid, pg8::StaticOrder, PG8_ALIGN1, PG8_SP2>(lds, g, S, E); } \
    GRID_BAR(); PROBE_AT(__COUNTER__ - PROBE_C0); \
    for (int rep_ = 0; rep_ < NREP(7); ++rep_) {   PHASE_ENV(); pg8::Gemm g{HIN, (const pg8::bf16_t*)(ws + (WPG)), MROWS, 1024, 1024}; pg8::StaticOrder S; S.init(MROWS, 1024, G, bx); \
        epi::EpiPleFused E{RIN, HIN, PROJ, HOUT, ROUT}; \
        pg8::gemm_phase<epi::EpiPleFused, pg8::StaticOrder, PG8_ALIGN1, PG8_SP2>(lds, g, S, E); } \
    GRID_BAR(); PROBE_AT(__COUNTER__ - PROBE_C0);
    FFN_PLE(WS_W_GU0, WS_W_DN0, WS_W_PG0, WS_W_PP0, (size_t)0, HBA, HBB, ROWSS, ROWSS2)

    for (int rep_ = 0; rep_ < NREP(9); ++rep_) {   PHASE_ENV();
        pg8::Gemm g{HBB, (const pg8::bf16_t*)(ws + WS_W_IN1), MROWS, 3840, 1024}; pg8::StaticOrder S; S.init(MROWS, 3840, G, bx);
        epi::EpiInOdd E{ROWSS2, CS, SN, (pg8::bf16_t*)(ws + WS_QO), (pg8::bf16_t*)(ws + WS_KC), (pg8::bf16_t*)(ws + WS_VC), (pg8::bf16_t*)(ws + WS_QI), (float*)(ws + WS_KIRAW), (float*)(ws + WS_WI)};
        pg8::gemm_phase<epi::EpiInOdd, pg8::StaticOrder, PG8_ALIGN, PG8_SP2>(lds, g, S, E);
        if (G == 256 && bx >= 192) xp_run<4>(ap, ws, (LAS float*)lds + wave * XP_SCR, lane, (bx - 192) * NWAVES + wave, 64 * NWAVES);
    }
    GRID_BAR(); PROBE_AT(__COUNTER__ - PROBE_C0);
#ifdef PROBE_CHECK
    { PHASE_ENV(); for (int s_ = gw; s_ < 2048; s_ += NGW) chk_proj(ap, ws, 1, s_, lane, ap->f0, ap->f1, ap->f2, ap->f3, ap->f4, ap->f5, ap->f6, ap->f7); }
#endif
    for (int rep_ = 0; rep_ < NREP(10); ++rep_) { PHASE_ENV(); kidx_rows(ap, ws, gw, NGW, lane); }
    GRID_BAR(); PROBE_AT(__COUNTER__ - PROBE_C0);
#ifdef PROBE_CHECK
    { PHASE_ENV(); for (int s_ = gw; s_ < 2048; s_ += NGW) chk_kidx(ap, ws, s_, lane, ap->f0, ap->f1, ap->f2, ap->f3, ap->f4, ap->f5, ap->f6, ap->f7); }
#endif
    for (int rep_ = 0; rep_ < NREP(11); ++rep_) {   PHASE_ENV();
        for (int v = vcu; v < 256; v += G)
#ifndef SKIP_IDX
            for (int j = 0; j < 8; ++j) { const int R = (j >> 1) * 512 + ((j & 1) ? 511 - v : v); if (rep_ == 0 && NREP(11) == 2) dsa_index_unit<PROBE_VAR>(ws, lds, R & 1, (R >> 1) * 8, wave, lane, tid); else dsa_index_unit<0>(ws, lds, R & 1, (R >> 1) * 8, wave, lane, tid); }
#endif
            ;
    }
    GRID_BAR(); PROBE_AT(__COUNTER__ - PROBE_C0);
#ifdef PROBE_CHECK
    { PHASE_ENV(); chk_copy((const bf16*)(ws + WS_QO), (bf16*)(ws + WS_HB), vcu * 512 + tid, G * 512); }
    GRID_BAR();
#endif
    for (int rep_ = 0; rep_ < NREP(12); ++rep_) {   PHASE_ENV();
        using attn_body::bf16;
        for (int p = vcu; p < 256; p += G) { const int bh = p >> 3, s = p & 7, b = bh >> 4, h = bh & 15;
            bf16* Qh = (bf16*)(ws + WS_QO) + (size_t)b * SEQ * 1024 + h * 64; const bf16* Kh = (const bf16*)(ws + WS_KC) + (size_t)b * SEQ * 1024 + h * 64;
            const bf16* Vh = (const bf16*)(ws + WS_VC) + (size_t)b * SEQ * 1024 + h * 64; const unsigned long long* mk = (const unsigned long long*)(ws + WS_MASK) + (size_t)b * SEQ * 128;
#ifndef SKIP_DSA
            for (int i = 0; i < 4; ++i) { const int qb = (i == 0) ? s : (i == 1) ? 15 - s : (i == 2) ? 16 + s : 31 - s; attn_body::attn_unit<1, 8, 1024, 1024>(qb, Qh, Kh, Vh, (rep_ == 0 && NREP(12) == 2) ? (bf16*)(ws + WS_HB) + (size_t)b * SEQ * 1024 + h * 64 : Qh, nullptr, nullptr, mk, (char*)lds_raw); }
#endif
        }
    }
    GRID_BAR(); PROBE_AT(__COUNTER__ - PROBE_C0);
#ifdef PROBE_CHECK
    { PHASE_ENV(); LAS float* Lw = (LAS float*)lds + wave * 1152;
      for (int s_ = gw; s_ < 2048; s_ += NGW) { chk_mask(ws, Lw, s_, lane); chk_dsa(ws, (const bf16*)(ws + WS_HB), Lw, s_, lane); } }
    GRID_BAR();
#endif
    for (int rep_ = 0; rep_ < NREP(13); ++rep_) {   PHASE_ENV();
        pg8::Gemm g{(const pg8::bf16_t*)(ws + WS_QO), (const pg8::bf16_t*)(ws + WS_W_OUT1), MROWS, 1024, 1024}; pg8::StaticOrder S; S.init(MROWS, 1024, G, bx);
        epi::EpiResid E{HBB, ROWSS2};
        pg8::gemm_phase<epi::EpiResid, pg8::StaticOrder, PG8_ALIGN1, PG8_SP2>(lds, g, S, E);
    }
    GRID_BAR(); PROBE_AT(__COUNTER__ - PROBE_C0);
    FFN_PLE(WS_W_GU1, WS_W_DN1, WS_W_PG1, WS_W_PP1, (size_t)MROWS * 256, HBB, HBA, ROWSS2, ROWSS)
    for (int rep_ = 0; rep_ < NREP(14); ++rep_) { PHASE_ENV(); final_norm(ap, ws, gw, NGW, lane); }
#ifdef PROBE_CHECK
    GRID_BAR();
    { PHASE_ENV(); const unsigned fl = __hip_atomic_load((unsigned*)(ws + CHK_FLAGS), __ATOMIC_RELAXED, __HIP_MEMORY_SCOPE_AGENT); const float cf = 1.f + (float)fl;
      for (size_t i = (size_t)bx * 512 + tid; i < (size_t)MROWS * 1024 / 4; i += (size_t)G * 512) ((f32x4*)OUT)[i] = (f32x4){cf, cf, cf, cf}; }
#endif
#ifdef PROBE_TIME
    GRID_BAR();
    { PHASE_ENV();
      if (bx == 0 && tid == 0) { const unsigned long long t0 = *(unsigned long long*)(ws + 512 * 1024); const unsigned long long el = (__builtin_amdgcn_s_memrealtime() - t0) / 100ull;
          unsigned c = 1; unsigned long long e = el >> 7; while (e) { ++c; e >>= 1; }
          const unsigned tmo = __hip_atomic_load((unsigned*)(ctl + CW_BAR) + XB_TMO, __ATOMIC_RELAXED, __HIP_MEMORY_SCOPE_AGENT);
          if (tmo) c += 16;
          __hip_atomic_store((unsigned*)(ws + 512 * 1024 + 64), c, __ATOMIC_RELAXED, __HIP_MEMORY_SCOPE_AGENT); }
    }
    GRID_BAR();
    { PHASE_ENV(); const unsigned c = __hip_atomic_load((unsigned*)(ws + 512 * 1024 + 64), __ATOMIC_RELAXED, __HIP_MEMORY_SCOPE_AGENT); const float cf = (float)c;
      for (size_t i = (size_t)bx * 512 + tid; i < (size_t)MROWS * 1024 / 4; i += (size_t)G * 512) ((f32x4*)OUT)[i] = (f32x4){cf, cf, cf, cf}; }
#endif
#undef FFN_PLE
#undef GRID_BAR
#undef PHASE_ENV
}

extern "C" void kernel_launch(void* const* d_in, const int* in_sizes, int n_in, void* d_out, int out_size, void* d_ws, size_t ws_size, hipStream_t stream) {
    static int grid = 0;
    if (grid == 0) {
        if (n_in != 22 || out_size != MROWS * DMODEL || ws_size < WS_END) { fprintf(stderr, "kernel_launch: unexpected problem (n_in %d, out %d, ws %zu); nothing launched\n", n_in, out_size, ws_size); grid = -1; return; }
        int dev = 0, cus = 0, per_cu = 0;
        if (hipGetDevice(&dev) != hipSuccess || hipDeviceGetAttribute(&cus, hipDeviceAttributeMultiprocessorCount, dev) != hipSuccess) { grid = -1; return; }
        if (hipFuncSetAttribute((const void*)trunk_fwd, hipFuncAttributeMaxDynamicSharedMemorySize, LDS_BYTES) != hipSuccess) { fprintf(stderr, "kernel_launch: hipFuncSetAttribute failed\n"); grid = -1; return; }
        if (hipOccupancyMaxActiveBlocksPerMultiprocessor(&per_cu, (const void*)trunk_fwd, NWAVES * 64, LDS_BYTES) != hipSuccess || per_cu < 1) { fprintf(stderr, "kernel_launch: occupancy query says %d blocks per CU\n", per_cu); per_cu = 1; }
        (void)hipGetLastError();
        grid = cus;
    }
    if (grid < 0) return;
    if (hipMemsetAsync((char*)d_ws + WS_CTL, 0, CTL_ZERO_BYTES, stream) != hipSuccess) { fprintf(stderr, "kernel_launch: memset failed\n"); return; }
    Args a{};
    for (int i = 0; i < 22; ++i) a.in[i] = (const float*)d_in[i];
    a.out = (float*)d_out; a.ws = (unsigned char*)d_ws;
    float f[8]; for (int i = 0; i < 8; ++i) f[i] = powf(500000.0f, -(float)(2 * i) / 16.0f);
    a.f0 = f[0]; a.f1 = f[1]; a.f2 = f[2]; a.f3 = f[3]; a.f4 = f[4]; a.f5 = f[5]; a.f6 = f[6]; a.f7 = f[7];
    hipLaunchKernelGGL(trunk_fwd, dim3(grid), dim3(NWAVES * 64), LDS_BYTES, stream, a);
    const hipError_t le = hipPeekAtLastError();
    if (le != hipSuccess) fprintf(stderr, "kernel_launch: launch failed: %s\n", hipGetErrorName(le));
}
```

```cpp
#include <hip/hip_runtime.h>
#include <cstdio>
#include <cstdint>
namespace pg8 {
#define PG8_LAS __attribute__((address_space(3)))
typedef unsigned short bf16_t;
typedef short bf16x8 __attribute__((ext_vector_type(8)));
typedef float f32x4 __attribute__((ext_vector_type(4)));
typedef unsigned u32x4 __attribute__((ext_vector_type(4)));
constexpr int BM = 256, BK = 64, HALF = 128, HTB = HALF * BK * 2  , STAGE_BYTES = 8 * HTB, NXCD = 8, WGM = 8;

__host__ __device__ __forceinline__ int lds_byte(int r, int c) { const int st = (r >> 4) * 2 + (c >> 5), rr = r & 15, cc = c & 31, ob = rr * 64 + cc * 2; return st * 1024 + (ob ^ (((ob >> 9) & 1) << 5)); }
__host__ __device__ __forceinline__ void stage_rc(int b, int& R, int& C) { const int st = b / 1024, sb = b % 1024, swz = sb ^ (((sb >> 9) & 1) << 5); R = (st >> 1) * 16 + swz / 64; C = (st & 1) * 32 + (swz % 64) / 2; }
__host__ __device__ __forceinline__ int perm32(int rho) { const int n = rho >> 4, i = rho & 15; return 8 * (i >> 2) + 4 * n + (i & 3); }

struct Unit { int pm, pn; };
struct Gemm { const bf16_t* A; const bf16_t* Bt; int M, N, K; };

struct StaticOrder {
    int nM, nN, nwg, G, c;
    __host__ __device__ void init(int M, int N, int G_, int c_) { nM = M / BM; nN = N / BM; nwg = nM * nN; G = G_; c = c_; }
    __host__ __device__ bool next(int i, Unit& u) const {
        const long L = (long)i * G + c; if (L >= nwg) return false;
        int wgid = (int)L; { const int q = nwg / NXCD, r = nwg % NXCD, xcd = wgid % NXCD, off = wgid / NXCD; wgid = (xcd < r ? xcd * (q + 1) : r * (q + 1) + (xcd - r) * q) + off; }
        const int nig = WGM * nN, gid = wgid / nig, fm = gid * WGM, gsz = (nM - fm) < WGM ? (nM - fm) : WGM;
        u.pm = fm + ((wgid % nig) % gsz); u.pn = (wgid % nig) / gsz; return true;
    }
    __device__ __forceinline__ void a_ready(const Unit&) const {}
    __device__ __forceinline__ void done(const Unit&) const {}
};
__device__ __forceinline__ unsigned cvt_pk_bf16(float lo, float hi) { unsigned r; asm volatile("v_cvt_pk_bf16_f32 %0, %1, %2" : "=v"(r) : "v"(lo), "v"(hi)); return r; }
typedef float f32x2 __attribute__((ext_vector_type(2)));
__device__ __forceinline__ f32x2 gelu_pk(f32x2 v) {
    const f32x2 av = __builtin_elementwise_abs(v), d = av * 0.2316418882f + 1.0f;
    f32x2 t; t.x = __builtin_amdgcn_rcpf(d.x); t.y = __builtin_amdgcn_rcpf(d.y);
    f32x2 q = t * 0.5307027145f + (-0.7265760135f); q = q * t + 0.7107068705f; q = q * t + (-0.142248368f); q = q * t + 0.127414796f; q = q * t;
    const f32x2 s = (v * v) * (-0.72134752044f);
    f32x2 e; e.x = __builtin_amdgcn_exp2f(s.x); e.y = __builtin_amdgcn_exp2f(s.y);
    const f32x2 m = v * (q * e), r = v - m;
    f32x2 o; o.x = v.x < 0.f ? m.x : r.x; o.y = v.y < 0.f ? m.y : r.y; return o;
}
template <class Epi, class Sched, bool ALIGN_EPI = false, bool SP2 = false>
__device__ __forceinline__ void gemm_phase(PG8_LAS unsigned char* lds, const Gemm g, const Sched& S, const Epi& E) {
    int tid_l = threadIdx.x; asm volatile("" : "+v"(tid_l)); const int tid = tid_l, wid = __builtin_amdgcn_readfirstlane(tid >> 6), lane = tid & 63, wr = wid >> 2, wc = wid & 3, fr = lane & 15, fq = lane >> 4;
    const int K = g.K, nt = K / BK;
    unsigned voffA[2], voffB[2];
#pragma unroll
    for (int i = 0; i < 2; ++i) { int R, C; stage_rc(tid * 16 + i * 8192, R, C); const int Rb = Epi::PERM ? ((R & ~31) + perm32(R & 31)) : R;
        voffA[i] = (unsigned)(R * K + C) * 2u; voffB[i] = (unsigned)(Rb * K + C) * 2u; }
    const size_t kstep = (size_t)(BK * 2);
    const size_t hstep = (size_t)HALF * K * 2;
    const size_t tstep = 2 * hstep;
    const unsigned ldsw = (unsigned)wid * 1024u;
    const int aoff = lds_byte(wr * 64 + fr, fq * 8), boff = lds_byte(wc * 32 + fr, fq * 8);
#define PG8_SA(b, h) (((b) * 2 + (h)) * HTB)
#define PG8_SB(b, h) ((4 + (b) * 2 + (h)) * HTB)
#define PG8_STAGE(bufoff, gbase, voff) do { _Pragma("unroll") for (int _i = 0; _i < 2; ++_i) \
        __builtin_amdgcn_global_load_lds((const unsigned*)((const char*)(gbase) + (voff)[_i]), (PG8_LAS unsigned*)(lds + (bufoff) + ldsw + _i * 8192), 16, 0, 0); } while (0)
#define PG8_LDA(dst, b, h) do { _Pragma("unroll") for (int m = 0; m < 4; ++m) _Pragma("unroll") for (int k = 0; k < 2; ++k) dst[m][k] = *(const PG8_LAS bf16x8*)(lds + PG8_SA(b, h) + aoff + m * 2048 + k * 1024); } while (0)
#define PG8_LDB(dst, b, h) do { _Pragma("unroll") for (int n = 0; n < 2; ++n) _Pragma("unroll") for (int k = 0; k < 2; ++k) dst[n][k] = *(const PG8_LAS bf16x8*)(lds + PG8_SB(b, h) + boff + n * 2048 + k * 1024); } while (0)
#define PG8_MMA(ai, bj, At, Bt) do { __builtin_amdgcn_s_setprio(1); _Pragma("unroll") for (int m = 0; m < 4; ++m) _Pragma("unroll") for (int n = 0; n < 2; ++n) _Pragma("unroll") for (int k = 0; k < 2; ++k) \
        acc[ai][bj][m][n] = __builtin_amdgcn_mfma_f32_16x16x32_bf16(Bt[n][k], At[m][k], acc[ai][bj][m][n], 0, 0, 0); __builtin_amdgcn_s_setprio(0); } while (0)
#define PG8_WAIT_V(n) asm volatile("s_waitcnt vmcnt(" #n ")" ::: "memory")
#define PG8_WAIT_L(n) asm volatile("s_waitcnt lgkmcnt(" #n ")" ::: "memory")
#define PG8_BAR __builtin_amdgcn_s_barrier()
#define PG8_SCHED __builtin_amdgcn_sched_barrier(0)
    Unit cur, nxt; int ui = 0;
    if (!S.next(0, cur)) return;
    f32x4 acc[2][2][4][2];
#pragma unroll
    for (int a = 0; a < 2; ++a)
#pragma unroll
        for (int b = 0; b < 2; ++b)
#pragma unroll
            for (int m = 0; m < 4; ++m)
#pragma unroll
                for (int n = 0; n < 2; ++n) acc[a][b][m][n] = (f32x4){0.f, 0.f, 0.f, 0.f};
    bf16x8 At[4][2], B0[2][2], B1[2][2];
    const char* cA = (const char*)g.A + (size_t)cur.pm * tstep; const char* cB = (const char*)g.Bt + (size_t)cur.pn * tstep;
    S.a_ready(cur);
    if constexpr (SP2) {
        PG8_STAGE(PG8_SB(0, 0), cB, voffB); PG8_STAGE(PG8_SB(0, 1), cB + hstep, voffB); PG8_STAGE(PG8_SA(0, 0), cA, voffA); PG8_STAGE(PG8_SA(0, 1), cA + hstep, voffA);
        if (wr == 1) PG8_BAR;
        PG8_WAIT_V(2); PG8_BAR;
        PG8_STAGE(PG8_SB(1, 0), cB + kstep, voffB); PG8_STAGE(PG8_SA(1, 0), cA + kstep, voffA); PG8_STAGE(PG8_SB(1, 1), cB + hstep + kstep, voffB);
        PG8_WAIT_V(6); PG8_BAR;
    } else {
        PG8_STAGE(PG8_SB(0, 0), cB, voffB); PG8_STAGE(PG8_SA(0, 0), cA, voffA); PG8_STAGE(PG8_SB(0, 1), cB + hstep, voffB); PG8_STAGE(PG8_SA(0, 1), cA + hstep, voffA);
        if (wr == 1) PG8_BAR;
        PG8_WAIT_V(4); PG8_BAR;
        PG8_STAGE(PG8_SB(1, 0), cB + kstep, voffB); PG8_STAGE(PG8_SA(1, 0), cA + kstep, voffA); PG8_STAGE(PG8_SB(1, 1), cB + hstep + kstep, voffB);
        PG8_WAIT_V(6); PG8_BAR;
    }
    for (;;) {
        const bool has_next = S.next(ui + 1, nxt);
        const char* nA = has_next ? (const char*)g.A + (size_t)nxt.pm * tstep : cA; const char* nB = has_next ? (const char*)g.Bt + (size_t)nxt.pn * tstep : cB;
        for (int t = 0; t < nt; t += 2) {
            const bool last = (t == nt - 2);
            const char* a1 = cA + (size_t)(t + 1) * kstep;
            const char* a2 = last ? nA : cA + (size_t)(t + 2) * kstep; const char* b2 = last ? nB : cB + (size_t)(t + 2) * kstep;
            const char* a3 = a2 + kstep; const char* b3 = b2 + kstep;
            if (last && has_next) S.a_ready(nxt);
            if constexpr (SP2) {
            PG8_LDB(B0, 0, 0); PG8_LDB(B1, 0, 1); PG8_SCHED; PG8_LDA(At, 0, 0); PG8_STAGE(PG8_SA(1, 1), a1 + hstep, voffA);
            PG8_WAIT_V(8); PG8_WAIT_L(0); PG8_BAR; PG8_MMA(0, 0, At, B0); PG8_MMA(0, 1, At, B1); PG8_BAR; PG8_SCHED;
            PG8_LDA(At, 0, 1); PG8_STAGE(PG8_SB(0, 0), b2, voffB); PG8_STAGE(PG8_SB(0, 1), b2 + hstep, voffB); PG8_STAGE(PG8_SA(0, 0), a2, voffA);
            PG8_WAIT_V(8); PG8_WAIT_L(0); PG8_BAR; PG8_MMA(1, 0, At, B0); PG8_MMA(1, 1, At, B1); PG8_BAR; PG8_SCHED;
            PG8_LDB(B0, 1, 0); PG8_LDB(B1, 1, 1); PG8_SCHED; PG8_LDA(At, 1, 0); PG8_STAGE(PG8_SA(0, 1), a2 + hstep, voffA);
            PG8_WAIT_V(8); PG8_WAIT_L(0); PG8_BAR; PG8_MMA(0, 0, At, B0); PG8_MMA(0, 1, At, B1); PG8_BAR; PG8_SCHED;
            PG8_LDA(At, 1, 1); PG8_STAGE(PG8_SB(1, 0), b3, voffB); PG8_STAGE(PG8_SB(1, 1), b3 + hstep, voffB); PG8_STAGE(PG8_SA(1, 0), a3, voffA);
            PG8_WAIT_V(8); PG8_WAIT_L(0); PG8_BAR; PG8_MMA(1, 0, At, B0); PG8_MMA(1, 1, At, B1); PG8_BAR; PG8_SCHED;
            } else {
            PG8_LDB(B0, 0, 0); PG8_SCHED; PG8_LDA(At, 0, 0); PG8_STAGE(PG8_SA(1, 1), a1 + hstep, voffA);
            PG8_WAIT_L(8); PG8_BAR; PG8_WAIT_L(0); PG8_MMA(0, 0, At, B0); PG8_BAR; PG8_SCHED;
            PG8_LDB(B1, 0, 1); PG8_STAGE(PG8_SB(0, 0), b2, voffB);
            PG8_BAR; PG8_WAIT_L(0); PG8_MMA(0, 1, At, B1); PG8_BAR;
            PG8_LDA(At, 0, 1); PG8_STAGE(PG8_SA(0, 0), a2, voffA);
            PG8_BAR; PG8_WAIT_L(0); PG8_MMA(1, 0, At, B0); PG8_BAR; PG8_SCHED;
            PG8_STAGE(PG8_SB(0, 1), b2 + hstep, voffB);
            PG8_WAIT_V(6); PG8_BAR; PG8_MMA(1, 1, At, B1); PG8_BAR;
            PG8_LDB(B0, 1, 0); PG8_SCHED; PG8_LDA(At, 1, 0); PG8_STAGE(PG8_SA(0, 1), a2 + hstep, voffA);
            PG8_WAIT_L(8); PG8_BAR; PG8_WAIT_L(0); PG8_MMA(0, 0, At, B0); PG8_BAR; PG8_SCHED;
            PG8_LDB(B1, 1, 1); PG8_STAGE(PG8_SB(1, 0), b3, voffB);
            PG8_BAR; PG8_WAIT_L(0); PG8_MMA(0, 1, At, B1); PG8_BAR;
            PG8_LDA(At, 1, 1); PG8_STAGE(PG8_SA(1, 0), a3, voffA);
            PG8_BAR; PG8_WAIT_L(0); PG8_MMA(1, 0, At, B0); PG8_BAR; PG8_SCHED;
            PG8_STAGE(PG8_SB(1, 1), b3 + hstep, voffB);
            PG8_WAIT_V(6); PG8_BAR; PG8_MMA(1, 1, At, B1); PG8_BAR;
            }
        }
        if constexpr (ALIGN_EPI) { if (wr == 0) PG8_BAR; }
        if constexpr (!Epi::AFTER_DRAIN) { E(acc, cur, wr, wc, fr, fq); S.done(cur); }
        if (!has_next) break;
#pragma unroll
        for (int a = 0; a < 2; ++a)
#pragma unroll
            for (int b = 0; b < 2; ++b)
#pragma unroll
                for (int m = 0; m < 4; ++m)
#pragma unroll
                    for (int n = 0; n < 2; ++n) acc[a][b][m][n] = (f32x4){0.f, 0.f, 0.f, 0.f};
        cur = nxt; cA = nA; cB = nB; ++ui;
        if constexpr (ALIGN_EPI) { if (wr == 1) PG8_BAR; }
    }
    PG8_WAIT_V(0);
    if constexpr (!ALIGN_EPI) { if (wr == 0) PG8_BAR; }
    PG8_BAR;
    if constexpr (Epi::AFTER_DRAIN) { E.fused(acc, cur, wr, wc, fr, fq, lds, wid, lane); S.done(cur); }
#undef PG8_SA
#undef PG8_SB
#undef PG8_STAGE
#undef PG8_LDA
#undef PG8_LDB
#undef PG8_MMA
#undef PG8_WAIT_V
#undef PG8_WAIT_L
#undef PG8_BAR
#undef PG8_SCHED
}
}
#ifndef PG8_SP2
#define PG8_SP2 true
#endif
#ifndef PG8_ALIGN
#define PG8_ALIGN true
#endif
#include <hip/hip_bf16.h>
#include <cmath>
namespace attn_body {
using bf16=__hip_bfloat16;
using bf16x8=__attribute__((ext_vector_type(8)))short;
using s16x4=__attribute__((ext_vector_type(4)))short;
using f32x16=__attribute__((ext_vector_type(16)))float;
using u32x4=__attribute__((ext_vector_type(4)))unsigned;
constexpr int SEQ=8192,D=64;
constexpr int NW=8,QBLK=32,QB=QBLK*NW,KVBLK=64,NQB=SEQ/QB;
constexpr int ATTN_UNIT_ROWS=QB;
__device__ __forceinline__ int crow(int r,int hi){return (r&3)+8*(r>>2)+4*hi;}
#define SBAR() __builtin_amdgcn_sched_barrier(0)
__device__ __forceinline__ void cmask(f32x16&p0,f32x16&p1,int jb,int qrel,int hi){
  const float NEG=-INFINITY; int kb=64*jb+4*hi;
  #pragma unroll
  for(int r=0;r<16;++r){int kv=kb+(r&3)+8*(r>>2); if(kv>qrel)p0[r]=NEG; if(kv+32>qrel)p1[r]=NEG;}
}

constexpr int SEL_OFF=86016;
template<int MODE,bool BAND> __device__ __forceinline__ void apply_mask(f32x16&p0,f32x16&p1,int t,int NT,int qrel,int hi,unsigned selmask,unsigned long long mw,float mhat){
  const float NEG=-INFINITY;
  if(MODE==0&&!BAND){
    const float sub=(((selmask>>(t>>2))&1u)!=0u)?mhat:INFINITY;
    #pragma unroll
    for(int r=0;r<16;++r){ p0[r]-=sub; p1[r]-=sub; }
    return;
  }
  if(MODE==0){
    const int jb=t-(NT-4);
    if(BAND&&jb>=0){ const int dq=qrel-64*jb; mw=(dq>=63)?~0ull:((dq<0)?0ull:((2ull<<dq)-1ull)); }
    else mw=(((selmask>>(t>>2))&1u)!=0u)?~0ull:0ull;
  }
  if(MODE==1){
    unsigned t0=(((unsigned)mw)>>(4*hi))<<4, t1=(((unsigned)(mw>>32))>>(4*hi))<<4; const float neg=NEG;
    asm volatile("s_nop 15\n\ts_nop 3":"+v"(p0),"+v"(p1));
    #pragma unroll
    for(int g=3;g>=0;--g){
      #pragma unroll
      for(int e=3;e>=0;--e){ const int r=4*g+e;
        asm volatile("v_add_co_u32 %0, vcc, %0, %0\n\tv_cndmask_b32 %1, %2, %1, vcc":"+v"(t0),"+v"(p0[r]):"v"(neg):"vcc");
        asm volatile("v_add_co_u32 %0, vcc, %0, %0\n\tv_cndmask_b32 %1, %2, %1, vcc":"+v"(t1),"+v"(p1[r]):"v"(neg):"vcc"); }
      t0<<=4; t1<<=4; }
    return;
  }
  {
    const unsigned lo=((unsigned)mw)>>(4*hi), hw=((unsigned)(mw>>32))>>(4*hi);
    #pragma unroll
    for(int r=0;r<16;++r){ const int bt=(r&3)+8*(r>>2); p0[r]=((lo>>bt)&1u)?(p0[r]-mhat):NEG; p1[r]=((hw>>bt)&1u)?(p1[r]-mhat):NEG; }
  }
}
constexpr int NSLOT=3, SLOTB=8192;
constexpr int LDS_K=0, LDS_V=NSLOT*SLOTB, LDS_WS=2*NSLOT*SLOTB, LDS_OST=LDS_WS+NW*64*4, LDS_BYTES=LDS_OST+NW*4096;
constexpr float C2=0.125f*1.4426950408889634f;
__device__ __forceinline__ void glds16(const void*gsrc,unsigned lds_dst){unsigned keep;
  asm volatile("s_mov_b32 %0, m0\n\ts_mov_b32 m0, %2\n\ts_nop 0\n\tglobal_load_lds_dwordx4 %1, off\n\ts_mov_b32 m0, %0":"=&s"(keep):"v"(gsrc),"s"(lds_dst):"memory");}
__device__ __forceinline__ float max3f(float a,float b,float c){float r;asm("v_max3_f32 %0, %1, %2, %3":"=v"(r):"v"(a),"v"(b),"v"(c));return r;}
__device__ __forceinline__ float max2f(float a,float b){float r;asm("v_max_f32_e32 %0, %1, %2":"=v"(r):"v"(a),"v"(b));return r;}
__device__ __forceinline__ float fadd_s(float a,float b){float r;asm("v_add_f32_e32 %0, %1, %2":"=v"(r):"v"(a),"v"(b));return r;}
__device__ __forceinline__ float fsub_s(float a,float b){float r;asm("v_sub_f32_e32 %0, %1, %2":"=v"(r):"v"(a),"v"(b));return r;}
typedef float f32x2_t __attribute__((ext_vector_type(2))); typedef __bf16 bf16x2_t __attribute__((ext_vector_type(2)));
__device__ __forceinline__ unsigned cvtpk_s(float lo,float hi){f32x2_t v={lo,hi};bf16x2_t b=__builtin_convertvector(v,bf16x2_t);return __builtin_bit_cast(unsigned,b);}
#define WAIT_BAR(N) asm volatile("s_waitcnt vmcnt(" #N ") lgkmcnt(0)\n\ts_barrier":::"memory")

__device__ __forceinline__ void qkt(f32x16&p0,f32x16&p1,const char*Kslot,const bf16x8*qr,const f32x16&negm,int r32,int hi){
  const char*kb=Kslot+hi*1024+r32*16;
  #pragma unroll
  for(int d0=0;d0<4;++d0){
    const bf16x8 b0=*reinterpret_cast<const bf16x8*>(kb+d0*2048);
    const bf16x8 b1=*reinterpret_cast<const bf16x8*>(kb+d0*2048+512);
    if(d0==0){p0=__builtin_amdgcn_mfma_f32_32x32x16_bf16(b0,qr[0],negm,0,0,0);p1=__builtin_amdgcn_mfma_f32_32x32x16_bf16(b1,qr[0],negm,0,0,0);}
    else{p0=__builtin_amdgcn_mfma_f32_32x32x16_bf16(b0,qr[d0],p0,0,0,0);p1=__builtin_amdgcn_mfma_f32_32x32x16_bf16(b1,qr[d0],p1,0,0,0);}}
}
typedef __attribute__((address_space(3))) const char* lds_cptr;
typedef short v4i16_t __attribute__((ext_vector_type(4)));
__device__ __forceinline__ void kload8(bf16x8*kf,lds_cptr kp){
  kf[0]=*(const __attribute__((address_space(3))) bf16x8*)(kp);      kf[1]=*(const __attribute__((address_space(3))) bf16x8*)(kp+512);
  kf[2]=*(const __attribute__((address_space(3))) bf16x8*)(kp+2048); kf[3]=*(const __attribute__((address_space(3))) bf16x8*)(kp+2560);
  kf[4]=*(const __attribute__((address_space(3))) bf16x8*)(kp+4096); kf[5]=*(const __attribute__((address_space(3))) bf16x8*)(kp+4608);
  kf[6]=*(const __attribute__((address_space(3))) bf16x8*)(kp+6144); kf[7]=*(const __attribute__((address_space(3))) bf16x8*)(kp+6656);
}
__device__ __forceinline__ void kload2(bf16x8*kf,lds_cptr kp,int j){ kf[2*j]=*(const __attribute__((address_space(3))) bf16x8*)(kp+j*2048); kf[2*j+1]=*(const __attribute__((address_space(3))) bf16x8*)(kp+j*2048+512); }
__device__ __forceinline__ s16x4 vtr(lds_cptr p){ return __builtin_bit_cast(s16x4,__builtin_amdgcn_ds_read_tr16_b64_v4i16((__attribute__((address_space(3))) v4i16_t*)p)); }
__device__ __forceinline__ float rowmax(const f32x16&p0,const f32x16&p1){
  float a=max3f(p0[0],p0[1],p1[0]),b=max3f(p0[2],p0[3],p1[1]);a=max3f(a,p1[2],p1[3]);
  #pragma unroll
  for(int r=4;r<16;r+=4){a=max3f(a,p0[r],p0[r+1]);b=max3f(b,p0[r+2],p0[r+3]);a=max3f(a,p1[r],p1[r+1]);b=max3f(b,p1[r+2],p1[r+3]);}
  const float m=max2f(a,b);
  auto rr=__builtin_amdgcn_permlane32_swap(__float_as_uint(m),__float_as_uint(m),false,false);
  return max2f(__uint_as_float(rr[0]),__uint_as_float(rr[1]));
}
__device__ __forceinline__ void pv(f32x16*o,int vb,bf16x8 pa0,bf16x8 pa1,bf16x8 pa2,bf16x8 pa3){
  #pragma unroll
  for(int d0=0;d0<2;++d0){s16x4 lo[4],hi[4];
    #pragma unroll
    for(int ks=0;ks<4;++ks){
      asm volatile("ds_read_b64_tr_b16 %0,%1 offset:%c2":"=&v"(lo[ks]):"v"(vb),"i"(d0*4096+ks*1024):"memory");
      asm volatile("ds_read_b64_tr_b16 %0,%1 offset:%c2":"=&v"(hi[ks]):"v"(vb),"i"(d0*4096+ks*1024+512):"memory");}
    asm volatile("s_waitcnt lgkmcnt(0)":::"memory");SBAR();
    #define PK(k) (bf16x8){lo[k][0],lo[k][1],lo[k][2],lo[k][3],hi[k][0],hi[k][1],hi[k][2],hi[k][3]}
    o[d0]=__builtin_amdgcn_mfma_f32_32x32x16_bf16(pa0,PK(0),o[d0],0,0,0);
    o[d0]=__builtin_amdgcn_mfma_f32_32x32x16_bf16(pa1,PK(1),o[d0],0,0,0);
    o[d0]=__builtin_amdgcn_mfma_f32_32x32x16_bf16(pa2,PK(2),o[d0],0,0,0);
    o[d0]=__builtin_amdgcn_mfma_f32_32x32x16_bf16(pa3,PK(3),o[d0],0,0,0);
    #undef PK
  }
}

#ifndef ATTN_STORE16
#define ATTN_STORE16(p,v) (*(u32x4*)(p)=(v))
#endif
template<int MODE,int THRL,int QP,int KP> __device__ __forceinline__ void attn_unit(int qb,const bf16*Qh,const bf16*__restrict__ Kh,const bf16*__restrict__ Vh,bf16*Oh,const bf16*__restrict__ kmh,const bf16*__restrict__ kml,const unsigned long long*__restrict__ maskb,char*shm){
  int tid_l=threadIdx.x; asm volatile("":"+v"(tid_l)); const int tid=tid_l,lane=tid&63,r32=lane&31,hi=lane>>5; const int wid=__builtin_amdgcn_readfirstlane(tid>>6);
  const int q0=qb*QB;
  const bf16*Qw=Qh+(long)(q0+wid*QBLK)*QP;
  const unsigned lds0=(unsigned)(uintptr_t)shm;
  float*wsf=(float*)(shm+LDS_WS)+wid*64;
  const bf16*ksrc=Kh+(long)lane*KP+wid*8;
  const bf16*vsrc=Vh+(long)(16*(wid&3)+(lane>>2))*KP+(wid>>2)*32+(lane&3)*8;
  const unsigned kdst=lds0+LDS_K+wid*1024, vdst=lds0+LDS_V+wid*1024;
  #define DMA_K(t,slot) glds16(ksrc+(long)(t)*KVBLK*KP,(unsigned)__builtin_amdgcn_readfirstlane(kdst+(slot)))
  #define DMA_V(t,slot) glds16(vsrc+(long)(t)*KVBLK*KP,(unsigned)__builtin_amdgcn_readfirstlane(vdst+(slot)))
  const int vb0=(int)(lds0+LDS_V)+((lane>>4)&1)*32+(lane&3)*8+(4*hi+((lane&15)>>2))*64;
  const char*Kbase=shm+LDS_K; bf16x8 kf[8];
  const lds_cptr shm3=(lds_cptr)shm; const lds_cptr kp0=shm3+LDS_K+hi*1024+r32*16; const lds_cptr vp0=shm3+LDS_V+((lane>>4)&1)*32+(lane&3)*8+(4*hi+((lane&15)>>2))*64;
  const int NT=(q0+QB)/KVBLK;
  DMA_K(0,0);DMA_V(0,0);DMA_K(1,SLOTB);
  bf16x8 qr[4];
  #pragma unroll
  for(int d0=0;d0<4;++d0)qr[d0]=*reinterpret_cast<const bf16x8*>(&Qw[(long)r32*QP+d0*16+hi*8]);
  unsigned selmask=0u; unsigned long long mw0=0ull,mw_c=0ull,mw_n=0ull; const unsigned long long*mq=maskb;
  if(MODE==1){ mq=maskb+(long)(q0+wid*QBLK+r32)*128; mw0=mq[0]; mw_c=mq[1]; }
  if(MODE==0){ selmask=((const unsigned*)(shm+SEL_OFF))[wid*QBLK+r32]; }
  float mhat=0.f,l_reg=0.f;f32x16 o[2];o[0]=f32x16{};o[1]=f32x16{};f32x16 negm=f32x16{}; if(MODE==1){asm volatile("":"+v"(negm));} const f32x16 zero16=f32x16{};
  const int qrel=wid*QBLK+r32;
  #define CMASK(P0,P1,t) apply_mask<MODE,true>(P0,P1,(t),NT,qrel,hi,selmask,mw_c,mhat)
  bool resc=false;
  #define START(P0,P1) do{ const float rm=rowmax(P0,P1); resc=false; \
    { const float dl=(rm>-1e30f)?rm:0.f; mhat=fadd_s(mhat,dl); \
      _Pragma("unroll") for(int r=0;r<16;++r){P0[r]=fsub_s(P0[r],dl);P1[r]=fsub_s(P1[r],dl);} \
      if(MODE==1){ _Pragma("unroll") for(int r=0;r<16;++r)negm[r]=-mhat; asm volatile("":"+v"(negm)); } } \
    _Pragma("unroll") for(int r=0;r<16;++r)P0[r]=__builtin_amdgcn_exp2f(P0[r]); }while(0)
  #define RESC() do{ if(resc){ asm volatile("s_waitcnt lgkmcnt(0)":::"memory"); \
      _Pragma("unroll") for(int d_=0;d_<2;++d_) _Pragma("unroll") for(int r=0;r<16;++r)o[d_][r]*=wsf[crow(r,hi)]; } }while(0)
  f32x16 pA0,pA1,pB0,pB1;
  int sl_prev=0,sl_cur=0,sl_next=SLOTB;
  #define ROT() do{sl_prev=sl_cur;sl_cur=sl_next;sl_next=(sl_next==(NSLOT-1)*SLOTB)?0:sl_next+SLOTB;}while(0)
  DMA_K(2,2*SLOTB);
  WAIT_BAR(3);
  qkt(pA0,pA1,Kbase,qr,(MODE==1?negm:zero16),r32,hi);asm volatile("s_nop 15\n\ts_nop 7":"+v"(pA0),"+v"(pA1));apply_mask<MODE,true>(pA0,pA1,0,NT,qrel,hi,selmask,mw0,0.f);
  START(pA0,pA1);
  _Pragma("unroll") for(int r=0;r<16;++r)pA1[r]=__builtin_amdgcn_exp2f(pA1[r]);
  WAIT_BAR(0);
  DMA_K(3,0);DMA_V(1,SLOTB);
  ROT();
  kload8(kf,kp0+sl_cur);
  WAIT_BAR(2);
  s16x4 vlo[8],vhi[8]; u32x4 pw0,pw1,pw2,pw3;
  #define PKW(P,B) cvtpk_s(P[B],P[B+1])
  #define PAF(k) __builtin_bit_cast(bf16x8,pw##k)
  #define VFR(i) (bf16x8){vlo[i][0],vlo[i][1],vlo[i][2],vlo[i][3],vhi[i][0],vhi[i][1],vhi[i][2],vhi[i][3]}
  #define PIN(x) asm volatile("":"+v"(x))
  #define MX3(a,b,c) __builtin_fmaxf(__builtin_fmaxf((a),(b)),(c))
  #define GAPA(MF,A0,A1,A2,A3,W0,W1,PW) do{ MF; sacc+=A0; sacc+=A1; sacc+=A2; sacc+=A3; PIN(sacc); W0; W1; PIN(PW); SBAR(); }while(0)
  #define EX(v) __builtin_amdgcn_exp2f(v)
  #define GAPB(MF,X,B) do{ MF; X[B]=EX(X[B]); X[B+1]=EX(X[B+1]); X[B+2]=EX(X[B+2]); X[B+3]=EX(X[B+3]); PIN(X); SBAR(); }while(0)
  #define VRD(i) do{ vlo[i]=vtr(vp_+(((i)>>2)*4096+((i)&3)*1024)); vhi[i]=vtr(vp_+(((i)>>2)*4096+((i)&3)*1024+512)); }while(0)
  #define KRD(G,j) do{ if(G){ kload2(kf,kp0+sl_next,j); SBAR(); } }while(0)
  #define STEP(C0,C1,P0,P1,t,GK,GV,GL) do{ SBAR(); if(MODE==1){ mw_n=((t)+1<NT)?mq[(t)+1]:0ull; } \
    const lds_cptr vp_=vp0+sl_prev; \
    VRD(0); SBAR(); float sacc=(P0[0]+P0[1]); \
    GAPA(C0=__builtin_amdgcn_mfma_f32_32x32x16_bf16(kf[0],qr[0],(MODE==1?negm:zero16),0,0,0), P0[2],P0[3],P0[4],P0[5],     pw0[0]=PKW(P0,0), pw0[1]=PKW(P0,2), pw0); \
    VRD(4); SBAR(); GAPA(C1=__builtin_amdgcn_mfma_f32_32x32x16_bf16(kf[1],qr[0],(MODE==1?negm:zero16),0,0,0), P0[6],P0[7],P0[8],P0[9],     pw0[2]=PKW(P0,4), pw0[3]=PKW(P0,6), pw0); \
    VRD(1); SBAR(); GAPA(C0=__builtin_amdgcn_mfma_f32_32x32x16_bf16(kf[2],qr[1],C0,0,0,0),   P0[10],P0[11],P0[12],P0[13], pw1[0]=PKW(P0,8), pw1[1]=PKW(P0,10), pw1); \
    VRD(5); SBAR(); GAPA(C1=__builtin_amdgcn_mfma_f32_32x32x16_bf16(kf[3],qr[1],C1,0,0,0),   P0[14],P0[15],P1[0],P1[1],   pw1[2]=PKW(P0,12),pw1[3]=PKW(P0,14), pw1); \
    VRD(2); SBAR(); GAPA(C0=__builtin_amdgcn_mfma_f32_32x32x16_bf16(kf[4],qr[2],C0,0,0,0),   P1[2],P1[3],P1[4],P1[5],     pw2[0]=PKW(P1,0), pw2[1]=PKW(P1,2), pw2); \
    VRD(6); SBAR(); GAPA(C1=__builtin_amdgcn_mfma_f32_32x32x16_bf16(kf[5],qr[2],C1,0,0,0),   P1[6],P1[7],P1[8],P1[9],     pw2[2]=PKW(P1,4), pw2[3]=PKW(P1,6), pw2); \
    VRD(3); SBAR(); GAPA(C0=__builtin_amdgcn_mfma_f32_32x32x16_bf16(kf[6],qr[3],C0,0,0,0),   P1[10],P1[11],P1[12],P1[13], pw3[0]=PKW(P1,8), pw3[1]=PKW(P1,10), pw3); \
    VRD(7); SBAR(); GAPA(C1=__builtin_amdgcn_mfma_f32_32x32x16_bf16(kf[7],qr[3],C1,0,0,0),   P1[14],P1[15],0.f,0.f,       pw3[2]=PKW(P1,12),pw3[3]=PKW(P1,14), pw3); \
    l_reg+=sacc; \
    CMASK(C0,C1,t); if(MODE==1){ mw_c=mw_n; } \
    if(GK){DMA_K((t)+3,sl_cur);} if(GV){DMA_V((t)+1,sl_next);} \
    { float a=MX3(C0[0],C0[1],C1[0]),b=MX3(C0[2],C0[3],C1[1]); a=MX3(a,C1[2],C1[3]); \
      _Pragma("unroll") for(int r=4;r<16;r+=4){a=MX3(a,C0[r],C0[r+1]);b=MX3(b,C0[r+2],C0[r+3]);a=MX3(a,C1[r],C1[r+1]);b=MX3(b,C1[r+2],C1[r+3]);} \
      float rm=__builtin_fmaxf(a,b); { auto rr=__builtin_amdgcn_permlane32_swap(__float_as_uint(rm),__float_as_uint(rm),false,false); rm=__builtin_fmaxf(__uint_as_float(rr[0]),__uint_as_float(rr[1])); } \
      resc=false; \
      if(__builtin_expect(__any(rm>(float)THRL),0)){ const float dl=__builtin_fmaxf(rm,0.f); mhat+=dl; \
        _Pragma("unroll") for(int r=0;r<16;++r){C0[r]-=dl;C1[r]-=dl;} \
        if(MODE==1){ _Pragma("unroll") for(int r=0;r<16;++r)negm[r]=-mhat; asm volatile("":"+v"(negm)); } \
        const float f=__builtin_amdgcn_exp2f(-dl); l_reg*=f; if(hi==0)wsf[r32]=f; resc=true; } } \
    SBAR(); \
    GAPB(o[0]=__builtin_amdgcn_mfma_f32_32x32x16_bf16(PAF(0),VFR(0),o[0],0,0,0), C0,0); \
    GAPB(o[1]=__builtin_amdgcn_mfma_f32_32x32x16_bf16(PAF(0),VFR(4),o[1],0,0,0), C0,4); \
    KRD(GL,0); GAPB(o[0]=__builtin_amdgcn_mfma_f32_32x32x16_bf16(PAF(1),VFR(1),o[0],0,0,0), C0,8); \
    KRD(GL,1); GAPB(o[1]=__builtin_amdgcn_mfma_f32_32x32x16_bf16(PAF(1),VFR(5),o[1],0,0,0), C0,12); \
    KRD(GL,2); GAPB(o[0]=__builtin_amdgcn_mfma_f32_32x32x16_bf16(PAF(2),VFR(2),o[0],0,0,0), C1,0); \
    KRD(GL,3); GAPB(o[1]=__builtin_amdgcn_mfma_f32_32x32x16_bf16(PAF(2),VFR(6),o[1],0,0,0), C1,4); \
    GAPB(o[0]=__builtin_amdgcn_mfma_f32_32x32x16_bf16(PAF(3),VFR(3),o[0],0,0,0), C1,8); \
    GAPB(o[1]=__builtin_amdgcn_mfma_f32_32x32x16_bf16(PAF(3),VFR(7),o[1],0,0,0), C1,12); \
    }while(0)
  int t=1;
  #undef CMASK
  #define CMASK(P0,P1,t) apply_mask<MODE,false>(P0,P1,(t),NT,qrel,hi,selmask,mw_c,mhat)
  for(;t+5<NT;t+=2){
    STEP(pB0,pB1,pA0,pA1,t,true,true,true);     WAIT_BAR(2); RESC(); ROT();
    STEP(pA0,pA1,pB0,pB1,t+1,true,true,true);   WAIT_BAR(2); RESC(); ROT();
  }
  #undef CMASK
  #define CMASK(P0,P1,t) apply_mask<MODE,true>(P0,P1,(t),NT,qrel,hi,selmask,mw_c,mhat)
  #define ENDW(tt) do{ if((tt)+3<NT){WAIT_BAR(2);} else if((tt)+2<NT){WAIT_BAR(1);} else {WAIT_BAR(0);} }while(0)
  for(;t+1<NT;t+=2){
    STEP(pB0,pB1,pA0,pA1,t,(t+3<NT),(t+1<NT),(t+1<NT));       ENDW(t);   RESC(); ROT();
    STEP(pA0,pA1,pB0,pB1,t+1,(t+4<NT),(t+2<NT),(t+2<NT));     ENDW(t+1); RESC(); ROT();
  }
  STEP(pB0,pB1,pA0,pA1,NT-1,false,false,false); RESC();
  { float sacc=pB0[0]+pB0[1]; _Pragma("unroll") for(int r=2;r<16;++r)sacc+=pB0[r]; _Pragma("unroll") for(int r=0;r<16;++r)sacc+=pB1[r]; l_reg+=sacc;
    pw0=(u32x4){PKW(pB0,0),PKW(pB0,2),PKW(pB0,4),PKW(pB0,6)};pw1=(u32x4){PKW(pB0,8),PKW(pB0,10),PKW(pB0,12),PKW(pB0,14)};pw2=(u32x4){PKW(pB1,0),PKW(pB1,2),PKW(pB1,4),PKW(pB1,6)};pw3=(u32x4){PKW(pB1,8),PKW(pB1,10),PKW(pB1,12),PKW(pB1,14)};
    SBAR(); pv(o,vb0+sl_cur,PAF(0),PAF(1),PAF(2),PAF(3)); }
  #undef PKW
  #undef PAF
  #undef VFR
  #undef PIN
  #undef MX3
  #undef GAPA
  #undef GAPB
  #undef EX
  #undef VRD
  #undef KRD
  #undef STEP
  #undef ENDW
  {auto rr=__builtin_amdgcn_permlane32_swap(__float_as_uint(l_reg),__float_as_uint(l_reg),false,false);l_reg=__uint_as_float(rr[0])+__uint_as_float(rr[1]);}
  if(hi==0)wsf[32+r32]=l_reg;asm volatile("s_waitcnt lgkmcnt(0)":::"memory");
  float rli[16];
  #pragma unroll
  for(int r=0;r<16;++r)rli[r]=__builtin_amdgcn_rcpf(wsf[32+crow(r,hi)]);
  bf16*Ow=Oh+(long)(q0+wid*QBLK)*QP;
  { bf16*stg=(bf16*)(shm+LDS_OST)+wid*2048;
    #pragma unroll
    for(int r=0;r<16;++r){const int orow=crow(r,hi);
      #pragma unroll
      for(int d0=0;d0<2;++d0)stg[orow*64+d0*32+r32]=__float2bfloat16(o[d0][r]*rli[r]);}
    asm volatile("s_waitcnt lgkmcnt(0)":::"memory");
    #pragma unroll
    for(int i=0;i<4;++i){const int row=i*8+(lane>>3),ch=lane&7; const u32x4 v=*(const u32x4*)(stg+row*64+ch*8); ATTN_STORE16(Ow+(long)row*QP+ch*8,v);} }
  asm volatile("s_waitcnt lgkmcnt(0)\n\ts_barrier":::"memory");
  #undef DMA_K
  #undef DMA_V
  #undef CMASK
  #undef START
  #undef RESC
  #undef ROT
}
constexpr int ATTN_LDS_BYTES=LDS_BYTES;

static_assert(SEL_OFF>=LDS_BYTES,"selection words above the attention body's own LDS use");
template<int QP> __device__ __forceinline__ void moba_gates(int qb,const bf16*Qh,const bf16*__restrict__ kmh,const bf16*__restrict__ kml,char*shm){
  int tid_l=threadIdx.x; asm volatile("":"+v"(tid_l)); const int tid=tid_l,lane=tid&63,r32=lane&31,hi=lane>>5; const int wid=__builtin_amdgcn_readfirstlane(tid>>6);
  const int q0=qb*QB; const bf16*Qw=Qh+(long)(q0+wid*QBLK)*QP;
  bf16x8 qr[4];
  #pragma unroll
  for(int d0=0;d0<4;++d0)qr[d0]=*reinterpret_cast<const bf16x8*>(&Qw[(long)r32*QP+d0*16+hi*8]);
  unsigned selmask=0u;
  {
    f32x16 g=f32x16{};
    #pragma unroll
    for(int d0=0;d0<4;++d0){
      const bf16x8 ah=*reinterpret_cast<const bf16x8*>(&kmh[r32*64+d0*16+hi*8]);
      const bf16x8 al=*reinterpret_cast<const bf16x8*>(&kml[r32*64+d0*16+hi*8]);
      g=__builtin_amdgcn_mfma_f32_32x32x16_bf16(ah,qr[d0],g,0,0,0);
      g=__builtin_amdgcn_mfma_f32_32x32x16_bf16(al,qr[d0],g,0,0,0);}
    float v1=-INFINITY,v2=-INFINITY,v3=-INFINITY; int i1=64,i2=64,i3=64;
    #define TOP3_INS(vv,ii) do{ const float v_=(vv); const int i_=(ii); \
      const bool b1=(v_>v1)||(v_==v1&&i_<i1), b2=(v_>v2)||(v_==v2&&i_<i2), b3=(v_>v3)||(v_==v3&&i_<i3); \
      if(b1){v3=v2;i3=i2;v2=v1;i2=i1;v1=v_;i1=i_;} else if(b2){v3=v2;i3=i2;v2=v_;i2=i_;} else if(b3){v3=v_;i3=i_;} }while(0)
    #pragma unroll
    for(int r=0;r<16;++r){ const int j=crow(r,hi); const float gv=(j<qb)?g[r]:-INFINITY; TOP3_INS(gv,(j<qb)?j:64); }
    { const float pv1=__shfl_xor(v1,32),pv2=__shfl_xor(v2,32),pv3=__shfl_xor(v3,32); const int pi1=__shfl_xor(i1,32),pi2=__shfl_xor(i2,32),pi3=__shfl_xor(i3,32);
      TOP3_INS(pv1,pi1); TOP3_INS(pv2,pi2); TOP3_INS(pv3,pi3); }
    #undef TOP3_INS
    if(i1<32)selmask|=1u<<i1; if(i2<32)selmask|=1u<<i2; if(i3<32)selmask|=1u<<i3;
  }
  if(hi==0)((unsigned*)(shm+SEL_OFF))[wid*QBLK+r32]=selmask;
}
#undef SBAR
#undef WAIT_BAR
}
#define GAS __attribute__((address_space(1)))
#define LAS __attribute__((address_space(3)))
typedef unsigned short bf16;
typedef unsigned v4u __attribute__((ext_vector_type(4)));
typedef float f32x4 __attribute__((ext_vector_type(4)));
typedef short bf16x8 __attribute__((ext_vector_type(8)));
typedef GAS unsigned gu32;
typedef GAS unsigned long long gu64;
#define RLX_AGENT __ATOMIC_RELAXED, __HIP_MEMORY_SCOPE_AGENT
#define LDS_WAIT() asm volatile("s_waitcnt lgkmcnt(0)" ::: "memory")
#define VM_WAIT() asm volatile("s_waitcnt vmcnt(0)" ::: "memory")
__device__ __forceinline__ unsigned long long rt() { return __builtin_amdgcn_s_memrealtime(); }
__device__ __forceinline__ unsigned f2bf(float f) { unsigned u = __builtin_bit_cast(unsigned, f); return (u + 0x7fffu + ((u >> 16) & 1u)) >> 16; }
__device__ __forceinline__ unsigned pk2(float lo, float hi) { return f2bf(lo) | (f2bf(hi) << 16); }

#define XB_TMO      128
#define XB_XCNT(j)  (256  + 64 * (j))
#define XB_XSUB(j)  (1280 + 64 * (j))
#define XB_XGEN(j)  (2304 + 64 * (j))
#define XB_TOP      3328
#define XB_TOPGEN   3392
#define XCD_BAR_WORDS 3456
#define XB_SPIN_CAP (1u << 18)

__device__ __forceinline__ unsigned xb_ld(unsigned* p)              { return __hip_atomic_load(p, __ATOMIC_RELAXED, __HIP_MEMORY_SCOPE_AGENT); }
__device__ __forceinline__ unsigned xb_add(unsigned* p, unsigned v) { return __hip_atomic_fetch_add(p, v, __ATOMIC_RELAXED, __HIP_MEMORY_SCOPE_AGENT); }
__device__ __forceinline__ unsigned xb_xcc_id() { return (unsigned)__builtin_amdgcn_s_getreg((3 << 11) | 20) & 0xFu; }
#define XB_SPIN(cond, bar) do { unsigned _sp = 0; while (cond) { __builtin_amdgcn_s_sleep(1); \
    if ((++_sp & 255u) == 0u) { if (xb_ld(&(bar)[XB_TMO])) break; if (_sp > XB_SPIN_CAP) { atomicAdd(&(bar)[XB_TMO], 1u); break; } } } } while (0)

struct XcdBarrier {
    unsigned* bar; unsigned x;
    volatile LAS unsigned* st;
};

__device__ __forceinline__ XcdBarrier xcd_barrier_post(unsigned* bar, volatile LAS unsigned* st) {
    XcdBarrier b; b.bar = bar; b.x = xb_xcc_id(); b.st = st;
    if (threadIdx.x == 0) (void)xb_add(&bar[XB_XCNT(b.x)], 1u);
    return b;
}
__device__ __forceinline__ void xcd_barrier_complete(unsigned* bar, unsigned x, unsigned& nloc, unsigned& nx) {
    const unsigned G = gridDim.x * gridDim.y * gridDim.z;
    unsigned sum, cnt, mine, sp = 0u;
    for (;;) {
        sum = 0u; cnt = 0u; mine = 0u;
#pragma unroll
        for (unsigned j = 0; j < 16; ++j) { const unsigned c = xb_ld(&bar[XB_XCNT(j)]); sum += c; cnt += (c > 0u) ? 1u : 0u; mine = (j == x) ? c : mine; }
        if (sum == G) break;
        __builtin_amdgcn_s_sleep(1);
        if ((++sp & 255u) == 0u) { if (xb_ld(&bar[XB_TMO])) break; if (sp > XB_SPIN_CAP) { atomicAdd(&bar[XB_TMO], 1u); break; } }
    }
    nloc = mine > 0u ? mine : 1u; nx = cnt > 0u ? cnt : 1u;
}

__device__ __forceinline__ void xcd_barrier(const XcdBarrier& b) {
    asm volatile("s_waitcnt vmcnt(0)" ::: "memory");
    __syncthreads();
    if (threadIdx.x == 0) {
        unsigned* bar = b.bar;
        __builtin_amdgcn_s_waitcnt(0);
        unsigned nloc = b.st[0], nx = b.st[1];
        if (nloc == 0u) { xcd_barrier_complete(bar, b.x, nloc, nx); b.st[0] = nloc; b.st[1] = nx; }
        const unsigned old = xb_add(&bar[XB_XSUB(b.x)], 1u);
        const unsigned gen = old / nloc;
        if (old + 1u == (gen + 1u) * nloc) {
            __builtin_amdgcn_fence(__ATOMIC_RELEASE, "agent");
            asm volatile("s_waitcnt vmcnt(0)" ::: "memory");
            const unsigned og = xb_add(&bar[XB_TOP], 1u);
            const unsigned tg = og / nx;
            if (og + 1u == (tg + 1u) * nx) xb_add(&bar[XB_TOPGEN], 1u);
            else XB_SPIN(xb_ld(&bar[XB_TOPGEN]) == tg, bar);
            __builtin_amdgcn_fence(__ATOMIC_ACQUIRE, "agent");
            xb_add(&bar[XB_XGEN(b.x)], 1u);
            asm volatile("s_waitcnt vmcnt(0)" ::: "memory");
        } else {
            XB_SPIN(xb_ld(&bar[XB_XGEN(b.x)]) == gen, bar);
            __builtin_amdgcn_fence(__ATOMIC_ACQUIRE, "agent");
            asm volatile("s_waitcnt vmcnt(0)" ::: "memory");
        }
    }
    __syncthreads();
}

constexpr int NWAVES = 8;
#ifndef STAG_TICKS
#define STAG_TICKS 0u
#endif
#ifndef PG8_ALIGN1
#define PG8_ALIGN1 true
#endif
constexpr int SEQ = 8192, DMODEL = 1024, MROWS = 16384, DFF = 2816;
constexpr float RMS_EPS = 1e-6f;
constexpr float QC2 = 0.125f * 1.4426950408889634f;
constexpr size_t MiB = 1u << 20;
constexpr size_t WS_CTL = 0, CTL_ZERO_BYTES = 1 * MiB;
constexpr size_t WS_W_IN0 = 1 * MiB, WS_W_OUT0 = 6 * MiB, WS_W_GU0 = 8 * MiB, WS_W_DN0 = 19 * MiB, WS_W_PG0 = 25 * MiB, WS_W_PP0 = 27 * MiB;
constexpr size_t WS_W_IN1 = 28 * MiB, WS_W_OUT1 = 36 * MiB, WS_W_GU1 = 38 * MiB, WS_W_DN1 = 49 * MiB, WS_W_PG1 = 55 * MiB, WS_W_PP1 = 57 * MiB;
constexpr size_t WS_ROPE = 58 * MiB;
constexpr size_t WS_ROWSS = 59 * MiB;
constexpr size_t WS_KMH = 60 * MiB, WS_KML = 60 * MiB + 64 * 1024, WS_WI = 60 * MiB + 512 * 1024;
constexpr size_t WS_KIRAW = 61 * MiB, WS_KI = 65 * MiB;
constexpr size_t WS_HB = 68 * MiB, WS_PB = 100 * MiB, WS_MASK = 116 * MiB, WS_R = 132 * MiB;
constexpr size_t WS_QO = WS_R, WS_VA = WS_R + 32 * MiB, WS_KB0 = WS_R + 48 * MiB, WS_VB0 = WS_R + 64 * MiB;
constexpr size_t WS_KC = WS_R + 32 * MiB, WS_VC = WS_R + 64 * MiB, WS_QI = WS_R + 96 * MiB;
constexpr size_t WS_ROWSS2 = 244 * MiB;
constexpr size_t WS_HID = WS_R,
#ifdef PROBE_G_ELSEWHERE
 WS_G = 100 * MiB,
#else
 WS_G = WS_R,
#endif
 WS_END = 256 * MiB;
static_assert(WS_QI + 16 * MiB <= WS_END && WS_HID + (size_t)MROWS * DFF * 2 <= WS_END, "ws map");
constexpr int CW_BAR = 4096;
constexpr int PHASE_LDS = 147456, LDSCTL_OFF = PHASE_LDS, LDS_BYTES = PHASE_LDS + 1024;

#ifndef PHMASK
#define PHMASK 0xffffffffu
#endif
#define RUNPH(k) (((PHMASK) >> (k)) & 1u)
#ifndef DUPMASK
#define DUPMASK 0u
#endif
#ifndef PROBE_VAR
#define PROBE_VAR 0
#endif
#define NREP(k) ((int)(RUNPH(k) * (1u + (((DUPMASK) >> (k)) & 1u))))
struct Args { const float* in[22]; float* out; unsigned char* ws; float f0, f1, f2, f3, f4, f5, f6, f7; };
typedef const __attribute__((address_space(4))) Args* KArgs;

namespace epi {
using pg8::f32x4; using pg8::f32x2; using pg8::Unit; using pg8::bf16_t;
typedef unsigned u32x2 __attribute__((ext_vector_type(2)));
typedef __bf16 bf16x2_t __attribute__((ext_vector_type(2)));
__device__ __forceinline__ unsigned cvtpk(float lo, float hi) { const f32x2 v = {lo, hi}; const bf16x2_t b = __builtin_convertvector(v, bf16x2_t); return __builtin_bit_cast(unsigned, b); }
__device__ __forceinline__ void st4(bf16_t* p, f32x4 v) { u32x2 w; w.x = cvtpk(v[0], v[1]); w.y = cvtpk(v[2], v[3]); *(u32x2*)p = w; }
__device__ __forceinline__ f32x4 ld4(const bf16_t* p) { const u32x2 w = *(const u32x2*)p; f32x4 v; v[0] = __uint_as_float(w.x << 16); v[1] = __uint_as_float(w.x & 0xffff0000u); v[2] = __uint_as_float(w.y << 16); v[3] = __uint_as_float(w.y & 0xffff0000u); return v; }
__device__ __forceinline__ f32x4 gelu4(f32x4 v) { const f32x2 a = pg8::gelu_pk((f32x2){v[0], v[1]}), b = pg8::gelu_pk((f32x2){v[2], v[3]}); return (f32x4){a.x, a.y, b.x, b.y}; }
__device__ __forceinline__ float sigm(float x) { return __builtin_amdgcn_rcpf(1.f + __builtin_amdgcn_exp2f(-1.4426950408889634f * x)); }
__device__ __forceinline__ float sum_fq(float s) {
    auto a = __builtin_amdgcn_permlane16_swap(__float_as_uint(s), __float_as_uint(s), false, false); s = __uint_as_float(a[0]) + __uint_as_float(a[1]);
    auto b = __builtin_amdgcn_permlane32_swap(__float_as_uint(s), __float_as_uint(s), false, false); return __uint_as_float(b[0]) + __uint_as_float(b[1]);
}
__device__ __forceinline__ float xor32(float v, int fq) {
    auto b = __builtin_amdgcn_permlane32_swap(__float_as_uint(v), __float_as_uint(v), false, false); return __uint_as_float(fq < 2 ? b[1] : b[0]);
}
__device__ __forceinline__ void row_rstd8(const float* rowss, int row0, int fq, float (&rs)[2][4]) {
    f32x4 v[2][4];
#pragma unroll
    for (int ai = 0; ai < 2; ++ai)
#pragma unroll
        for (int m = 0; m < 4; ++m) v[ai][m] = *(const f32x4*)(rowss + (size_t)(row0 + ai * 128 + m * 16) * 16 + 4 * fq);
#pragma unroll
    for (int ai = 0; ai < 2; ++ai)
#pragma unroll
        for (int m = 0; m < 4; ++m) { const float s = sum_fq((v[ai][m][0] + v[ai][m][1]) + (v[ai][m][2] + v[ai][m][3])); rs[ai][m] = 1.0f / sqrtf(s * (1.f / 1024.f) + RMS_EPS); }
}
#define EPI_FENCE() asm volatile("" ::: "memory")
typedef unsigned u32x4e __attribute__((ext_vector_type(4)));
__device__ __forceinline__ void st8(bf16_t* p, f32x4 a, f32x4 b) { u32x4e w; w.x = cvtpk(a[0], a[1]); w.y = cvtpk(a[2], a[3]); w.z = cvtpk(b[0], b[1]); w.w = cvtpk(b[2], b[3]); *(u32x4e*)p = w; }
__device__ __forceinline__ void ld8(const bf16_t* p, f32x4& a, f32x4& b) { const u32x4e w = *(const u32x4e*)p;
    a[0] = __uint_as_float(w.x << 16); a[1] = __uint_as_float(w.x & 0xffff0000u); a[2] = __uint_as_float(w.y << 16); a[3] = __uint_as_float(w.y & 0xffff0000u);
    b[0] = __uint_as_float(w.z << 16); b[1] = __uint_as_float(w.z & 0xffff0000u); b[2] = __uint_as_float(w.w << 16); b[3] = __uint_as_float(w.w & 0xffff0000u); }
__device__ __forceinline__ float xor16(float v, int fq) {
    auto a = __builtin_amdgcn_permlane16_swap(__float_as_uint(v), __float_as_uint(v), false, false); return __uint_as_float((fq & 1) ? a[0] : a[1]);
}
__device__ __forceinline__ void rope8(f32x4& a, f32x4& b, const float* cs, const float* sn, int row, int fq) {
    const f32x4 c0 = *(const f32x4*)(cs + (size_t)row * 8), c1 = *(const f32x4*)(cs + (size_t)row * 8 + 4), s0 = *(const f32x4*)(sn + (size_t)row * 8), s1 = *(const f32x4*)(sn + (size_t)row * 8 + 4);
    f32x4 pa, pb;
#pragma unroll
    for (int j = 0; j < 4; ++j) { pa[j] = xor16(a[j], fq); pb[j] = xor16(b[j], fq); }
    if (fq < 2) {
#pragma unroll
        for (int j = 0; j < 4; ++j) { a[j] = (fq == 0) ? (a[j] * c0[j] - pa[j] * s0[j]) : (a[j] * c0[j] + pa[j] * s0[j]); b[j] = (fq == 0) ? (b[j] * c1[j] - pb[j] * s1[j]) : (b[j] * c1[j] + pb[j] * s1[j]); } }
}
struct EpiInEven {
    static constexpr bool PERM = true, AFTER_DRAIN = false;
    const float* rowss; const float* cs; const float* sn; bf16_t *UQ, *VA, *KB, *VB;
    __device__ __forceinline__ void operator()(const f32x4 (&acc)[2][2][4][2], const Unit& u, int wr, int wc, int fr, int fq) const {
        const int row0 = u.pm * 256 + wr * 64 + fr; float rs8[2][4]; row_rstd8(rowss, row0, fq, rs8);
        const int sec = u.pn >> 1, cb = (u.pn & 1) * 256 + wc * 32 + 8 * fq; const bool ropew = (wc & 1) == 0;
#pragma unroll
        for (int ai = 0; ai < 2; ++ai) {
#pragma unroll
            for (int m = 0; m < 4; ++m) { const int row = row0 + ai * 128 + m * 16; const float r_ = rs8[ai][m];
#pragma unroll
                for (int bj = 0; bj < 2; ++bj) { const int c = cb + bj * 128; f32x4 a = acc[ai][bj][m][0] * r_, b = acc[ai][bj][m][1] * r_;
                    if (sec == 0) { st8(UQ + (size_t)row * 1024 + c, gelu4(a), gelu4(b)); }
                    else if (sec == 1) { st8(VA + (size_t)row * 512 + c, gelu4(a), gelu4(b)); }
                    else if (sec == 2) { if (ropew) rope8(a, b, cs, sn, row, fq); st8(UQ + (size_t)row * 1024 + 512 + c, a * QC2, b * QC2); }
                    else if (sec == 3) { if (ropew) rope8(a, b, cs, sn, row, fq); st8(KB + (size_t)row * 512 + c, a, b); }
                    else { st8(VB + (size_t)row * 512 + c, a, b); } }
                EPI_FENCE(); } }
    }
};
struct EpiResid {
    static constexpr bool PERM = true, AFTER_DRAIN = false;
    bf16_t* hb; float* rowss;
    __device__ __forceinline__ void operator()(const f32x4 (&acc)[2][2][4][2], const Unit& u, int wr, int wc, int fr, int fq) const {
        const int row0 = u.pm * 256 + wr * 64 + fr, cb = u.pn * 256 + wc * 32 + 8 * fq;
#pragma unroll
        for (int ai = 0; ai < 2; ++ai)
#pragma unroll
            for (int m = 0; m < 4; ++m) { const int row = row0 + ai * 128 + m * 16; float ss = 0.f;
#pragma unroll
                for (int bj = 0; bj < 2; ++bj) { const size_t off = (size_t)row * 1024 + cb + bj * 128; f32x4 a, b; ld8(hb + off, a, b); a = a + acc[ai][bj][m][0]; b = b + acc[ai][bj][m][1];
                    st8(hb + off, a, b); ss += ((a[0] * a[0] + a[1] * a[1]) + (a[2] * a[2] + a[3] * a[3])) + ((b[0] * b[0] + b[1] * b[1]) + (b[2] * b[2] + b[3] * b[3])); }
                ss = sum_fq(ss);
                if (fq == 0) rowss[(size_t)row * 16 + u.pn * 4 + wc] = ss;
                EPI_FENCE(); }
    }
};
struct EpiSwiglu {
    static constexpr bool PERM = true, AFTER_DRAIN = false;
    const float* rowss; bf16_t* HID;
    __device__ __forceinline__ void operator()(const f32x4 (&acc)[2][2][4][2], const Unit& u, int wr, int wc, int fr, int fq) const {
        const int row0 = u.pm * 256 + wr * 64 + fr; float rs8[2][4]; row_rstd8(rowss, row0, fq, rs8);
        const int cb = u.pn * 128 + wc * 32 + 8 * fq;
#pragma unroll
        for (int ai = 0; ai < 2; ++ai) {
#pragma unroll
            for (int m = 0; m < 4; ++m) { const int row = row0 + ai * 128 + m * 16; const float r_ = rs8[ai][m]; f32x4 o[2];
#pragma unroll
                for (int n = 0; n < 2; ++n) { const f32x4 g = acc[ai][0][m][n] * r_, up = acc[ai][1][m][n] * r_;
#pragma unroll
                    for (int j = 0; j < 4; ++j) o[n][j] = g[j] * up[j] * sigm(g[j]); }
                st8(HID + (size_t)row * DFF + cb, o[0], o[1]);
                EPI_FENCE(); } }
    }
};
struct EpiStore {
    static constexpr bool PERM = true, AFTER_DRAIN = false;
    bf16_t* O;
    __device__ __forceinline__ void operator()(const f32x4 (&acc)[2][2][4][2], const Unit& u, int wr, int wc, int fr, int fq) const {
        const int row0 = u.pm * 256 + wr * 64 + fr, cb = u.pn * 256 + wc * 32 + 8 * fq;
#pragma unroll
        for (int ai = 0; ai < 2; ++ai)
#pragma unroll
            for (int m = 0; m < 4; ++m) { const int row = row0 + ai * 128 + m * 16;
#pragma unroll
                for (int bj = 0; bj < 2; ++bj) st8(O + (size_t)row * 1024 + cb + bj * 128, acc[ai][bj][m][0], acc[ai][bj][m][1]); }
    }
};
struct EpiPleFused {
    static constexpr bool PERM = true, AFTER_DRAIN = false;
    const float* rowss; const bf16_t* hin; const bf16_t* proj; bf16_t* hout; float* rowss_out;
    __device__ __forceinline__ void operator()(const f32x4 (&acc)[2][2][4][2], const Unit& u, int wr, int wc, int fr, int fq) const {
        const int row0 = u.pm * 256 + wr * 64 + fr, cb = u.pn * 256 + wc * 32 + 8 * fq; float rs8[2][4]; row_rstd8(rowss, row0, fq, rs8);
#pragma unroll
        for (int ai = 0; ai < 2; ++ai)
#pragma unroll
            for (int m = 0; m < 4; ++m) { const int row = row0 + ai * 128 + m * 16; const float r_ = rs8[ai][m]; float ss = 0.f;
#pragma unroll
                for (int bj = 0; bj < 2; ++bj) { const size_t off = (size_t)row * 1024 + cb + bj * 128; f32x4 a, b, pa, pb; ld8(hin + off, a, b); ld8(proj + off, pa, pb);
                    const f32x4 ga = acc[ai][bj][m][0] * r_, gb = acc[ai][bj][m][1] * r_;
#pragma unroll
                    for (int j = 0; j < 4; ++j) { a[j] += pa[j] * sigm(ga[j]); b[j] += pb[j] * sigm(gb[j]); }
                    st8(hout + off, a, b); ss += ((a[0] * a[0] + a[1] * a[1]) + (a[2] * a[2] + a[3] * a[3])) + ((b[0] * b[0] + b[1] * b[1]) + (b[2] * b[2] + b[3] * b[3])); }
                ss = sum_fq(ss);
                if (fq == 0) rowss_out[(size_t)row * 16 + u.pn * 4 + wc] = ss;
                EPI_FENCE(); }
    }
};
struct PairOrder {
    int first;
    __device__ __forceinline__ bool next(int i, Unit& u) const { if (i >= 2) return false; const int t = first + i; u.pm = t >> 2; u.pn = t & 3; return true; }
    __device__ __forceinline__ void a_ready(const Unit&) const {}
    __device__ __forceinline__ void done(const Unit&) const {}
};
struct EpiPleGate {
    static constexpr bool PERM = true, AFTER_DRAIN = false;
    const float* rowss; bf16_t* G;
    __device__ __forceinline__ void operator()(const f32x4 (&acc)[2][2][4][2], const Unit& u, int wr, int wc, int fr, int fq) const {
        const int row0 = u.pm * 256 + wr * 64 + fr; float rs8[2][4]; row_rstd8(rowss, row0, fq, rs8);
        const int cb = u.pn * 256 + wc * 32 + 8 * fq;
#pragma unroll
        for (int ai = 0; ai < 2; ++ai) {
#pragma unroll
            for (int m = 0; m < 4; ++m) { const int row = row0 + ai * 128 + m * 16; const float r_ = rs8[ai][m];
#pragma unroll
                for (int bj = 0; bj < 2; ++bj) { const f32x4 a = acc[ai][bj][m][0] * r_, b = acc[ai][bj][m][1] * r_; f32x4 oa, ob;
#pragma unroll
                    for (int j = 0; j < 4; ++j) { oa[j] = sigm(a[j]); ob[j] = sigm(b[j]); }
                    st8(G + (size_t)row * 1024 + cb + bj * 128, oa, ob); }
                EPI_FENCE(); } }
    }
};
struct EpiPleProj {
    static constexpr bool PERM = true, AFTER_DRAIN = false;
    bf16_t* hb; float* rowss; const bf16_t* G;
    __device__ __forceinline__ void operator()(const f32x4 (&acc)[2][2][4][2], const Unit& u, int wr, int wc, int fr, int fq) const {
        const int row0 = u.pm * 256 + wr * 64 + fr, cb = u.pn * 256 + wc * 32 + 8 * fq;
#pragma unroll
        for (int ai = 0; ai < 2; ++ai)
#pragma unroll
            for (int m = 0; m < 4; ++m) { const int row = row0 + ai * 128 + m * 16; float ss = 0.f;
#pragma unroll
                for (int bj = 0; bj < 2; ++bj) { const size_t off = (size_t)row * 1024 + cb + bj * 128; f32x4 a, b, ga, gb; ld8(hb + off, a, b); ld8(G + off, ga, gb);
                    a = a + acc[ai][bj][m][0] * ga; b = b + acc[ai][bj][m][1] * gb;
                    st8(hb + off, a, b); ss += ((a[0] * a[0] + a[1] * a[1]) + (a[2] * a[2] + a[3] * a[3])) + ((b[0] * b[0] + b[1] * b[1]) + (b[2] * b[2] + b[3] * b[3])); }
                ss = sum_fq(ss);
                if (fq == 0) rowss[(size_t)row * 16 + u.pn * 4 + wc] = ss;
                EPI_FENCE(); }
    }
};
struct EpiInOdd {
    static constexpr bool PERM = true, AFTER_DRAIN = false;
    const float* rowss; const float* cs; const float* sn; bf16_t *QO, *KC, *VC, *QI; float* KIRAW; float* WI;
    __device__ __forceinline__ void operator()(const f32x4 (&acc)[2][2][4][2], const Unit& u, int wr, int wc, int fr, int fq) const {
        const int row0 = u.pm * 256 + wr * 64 + fr; float rs8[2][4]; row_rstd8(rowss, row0, fq, rs8);
        const int pn = u.pn, cl = wc * 32 + 8 * fq; const bool ropew = (wc & 1) == 0;
#pragma unroll
        for (int ai = 0; ai < 2; ++ai) {
#pragma unroll
            for (int m = 0; m < 4; ++m) { const int row = row0 + ai * 128 + m * 16; const float r_ = rs8[ai][m];
#pragma unroll
                for (int bj = 0; bj < 2; ++bj) { const int c = cl + bj * 128; f32x4 a = acc[ai][bj][m][0] * r_, b = acc[ai][bj][m][1] * r_;
                    if (pn < 4) { if (ropew) rope8(a, b, cs, sn, row, fq); st8(QO + (size_t)row * 1024 + pn * 256 + c, a * QC2, b * QC2); }
                    else if (pn < 8) { if (ropew) rope8(a, b, cs, sn, row, fq); st8(KC + (size_t)row * 1024 + (pn - 4) * 256 + c, a, b); }
                    else if (pn < 12) { st8(VC + (size_t)row * 1024 + (pn - 8) * 256 + c, a, b); }
                    else if (pn < 14) { if (ropew) rope8(a, b, cs, sn, row, fq); st8(QI + (size_t)row * 512 + (pn - 12) * 256 + c, a, b); }
                    else { if (c < 64) { *(f32x4*)(KIRAW + (size_t)row * 64 + c) = a; *(f32x4*)(KIRAW + (size_t)row * 64 + c + 4) = b; }
                           else if (c == 64) { *(f32x4*)(WI + (size_t)row * 8) = a * 0.04419417382415922f; *(f32x4*)(WI + (size_t)row * 8 + 4) = b * 0.04419417382415922f; } } }
                EPI_FENCE(); } }
    }
};
}

__device__ __forceinline__ float wave_sum(float v) {
#pragma unroll
    for (int o = 1; o < 64; o <<= 1) v += __shfl_xor(v, o);
    return v;
}
constexpr int XP_SCR = 64 * 65;
template <int MODE>
__device__ __forceinline__ void xpose_item(const float* __restrict__ W, int K, int N, const float* __restrict__ g, bf16* __restrict__ WT, int off, LAS float* scr, int item, int lane) {
    const int nblk = (N + 63) / 64, kb = item / nblk, nb = item % nblk, k0 = 64 * kb, n0 = 64 * nb;
    const int nq = lane & 15, kr = lane >> 4; const int nn = n0 + 4 * nq; const bool ok = nn < N;
#pragma unroll 8
    for (int i = 0; i < 16; ++i) { const int kk = 4 * i + kr; f32x4 v = ok ? *(const f32x4*)(W + (size_t)(k0 + kk) * N + nn) : (f32x4){0.f, 0.f, 0.f, 0.f};
        if (g) v = v * g[k0 + kk];
        LAS float* d = scr + kk * 65 + 4 * nq; d[0] = v[0]; d[1] = v[1]; d[2] = v[2]; d[3] = v[3]; }
    LDS_WAIT(); asm volatile("" ::: "memory");
    const int c = lane & 7;
#pragma unroll
    for (int j = 0; j < 8; ++j) { const int n = (lane >> 3) + 8 * j; const LAS float* s = scr + (8 * c) * 65 + n;
        v4u o; o.x = pk2(s[0 * 65], s[1 * 65]); o.y = pk2(s[2 * 65], s[3 * 65]); o.z = pk2(s[4 * 65], s[5 * 65]); o.w = pk2(s[6 * 65], s[7 * 65]);
        const int ng = n0 + n;
        if (ng < N) { const int dr = (MODE == 0) ? (ng + off) : ((ng >> 7) * 256 + (ng & 127) + off); *(v4u*)(WT + (size_t)dr * K + k0 + 8 * c) = o; } }
    LDS_WAIT(); asm volatile("" ::: "memory");
}
__device__ __forceinline__ float bf2f(bf16 b) { return __uint_as_float(((unsigned)b) << 16); }

__device__ __forceinline__ void stagger_start(int nunits_total, int G, int bx, unsigned ticks) {
    const int rem = nunits_total % G;
    if (rem != 0 && bx >= rem) { const unsigned long long t0 = __builtin_amdgcn_s_memrealtime(); while (__builtin_amdgcn_s_memrealtime() - t0 < (unsigned long long)ticks) __builtin_amdgcn_s_sleep(32); }
}
template <int LM>
__device__ __forceinline__ void xp_run(KArgs ap, unsigned char* ws, LAS float* scr, int lane, int first, int stride) {
    const float *g_mix = ap->in[3], *w_in_even = ap->in[4], *w_out_even = ap->in[9], *w_in_odd = ap->in[10], *w_out_odd = ap->in[13], *g_ffn = ap->in[14], *w_gate = ap->in[15], *w_up = ap->in[16],
                *w_down = ap->in[17], *g_ple = ap->in[18], *w_pproj = ap->in[19], *w_pgate = ap->in[20];
    constexpr int I_IN0 = 16 * 40, I_SQ = 16 * 16, I_GU = 16 * 44, I_DN = 44 * 16, I_PP = 4 * 16, I_IN1 = 16 * 58;
    constexpr int N_L = I_SQ + 2 * I_GU + I_DN + I_SQ + I_PP;
    constexpr int NITEMS = ((LM & 1) ? I_IN0 : 0) + ((LM & 8) ? I_IN1 : 0) + ((LM & 2) ? N_L : 0) + ((LM & 4) ? N_L : 0);
#define XP(BIT, MODE, Wp, K_, N_, gp, OFFB, off_, NI) if (LM & (BIT)) { if (r < (NI)) { xpose_item<MODE>((Wp), (K_), (N_), (gp), (bf16*)(ws + (OFFB)), (off_), scr, r, lane); continue; } r -= (NI); }
    for (int it = first; it < NITEMS; it += stride) {
        int r = it;
        XP(1, 0, w_in_even, 1024, 2560, g_mix, WS_W_IN0, 0, I_IN0)
        XP(2, 0, w_out_even, 1024, 1024, (const float*)nullptr, WS_W_OUT0, 0, I_SQ)
        XP(2, 1, w_gate, 1024, DFF, g_ffn, WS_W_GU0, 0, I_GU)
        XP(2, 1, w_up, 1024, DFF, g_ffn, WS_W_GU0, 128, I_GU)
        XP(2, 0, w_down, DFF, 1024, (const float*)nullptr, WS_W_DN0, 0, I_DN)
        XP(2, 0, w_pgate, 1024, 1024, g_ple, WS_W_PG0, 0, I_SQ)
        XP(2, 0, w_pproj, 256, 1024, (const float*)nullptr, WS_W_PP0, 0, I_PP)
        XP(8, 0, w_in_odd, 1024, 3656, g_mix + 1024, WS_W_IN1, 0, I_IN1)
        XP(4, 0, w_out_odd, 1024, 1024, (const float*)nullptr, WS_W_OUT1, 0, I_SQ)
        XP(4, 1, w_gate + (size_t)1024 * DFF, 1024, DFF, g_ffn + 1024, WS_W_GU1, 0, I_GU)
        XP(4, 1, w_up + (size_t)1024 * DFF, 1024, DFF, g_ffn + 1024, WS_W_GU1, 128, I_GU)
        XP(4, 0, w_down + (size_t)DFF * 1024, DFF, 1024, (const float*)nullptr, WS_W_DN1, 0, I_DN)
        XP(4, 0, w_pgate + (size_t)1024 * 1024, 1024, 1024, g_ple + 1024, WS_W_PG1, 0, I_SQ)
        XP(4, 0, w_pproj + (size_t)256 * 1024, 256, 1024, (const float*)nullptr, WS_W_PP1, 0, I_PP)
    }
#undef XP
}
__device__ __forceinline__ void pb_convert(KArgs ap, unsigned char* ws, int gt, int NGT) {
    const f32x4* p4 = (const f32x4*)ap->in[1]; unsigned long long* o8 = (unsigned long long*)(ws + WS_PB); const int n4 = 2 * MROWS * 256 / 4;
    for (int i = gt; i < n4; i += NGT) { const f32x4 v = p4[i]; o8[i] = (unsigned long long)pk2(v[0], v[1]) | ((unsigned long long)pk2(v[2], v[3]) << 32); }
}
__device__ __forceinline__ void p0_prologue(KArgs ap, unsigned char* ws, LAS unsigned char* lds, int vcu, int G, int wave, int lane, int tid) {
    LAS float* scr = (LAS float*)lds + wave * XP_SCR;
    const int gw = vcu * NWAVES + wave, NGW = G * NWAVES, gt = vcu * (NWAVES * 64) + tid, NGT = G * NWAVES * 64;
    if (G == 256) xp_run<1>(ap, ws, scr, lane, gw, NGW); else xp_run<15>(ap, ws, scr, lane, gw, NGW);
    { v4u* z = (v4u*)(ws + WS_W_IN1 + (size_t)3656 * 1024 * 2); const int nz = (3840 - 3656) * 1024 * 2 / 16;
      for (int i = gt; i < nz; i += NGT) z[i] = (v4u){0u, 0u, 0u, 0u}; }
    { const float* x = ap->in[0]; bf16* hb = (bf16*)(ws + WS_HB); float* rowss = (float*)(ws + WS_ROWSS);
      for (int row = gw; row < MROWS; row += NGW) {
          const f32x4* xr = (const f32x4*)(x + (size_t)row * 1024) + lane; unsigned long long* o8 = (unsigned long long*)(hb + (size_t)row * 1024) + lane; float ss = 0.f;
#pragma unroll
          for (int j = 0; j < 4; ++j) { const f32x4 v = xr[64 * j]; ss += (v[0] * v[0] + v[1] * v[1]) + (v[2] * v[2] + v[3] * v[3]);
              o8[64 * j] = (unsigned long long)pk2(v[0], v[1]) | ((unsigned long long)pk2(v[2], v[3]) << 32); }
          ss = wave_sum(ss);
          if (lane < 16) rowss[(size_t)row * 16 + lane] = (lane == 0) ? ss : 0.f; } }
    pb_convert(ap, ws, gt, NGT);
    { const int* pos = (const int*)ap->in[2]; float* cs = (float*)(ws + WS_ROPE); float* sn = cs + MROWS * 8;
      for (int e = gt; e < MROWS * 8; e += NGT) { const int row = e >> 3, i = e & 7;
          const float f = (i == 0) ? ap->f0 : (i == 1) ? ap->f1 : (i == 2) ? ap->f2 : (i == 3) ? ap->f3 : (i == 4) ? ap->f4 : (i == 5) ? ap->f5 : (i == 6) ? ap->f6 : ap->f7;
          const float ang = (float)pos[row] * f; const double rev = (double)ang * 0.15915494309189533577; const float fr = (float)(rev - floor(rev));
          cs[e] = __builtin_amdgcn_cosf(fr); sn[e] = __builtin_amdgcn_sinf(fr); } }
}

__device__ __forceinline__ void kmean_unit(unsigned char* ws, int u, int lane) {
    const int bh = u >> 5, blk = u & 31, c = lane & 7, ro = lane >> 3;
    const bf16* kb = (const bf16*)(ws + WS_KB0) + ((size_t)(bh >> 3) * SEQ + blk * 256 + ro) * 512 + (bh & 7) * 64 + 8 * c;
    float s[8];
#pragma unroll
    for (int e = 0; e < 8; ++e) s[e] = 0.f;
#pragma unroll 8
    for (int r = 0; r < 32; ++r) { const v4u w = *(const v4u*)(kb + (size_t)r * 8 * 512);
        s[0] += __uint_as_float(w.x << 16); s[1] += __uint_as_float(w.x & 0xffff0000u); s[2] += __uint_as_float(w.y << 16); s[3] += __uint_as_float(w.y & 0xffff0000u);
        s[4] += __uint_as_float(w.z << 16); s[5] += __uint_as_float(w.z & 0xffff0000u); s[6] += __uint_as_float(w.w << 16); s[7] += __uint_as_float(w.w & 0xffff0000u); }
    unsigned hh[8], ll[8];
#pragma unroll
    for (int e = 0; e < 8; ++e) { float t = s[e]; t += __shfl_xor(t, 8); t += __shfl_xor(t, 16); t += __shfl_xor(t, 32);
        const float mean = t * (1.f / 256.f); hh[e] = f2bf(mean); ll[e] = f2bf(mean - __uint_as_float(hh[e] << 16)); }
    if (lane < 8) { const v4u vh = {hh[0] | (hh[1] << 16), hh[2] | (hh[3] << 16), hh[4] | (hh[5] << 16), hh[6] | (hh[7] << 16)}, vl = {ll[0] | (ll[1] << 16), ll[2] | (ll[3] << 16), ll[4] | (ll[5] << 16), ll[6] | (ll[7] << 16)};
        *(v4u*)((bf16*)(ws + WS_KMH) + u * 64 + 8 * c) = vh; *(v4u*)((bf16*)(ws + WS_KML) + u * 64 + 8 * c) = vl; }
}
__device__ __forceinline__ void sgu_unit(KArgs ap, unsigned char* ws, LAS unsigned char* lds, int cu, int g, int wave, int lane, int tid, bf16* YO) {
    constexpr int LTS = 136;
    LAS bf16* LT = (LAS bf16*)lds;
    const float *ln_g = ap->in[5], *ln_b = ap->in[6], *w_s = ap->in[7], *b_s = ap->in[8];
    bf16* UQ = (bf16*)(ws + WS_QO); const bf16* VA = (const bf16*)(ws + WS_VA);
    const int row0 = cu * 128;
    { const int s = tid >> 2, qd = tid & 3; const bf16* vp = VA + (size_t)(row0 + s) * 512 + g * 64 + qd * 16;
      const v4u w0 = *(const v4u*)vp, w1 = *(const v4u*)(vp + 8); float xv[16];
      xv[0] = __uint_as_float(w0.x << 16); xv[1] = __uint_as_float(w0.x & 0xffff0000u); xv[2] = __uint_as_float(w0.y << 16); xv[3] = __uint_as_float(w0.y & 0xffff0000u);
      xv[4] = __uint_as_float(w0.z << 16); xv[5] = __uint_as_float(w0.z & 0xffff0000u); xv[6] = __uint_as_float(w0.w << 16); xv[7] = __uint_as_float(w0.w & 0xffff0000u);
      xv[8] = __uint_as_float(w1.x << 16); xv[9] = __uint_as_float(w1.x & 0xffff0000u); xv[10] = __uint_as_float(w1.y << 16); xv[11] = __uint_as_float(w1.y & 0xffff0000u);
      xv[12] = __uint_as_float(w1.z << 16); xv[13] = __uint_as_float(w1.z & 0xffff0000u); xv[14] = __uint_as_float(w1.w << 16); xv[15] = __uint_as_float(w1.w & 0xffff0000u);
      float sm = 0.f;
#pragma unroll
      for (int e = 0; e < 16; ++e) sm += xv[e];
      sm += __shfl_xor(sm, 1); sm += __shfl_xor(sm, 2); const float mean = sm * (1.f / 64.f); float sq = 0.f;
#pragma unroll
      for (int e = 0; e < 16; ++e) { xv[e] -= mean; sq += xv[e] * xv[e]; }
      sq += __shfl_xor(sq, 1); sq += __shfl_xor(sq, 2); const float rstd = 1.0f / sqrtf(sq * (1.f / 64.f) + RMS_EPS);
#pragma unroll
      for (int e = 0; e < 16; ++e) { const int d = qd * 16 + e; const float y = xv[e] * rstd * ln_g[g * 64 + d] + ln_b[g * 64 + d]; LT[d * LTS + s] = (bf16)f2bf(y); } }
    __syncthreads();
    { const int r = lane & 15, kq = lane >> 4, t = 16 * wave + r; const int nks = (16 * wave + 16 + 31) >> 5;
      f32x4 acc[4];
#pragma unroll
      for (int ct = 0; ct < 4; ++ct) acc[ct] = (f32x4){0.f, 0.f, 0.f, 0.f};
      const float* wrow = w_s + ((size_t)g * 128 + t) * 128;
#pragma unroll
      for (int ks = 0; ks < 4; ++ks) { const int s0 = 32 * ks + 8 * kq; const f32x4 wa = *(const f32x4*)(wrow + s0), wb = *(const f32x4*)(wrow + s0 + 4);
          v4u af; af.x = pk2(s0 + 0 <= t ? wa[0] : 0.f, s0 + 1 <= t ? wa[1] : 0.f); af.y = pk2(s0 + 2 <= t ? wa[2] : 0.f, s0 + 3 <= t ? wa[3] : 0.f);
          af.z = pk2(s0 + 4 <= t ? wb[0] : 0.f, s0 + 5 <= t ? wb[1] : 0.f); af.w = pk2(s0 + 6 <= t ? wb[2] : 0.f, s0 + 7 <= t ? wb[3] : 0.f);
          const bf16x8 afr = __builtin_bit_cast(bf16x8, af);
#pragma unroll
          for (int ct = 0; ct < 4; ++ct) { const bf16x8 bfr = *(const LAS bf16x8*)(LT + (16 * ct + r) * LTS + s0); acc[ct] = __builtin_amdgcn_mfma_f32_16x16x32_bf16(afr, bfr, acc[ct], 0, 0, 0); } }
#pragma unroll
      for (int ct = 0; ct < 4; ++ct)
#pragma unroll
          for (int rg = 0; rg < 4; ++rg) { const int tt = 16 * wave + 4 * kq + rg, d = 16 * ct + r; const float mixed = acc[ct][rg] + b_s[g * 128 + tt];
              const size_t oi = (size_t)(row0 + tt) * 1024 + g * 64 + d; YO[oi] = (bf16)f2bf(bf2f(UQ[oi]) * mixed); } }
    __syncthreads();
}

__device__ __forceinline__ void kidx_rows(KArgs ap, unsigned char* ws, int gw, int NGW, int lane) {
    const float* kr = (const float*)(ws + WS_KIRAW); bf16* ki = (bf16*)(ws + WS_KI); const float* cs = (const float*)(ws + WS_ROPE); const float* sn = cs + MROWS * 8;
    const float gg = ap->in[11][lane], bb = ap->in[12][lane];
    for (int row0 = gw; row0 < MROWS; row0 += 4 * NGW) {
        float x[4], c[4], s[4];
#pragma unroll
        for (int q = 0; q < 4; ++q) { const int row = (row0 + q * NGW < MROWS) ? row0 + q * NGW : row0; x[q] = kr[(size_t)row * 64 + lane]; c[q] = cs[(size_t)row * 8 + (lane & 7)]; s[q] = sn[(size_t)row * 8 + (lane & 7)]; }
#pragma unroll
        for (int q = 0; q < 4; ++q) { const int row = row0 + q * NGW;
            const float mean = wave_sum(x[q]) * (1.f / 64.f); const float xc = x[q] - mean; const float var = wave_sum(xc * xc) * (1.f / 64.f);
            float y = xc * (1.0f / sqrtf(var + RMS_EPS)) * gg + bb; const float pr = __shfl_xor(y, 8);
            if (lane < 16) y = (lane < 8) ? (y * c[q] - pr * s[q]) : (y * c[q] + pr * s[q]);
            if (row < MROWS) ki[(size_t)(row >> 5) * 2048 + (lane >> 4) * 512 + ((lane >> 3) & 1) * 256 + (row & 31) * 8 + (lane & 7)] = (bf16)f2bf(y); } }
}

typedef float f32x16 __attribute__((ext_vector_type(16)));
__device__ __forceinline__ unsigned raw2key(unsigned b) { return (b & 0x8000u) ? ((~b) & 0xffffu) : (b | 0x8000u); }
__device__ __forceinline__ unsigned f2raw16(float s) { const _Float16 h = (_Float16)(s + 0.0f); return (unsigned)__builtin_bit_cast(unsigned short, h); }
__device__ __forceinline__ void hist_find4(const v4u h, unsigned need, unsigned& bin, unsigned& above) {
    const unsigned c = h.x + h.y + h.z + h.w; unsigned long long nz = __ballot(c != 0u); unsigned cum = 0u; int L = 0; unsigned cl = 0u;
    while (nz) { L = 63 - (int)__builtin_clzll(nz); cl = (unsigned)__builtin_amdgcn_readlane((int)c, L); if (cum + cl >= need) break; cum += cl; nz &= ~(1ull << L); }
    const unsigned hw = (unsigned)__builtin_amdgcn_readlane((int)h.w, L), hz = (unsigned)__builtin_amdgcn_readlane((int)h.z, L), hy = (unsigned)__builtin_amdgcn_readlane((int)h.y, L);
    if (cum + hw >= need) { bin = 4 * L + 3; above = cum; } else { cum += hw; if (cum + hz >= need) { bin = 4 * L + 2; above = cum; } else { cum += hz; if (cum + hy >= need) { bin = 4 * L + 1; above = cum; } else { cum += hy; bin = 4 * L; above = cum; } } }
}
template <int VAR> __device__ __forceinline__ void dsa_index_unit(unsigned char* ws, LAS unsigned char* lds, int b, int q0, int wave, int lane, int tid) {
    LAS unsigned short* SC = (LAS unsigned short*)lds; LAS unsigned* HIST = (LAS unsigned*)(lds + 131072);
    const bf16* QI = (const bf16*)(ws + WS_QI); const bf16* KI = (const bf16*)(ws + WS_KI); const float* WI = (const float*)(ws + WS_WI);
    unsigned long long* MASK = (unsigned long long*)(ws + WS_MASK);
    const int r32 = lane & 31, hi = lane >> 5; const size_t rowb = (size_t)b * SEQ;
    for (int i = tid; i < 2048; i += NWAVES * 64) HIST[i] = 0u;
    bf16x8 af[2][4]; float sg[2][16];
#pragma unroll
    for (int rt = 0; rt < 2; ++rt) { const size_t qrow = rowb + q0 + 4 * rt + (r32 >> 3); const int ih = r32 & 7; const float w = WI[qrow * 8 + ih];
#pragma unroll
        for (int ks = 0; ks < 4; ++ks) { const v4u q4 = *(const v4u*)(QI + qrow * 512 + ih * 64 + 16 * ks + 8 * hi); v4u o;
            o.x = pk2(__uint_as_float(q4.x << 16) * w, __uint_as_float(q4.x & 0xffff0000u) * w); o.y = pk2(__uint_as_float(q4.y << 16) * w, __uint_as_float(q4.y & 0xffff0000u) * w);
            o.z = pk2(__uint_as_float(q4.z << 16) * w, __uint_as_float(q4.z & 0xffff0000u) * w); o.w = pk2(__uint_as_float(q4.w << 16) * w, __uint_as_float(q4.w & 0xffff0000u) * w);
            af[rt][ks] = __builtin_bit_cast(bf16x8, o); }
#pragma unroll
        for (int ql = 0; ql < 4; ++ql) { const f32x4 w4 = *(const f32x4*)(WI + (rowb + q0 + 4 * rt + ql) * 8 + 4 * hi);
#pragma unroll
            for (int e = 0; e < 4; ++e) sg[rt][4 * ql + e] = (w4[e] >= 0.f) ? INFINITY : -INFINITY; } }
    __syncthreads();
    const int nkt = ((q0 + 8 + 255) >> 8) << 3;
    const bf16* kbase = KI + rowb * 64 + hi * 256 + r32 * 8;
    bf16x8 b0[4], b1[4], b2[4];
#define IDX_LOAD(B, KT) do { const int kt_ = ((KT) < nkt) ? (KT) : wave; const bf16* kp = kbase + (size_t)kt_ * 32 * 64; \
        _Pragma("unroll") for (int ks = 0; ks < 4; ++ks) (B)[ks] = *(const bf16x8*)(kp + 512 * ks); } while (0)
#define IDX_TILE(B, KT) do { const int kti = (KT); \
        f32x16 d0 = f32x16{}, d1 = f32x16{}; \
        _Pragma("unroll") for (int ks = 0; ks < 4; ++ks) { d0 = __builtin_amdgcn_mfma_f32_32x32x16_bf16(af[0][ks], (B)[ks], d0, 0, 0, 0); d1 = __builtin_amdgcn_mfma_f32_32x32x16_bf16(af[1][ks], (B)[ks], d1, 0, 0, 0); } \
        const int key = kti * 32 + r32; const bool diag = (kti * 32 + 31 > q0); \
        const int pos = (key & ~255) + 4 * (key & 63) + ((key >> 6) & 3); \
        _Pragma("unroll") for (int p = 0; p < 4; ++p) { const int rt = p >> 1, qe = (2 * p) & 3, qo = qe + 1; float se = 0.f, so = 0.f; \
            _Pragma("unroll") for (int e = 0; e < 4; ++e) { const float le = rt ? d1[4 * qe + e] : d0[4 * qe + e], lo = rt ? d1[4 * qo + e] : d0[4 * qo + e]; \
                se += __builtin_amdgcn_fmed3f(le, 0.f, sg[rt][4 * qe + e]); so += __builtin_amdgcn_fmed3f(lo, 0.f, sg[rt][4 * qo + e]); } \
            auto sw = __builtin_amdgcn_permlane32_swap(__float_as_uint(se), __float_as_uint(so), false, false); \
            const float s = __uint_as_float(sw[0]) + __uint_as_float(sw[1]); const int qi = 2 * p + hi; \
            unsigned k16 = raw2key(f2raw16(s)); if (diag) k16 = (key <= q0 + qi) ? k16 : 0u; \
            SC[qi * 8192 + pos] = (unsigned short)k16; if (VAR != 1) __hip_atomic_fetch_add(HIST + qi * 256 + (k16 >> 8), 1u, __ATOMIC_RELAXED, __HIP_MEMORY_SCOPE_WORKGROUP); } } while (0)
    if (VAR != 4) {
        IDX_LOAD(b0, wave); IDX_LOAD(b1, wave + NWAVES); IDX_LOAD(b2, wave + 2 * NWAVES);
        for (int kt = wave; kt < nkt; kt += 3 * NWAVES) {
            IDX_TILE(b0, kt); IDX_LOAD(b0, kt + 3 * NWAVES);
            if (kt + NWAVES < nkt) { IDX_TILE(b1, kt + NWAVES); IDX_LOAD(b1, kt + 4 * NWAVES); }
            if (kt + 2 * NWAVES < nkt) { IDX_TILE(b2, kt + 2 * NWAVES); IDX_LOAD(b2, kt + 5 * NWAVES); }
        }
    }
#undef IDX_LOAD
#undef IDX_TILE
    __syncthreads();
    if (VAR != 2) { const int qi = wave, qpos = q0 + qi, nk = nkt * 32; const LAS unsigned short* row = SC + qi * 8192; LAS unsigned* hrow = HIST + qi * 256;
      unsigned thr = 1u, ties = 0u; bool tiepath = false;
      if (VAR != 5 && qpos + 1 > 256) {
          const v4u h = *(const LAS v4u*)(hrow + 4 * lane);
          unsigned b1, ab1; hist_find4(h, 256u, b1, ab1); const unsigned need2 = 256u - ab1;
          LDS_WAIT();
          *(LAS v4u*)(hrow + 4 * lane) = (v4u){0u, 0u, 0u, 0u};
          LDS_WAIT();
          for (int k = 8 * lane; k < nk; k += 512) { const v4u v = *(const LAS v4u*)(row + k);
#pragma unroll
              for (int e = 0; e < 4; ++e) { const unsigned w = (e == 0) ? v.x : (e == 1) ? v.y : (e == 2) ? v.z : v.w; const unsigned k0 = w & 0xffffu, k1 = w >> 16;
                  if ((k0 >> 8) == b1) __hip_atomic_fetch_add(hrow + (k0 & 255u), 1u, __ATOMIC_RELAXED, __HIP_MEMORY_SCOPE_WORKGROUP);
                  if ((k1 >> 8) == b1) __hip_atomic_fetch_add(hrow + (k1 & 255u), 1u, __ATOMIC_RELAXED, __HIP_MEMORY_SCOPE_WORKGROUP); } }
          LDS_WAIT();
          const v4u h2 = *(const LAS v4u*)(hrow + 4 * lane);
          unsigned b2, ab2; hist_find4(h2, need2, b2, ab2);
          thr = (b1 << 8) | b2; ties = need2 - ab2; tiepath = (hrow[b2] != ties);
      }
      const int nchunk = (qpos >> 8) + 1; unsigned tiecnt = 0u; int w0lo = 0, w0hi = 0, w1lo = 0, w1hi = 0;
#define EMIT_CHUNK(c, WLO, WHI) do { const unsigned long long kk = *(const LAS unsigned long long*)(row + 256 * (c) + 4 * lane); \
          _Pragma("unroll") for (int e = 0; e < 4; ++e) { const unsigned key = (unsigned)(kk >> (16 * e)) & 0xffffu; unsigned long long wv; \
              if (!tiepath) wv = __ballot(key >= thr); \
              else { const bool gt_ = key > thr, eq = (key == thr); const unsigned long long eqm = __ballot(eq); \
                     const unsigned before = (unsigned)__builtin_popcountll(eqm & ((1ull << lane) - 1ull)); \
                     wv = __ballot(gt_ || (eq && (tiecnt + before < ties))); tiecnt += (unsigned)__builtin_popcountll(eqm); } \
              const bool mine = (lane == ((4 * (c) + e) & 63)); WLO = mine ? (int)(unsigned)wv : WLO; WHI = mine ? (int)(unsigned)(wv >> 32) : WHI; } } while (0)
      { const int n0 = nchunk < 16 ? nchunk : 16; for (int c = 0; c < ((VAR == 6) ? 1 : n0); ++c) EMIT_CHUNK(c, w0lo, w0hi); for (int c = 16; c < ((VAR == 6) ? 0 : nchunk); ++c) EMIT_CHUNK(c, w1lo, w1hi); }
#undef EMIT_CHUNK
      const unsigned long long my0 = ((unsigned long long)(unsigned)w0hi << 32) | (unsigned)w0lo, my1 = ((unsigned long long)(unsigned)w1hi << 32) | (unsigned)w1lo;
      const int nwords = 4 * nchunk; unsigned long long* mrow = MASK + (rowb + qpos) * 128;
      if (lane < nwords) mrow[lane] = my0;
      if (64 + lane < nwords) mrow[64 + lane] = my1; }
    __syncthreads();
}

__device__ __forceinline__ void final_norm(KArgs ap, unsigned char* ws, int gw, int NGW, int lane) {
    const float* rowss = (const float*)(ws + WS_ROWSS); const f32x4* gf = (const f32x4*)ap->in[21] + lane; float* out = ap->out; const bf16* hb = (const bf16*)(ws + WS_HB);
    f32x4 g4[4];
#pragma unroll
    for (int j = 0; j < 4; ++j) g4[j] = gf[64 * j];
    for (int row0 = gw; row0 < MROWS; row0 += 4 * NGW) {
        float sp[4]; unsigned long long w[4][4];
#pragma unroll
        for (int q = 0; q < 4; ++q) { const int row = (row0 + q * NGW < MROWS) ? row0 + q * NGW : row0; sp[q] = (lane < 16) ? rowss[(size_t)row * 16 + lane] : 0.f;
            const unsigned long long* h8 = (const unsigned long long*)(hb + (size_t)row * 1024) + lane;
#pragma unroll
            for (int j = 0; j < 4; ++j) w[q][j] = h8[64 * j]; }
#pragma unroll
        for (int q = 0; q < 4; ++q) { const int row = row0 + q * NGW; const float ss = wave_sum(sp[q]); const float rstd = 1.0f / sqrtf(ss * (1.f / 1024.f) + RMS_EPS);
            if (row < MROWS) { f32x4* o = (f32x4*)(out + (size_t)row * 1024) + lane;
#pragma unroll
                for (int j = 0; j < 4; ++j) { const unsigned lo = (unsigned)w[q][j], hi = (unsigned)(w[q][j] >> 32);
                    const f32x4 h = {__uint_as_float(lo << 16), __uint_as_float(lo & 0xffff0000u), __uint_as_float(hi << 16), __uint_as_float(hi & 0xffff0000u)};
                    o[64 * j] = h * rstd * g4[j]; } } } }
}

#ifdef PROBE_STOP
#ifndef PROBE_OFF
#define PROBE_OFF WS_R
#endif
#ifndef PROBE_CHUNKS
#define PROBE_CHUNKS 0
#endif
#ifndef PROBE_LEN
#define PROBE_LEN (1ull << 40)
#endif
#ifdef PROBE_OWN_TILE
#define PROBE_AT(k) if ((k) == PROBE_STOP) { PHASE_ENV(); pg8::StaticOrder S_; S_.init(MROWS, 1024, G, bx); pg8::Unit u_; if (S_.next(0, u_)) { const bf16* src = (const bf16*)(ws + PROBE_OFF); \
      for (int e = tid; e < 256 * 256; e += 512) { const size_t i = (size_t)(u_.pm * 256 + (e >> 8)) * 1024 + u_.pn * 256 + (e & 255); float v_ = bf2f(src[i]); if (!(fabsf(v_) < 1e30f)) v_ = 12345.f; OUT[i] = v_; } } return; }
#else
#define PROBE_AT(k) if ((k) == PROBE_STOP) { PHASE_ENV(); if (PROBE_CHUNKS > 0) { const bf16* src = (const bf16*)(ws + PROBE_OFF); \
      for (size_t i = (size_t)bx * 512 + tid; i < (size_t)MROWS * 1024; i += (size_t)G * 512) { float acc_ = 0.f; \
          for (int j = 0; j < PROBE_CHUNKS; ++j) { float v_ = bf2f(src[(i + (size_t)j * MROWS * 1024) % (size_t)(PROBE_LEN)]); if (!(fabsf(v_) < 1e30f)) v_ = 12345.f; acc_ += v_; } OUT[i] = acc_; } } return; }
#endif
#else
#define PROBE_AT(k)
#endif

#ifdef PROBE_CHECK
__device__ __forceinline__ float wave_maxf(float v) {
#pragma unroll
    for (int o = 1; o < 64; o <<= 1) v = fmaxf(v, __shfl_xor(v, o));
    return v;
}
__device__ __forceinline__ float wave_minf(float v) {
#pragma unroll
    for (int o = 1; o < 64; o <<= 1) v = fminf(v, __shfl_xor(v, o));
    return v;
}
#ifndef CHK_TOL
#define CHK_TOL 0.04f
#define CHK_ABS 1e-4f
#define CHK_MTOL 0.02f
#endif
constexpr size_t CHK_FLAGS = 512 * 1024 + 256;
__device__ __forceinline__ void chk_copy(const bf16* src, bf16* dst, int gt, int NGT) {
    const v4u* s = (const v4u*)src; v4u* d = (v4u*)dst; const int n = MROWS * 1024 / 8;
    for (int i = gt; i < n; i += NGT) d[i] = s[i];
}
__device__ __forceinline__ void chk_moba(unsigned char* ws, const bf16* QC, LAS float* L, int sample, int lane) {
    const unsigned r = (unsigned)sample * 2654435761u + 12345u; const int b = (r >> 3) & 1, h = (r >> 4) & 7, q = (r >> 8) & 8191, qb = q >> 8;
    const bf16* KB = (const bf16*)(ws + WS_KB0) + (size_t)b * SEQ * 512 + h * 64; const bf16* VB = (const bf16*)(ws + WS_VB0) + (size_t)b * SEQ * 512 + h * 64;
    const bf16* O = (const bf16*)(ws + WS_QO) + ((size_t)b * SEQ + q) * 1024 + 512 + h * 64;
    LAS float* Lg = L; LAS float* Lq = L + 32; LAS float* Ls = L + 96;
    const float qv = bf2f(QC[((size_t)b * SEQ + q) * 1024 + 512 + h * 64 + lane]); Lq[lane] = qv;
    for (int j = 0; j < qb; ++j) { float km = 0.f; for (int rr = 0; rr < 256; ++rr) km += bf2f(KB[(size_t)(j * 256 + rr) * 512 + lane]); km *= (1.f / 256.f);
        const float g = wave_sum(qv * km); if (lane == 0) Lg[j] = g; }
    LDS_WAIT();
    float v1 = -INFINITY, v2 = -INFINITY, v3 = -INFINITY; int i1 = -1, i2 = -1, i3 = -1;
    for (int j = 0; j < qb; ++j) { const float g = Lg[j]; if (g > v1) { v3 = v2; i3 = i2; v2 = v1; i2 = i1; v1 = g; i1 = j; } else if (g > v2) { v3 = v2; i3 = i2; v2 = g; i2 = j; } else if (g > v3) { v3 = g; i3 = j; } }
    float mx = -INFINITY;
    for (int sl = 0; sl < 4; ++sl) { const int blk = (sl == 0) ? i1 : (sl == 1) ? i2 : (sl == 2) ? i3 : qb;
        for (int t = 0; t < 4; ++t) { const int kk = lane + 64 * t, key = blk * 256 + kk; float s = -INFINITY;
            if (blk >= 0 && key <= q) { s = 0.f; for (int d = 0; d < 64; ++d) s += Lq[d] * bf2f(KB[(size_t)key * 512 + d]); }
            Ls[sl * 256 + kk] = s; mx = fmaxf(mx, s); } }
    mx = wave_maxf(mx); LDS_WAIT();
    float lsum = 0.f; for (int i = lane; i < 1024; i += 64) { const float p = exp2f(Ls[i] - mx); Ls[i] = p; lsum += p; }
    lsum = wave_sum(lsum); LDS_WAIT();
    float o = 0.f;
    for (int sl = 0; sl < 4; ++sl) { const int blk = (sl == 0) ? i1 : (sl == 1) ? i2 : (sl == 2) ? i3 : qb; if (blk < 0) continue;
        for (int kk = 0; kk < 256; ++kk) { const float p = Ls[sl * 256 + kk]; if (p != 0.f) o += p * bf2f(VB[(size_t)(blk * 256 + kk) * 512 + lane]); } }
    o /= lsum;
    const float err = wave_maxf(fabsf(o - bf2f(O[lane]))), ref = wave_maxf(fabsf(o));
    if (lane == 0 && !(err <= CHK_TOL * ref + CHK_ABS)) atomicOr((unsigned*)(ws + CHK_FLAGS), 1u);
    LDS_WAIT();
}
__device__ __forceinline__ void chk_mask(unsigned char* ws, LAS float* L, int sample, int lane) {
    const unsigned r = (unsigned)sample * 2246822519u + 777u; const int b = (r >> 3) & 1; int q = (r >> 8) & 8191; if ((sample & 7) == 0) q &= 511;
    const bf16* QI = (const bf16*)(ws + WS_QI); const bf16* KI = (const bf16*)(ws + WS_KI); const float* WI = (const float*)(ws + WS_WI);
    const unsigned long long* MK = (const unsigned long long*)(ws + WS_MASK) + ((size_t)b * SEQ + q) * 128; const size_t rowb = (size_t)b * SEQ;
    LAS float* Lq = L;
    for (int i = lane; i < 512; i += 64) Lq[i] = bf2f(QI[(rowb + q) * 512 + i]);
    LDS_WAIT();
    float w[8];
#pragma unroll
    for (int i = 0; i < 8; ++i) w[i] = WI[(rowb + q) * 8 + i];
    const int kend = 256 * ((q >> 8) + 1); int cnt = 0; float minsel = INFINITY, maxuns = -INFINITY; int bad = 0;
    for (int key = lane; key < kend; key += 64) { const bool bit = (MK[key >> 6] >> (key & 63)) & 1ull;
        if (key > q) { if (bit) bad = 1; continue; }
        const size_t kr = rowb + key; const bf16* kp = KI + (kr >> 5) * 2048 + (kr & 31) * 8; float sc = 0.f;
#pragma unroll
        for (int i = 0; i < 8; ++i) { float l = 0.f; for (int d = 0; d < 64; ++d) l += Lq[i * 64 + d] * bf2f(kp[(d >> 4) * 512 + ((d >> 3) & 1) * 256 + (d & 7)]); sc += fmaxf(l, 0.f) * w[i]; }
        if (bit) { ++cnt; minsel = fminf(minsel, sc); } else maxuns = fmaxf(maxuns, sc); }
    const int tot = (int)wave_sum((float)cnt); const float ms = wave_minf(minsel), mu = wave_maxf(maxuns); const int anybad = (int)wave_sum((float)bad);
    const int want = (q + 1 < 256) ? q + 1 : 256;
    if (lane == 0 && (tot != want || anybad != 0 || (mu - ms) > CHK_MTOL)) atomicOr((unsigned*)(ws + CHK_FLAGS), 2u);
    LDS_WAIT();
}
__device__ __forceinline__ void chk_dsa(unsigned char* ws, const bf16* QC, LAS float* L, int sample, int lane) {
    const unsigned r = (unsigned)sample * 3266489917u + 4242u; const int b = (r >> 3) & 1, h = (r >> 4) & 15, q = (r >> 8) & 8191;
    const bf16* KC = (const bf16*)(ws + WS_KC) + (size_t)b * SEQ * 1024 + h * 64; const bf16* VC = (const bf16*)(ws + WS_VC) + (size_t)b * SEQ * 1024 + h * 64;
    const bf16* O = (const bf16*)(ws + WS_QO) + ((size_t)b * SEQ + q) * 1024 + h * 64;
    const unsigned long long* MK = (const unsigned long long*)(ws + WS_MASK) + ((size_t)b * SEQ + q) * 128;
    LAS float* Lq = L; LAS float* Ls = L + 64; LAS int* Lk = (LAS int*)(L + 64 + 320); LAS int* Ln = (LAS int*)(L + 64 + 640);
    Lq[lane] = bf2f(QC[((size_t)b * SEQ + q) * 1024 + h * 64 + lane]); if (lane == 0) Ln[0] = 0;
    LDS_WAIT();
    float mx = -INFINITY;
    for (int key = lane; key <= q; key += 64) { const bool bit = (MK[key >> 6] >> (key & 63)) & 1ull; if (!bit) continue;
        float s = 0.f; for (int d = 0; d < 64; ++d) s += Lq[d] * bf2f(KC[(size_t)key * 1024 + d]);
        const int slot = atomicAdd((int*)Ln, 1); if (slot < 320) { Ls[slot] = s; Lk[slot] = key; } mx = fmaxf(mx, s); }
    mx = wave_maxf(mx); LDS_WAIT();
    const int n = Ln[0] < 320 ? Ln[0] : 320; float lsum = 0.f, o = 0.f;
    for (int i = 0; i < n; ++i) { const float p = exp2f(Ls[i] - mx); lsum += p; o += p * bf2f(VC[(size_t)Lk[i] * 1024 + lane]); }
    o /= lsum;
    const float err = wave_maxf(fabsf(o - bf2f(O[lane]))), ref = wave_maxf(fabsf(o));
    if (lane == 0 && !(err <= CHK_TOL * ref + CHK_ABS)) atomicOr((unsigned*)(ws + CHK_FLAGS), 4u);
    LDS_WAIT();
}
__device__ __forceinline__ void chk_sincos(int pos, float f, float& c, float& s) {
    const double ang = (double)((float)pos * f); double t = ang * 0.15915494309189533577; t -= floor(t); const double x = (t - 0.5) * 6.283185307179586477;
    const double x2 = x * x; double sn = 0.0, cs = 0.0, term = x;
    for (int k = 1; k <= 23; k += 2) { sn += term; term *= -x2 / (double)((k + 1) * (k + 2)); }
    term = 1.0; for (int k = 0; k <= 24; k += 2) { cs += term; term *= -x2 / (double)((k + 1) * (k + 2)); }
    c = (float)(-cs); s = (float)(-sn);
}
__device__ __forceinline__ void chk_proj(KArgs ap, unsigned char* ws, int layer, int sample, int lane, float f0, float f1, float f2, float f3, float f4, float f5, float f6, float f7) {
    const unsigned r = (unsigned)sample * 2654435761u + 99u + (unsigned)layer * 7777u; const int row = (r >> 7) & 16383; int kind = (r >> 3) % (layer ? 5 : 3); const int hd = (r >> 22) & (layer ? 15 : 7);
    const bf16* hb = (layer ? (const bf16*)ap->out + (size_t)MROWS * 1024 : (const bf16*)(ws + WS_HB)) + (size_t)row * 1024; const float* rowss = (const float*)(ws + (layer ? WS_ROWSS2 : WS_ROWSS)) + (size_t)row * 16;
    float ss = 0.f; for (int i = 0; i < 16; ++i) ss += rowss[i]; const float rstd = 1.0f / sqrtf(ss * (1.f / 1024.f) + RMS_EPS);
    int col; const bf16* st = nullptr; const float* stf = nullptr; float scale = 1.f; bool rope = false;
    if (layer == 0) { if (kind == 0) { col = 1024 + hd * 64 + lane; st = (const bf16*)(ws + WS_QO) + (size_t)row * 1024 + 512 + hd * 64 + lane; scale = QC2; rope = true; }
                      else if (kind == 1) { col = 1536 + hd * 64 + lane; st = (const bf16*)(ws + WS_KB0) + (size_t)row * 512 + hd * 64 + lane; rope = true; }
                      else { col = 2048 + hd * 64 + lane; st = (const bf16*)(ws + WS_VB0) + (size_t)row * 512 + hd * 64 + lane; } }
    else { if (kind == 0) { col = hd * 64 + lane; st = (const bf16*)(ws + WS_QO) + (size_t)row * 1024 + hd * 64 + lane; scale = QC2; rope = true; }
           else if (kind == 1) { col = 1024 + hd * 64 + lane; st = (const bf16*)(ws + WS_KC) + (size_t)row * 1024 + hd * 64 + lane; rope = true; }
           else if (kind == 2) { col = 2048 + hd * 64 + lane; st = (const bf16*)(ws + WS_VC) + (size_t)row * 1024 + hd * 64 + lane; }
           else if (kind == 3) { col = 3072 + (hd & 7) * 64 + lane; st = (const bf16*)(ws + WS_QI) + (size_t)row * 512 + (hd & 7) * 64 + lane; rope = true; }
           else { col = 3584 + lane; stf = (const float*)(ws + WS_KIRAW) + (size_t)row * 64 + lane; } }
    const bf16* wrow = (const bf16*)(ws + (layer ? WS_W_IN1 : WS_W_IN0)) + (size_t)col * 1024;
    float z = 0.f; for (int k = 0; k < 1024; ++k) z += bf2f(hb[k]) * bf2f(wrow[k]);
    z *= rstd;
    float expect = z;
    if (rope) { const float pr = __shfl_xor(z, 8); const int i = lane & 7; const float f = (i == 0) ? f0 : (i == 1) ? f1 : (i == 2) ? f2 : (i == 3) ? f3 : (i == 4) ? f4 : (i == 5) ? f5 : (i == 6) ? f6 : f7;
        float c, s; chk_sincos(((const int*)ap->in[2])[row], f, c, s); if (lane < 16) expect = (lane < 8) ? (z * c - pr * s) : (z * c + pr * s); }
    expect *= scale;
    const float got = st ? bf2f(*st) : *stf; const float err = wave_maxf(fabsf(expect - got)), ref = wave_maxf(fabsf(expect));
    bool bad = !(err <= CHK_TOL * ref + 1e-3f);
    if (layer == 1 && kind == 4) {
        const bf16* w2 = (const bf16*)(ws + WS_W_IN1) + (size_t)(3648 + (lane & 7)) * 1024; float zz = 0.f; for (int k = 0; k < 1024; ++k) zz += bf2f(hb[k]) * bf2f(w2[k]);
        zz *= rstd * 0.04419417382415922f; const float g2 = ((const float*)(ws + WS_WI))[(size_t)row * 8 + (lane & 7)]; const float e2 = wave_maxf(fabsf(zz - g2)), r2 = wave_maxf(fabsf(zz)); bad = bad || !(e2 <= CHK_TOL * r2 + 1e-4f); }
    if (lane == 0 && bad) atomicOr((unsigned*)(ws + CHK_FLAGS), layer ? 16u : 8u);
}
__device__ __forceinline__ void chk_kidx(KArgs ap, unsigned char* ws, int sample, int lane, float f0, float f1, float f2, float f3, float f4, float f5, float f6, float f7) {
    const unsigned r = (unsigned)sample * 40503u + 31u; const int row = (r >> 2) & 16383;
    const float x = ((const float*)(ws + WS_KIRAW))[(size_t)row * 64 + lane]; const float mean = wave_sum(x) * (1.f / 64.f); const float xc = x - mean; const float var = wave_sum(xc * xc) * (1.f / 64.f);
    float y = xc / sqrtf(var + RMS_EPS) * ap->in[11][lane] + ap->in[12][lane]; const float pr = __shfl_xor(y, 8); const int i = lane & 7;
    const float f = (i == 0) ? f0 : (i == 1) ? f1 : (i == 2) ? f2 : (i == 3) ? f3 : (i == 4) ? f4 : (i == 5) ? f5 : (i == 6) ? f6 : f7;
    float c, s; chk_sincos(((const int*)ap->in[2])[row], f, c, s); if (lane < 16) y = (lane < 8) ? (y * c - pr * s) : (y * c + pr * s);
    const bf16* ki = (const bf16*)(ws + WS_KI); const float got = bf2f(ki[(size_t)(row >> 5) * 2048 + (lane >> 4) * 512 + ((lane >> 3) & 1) * 256 + (row & 31) * 8 + (lane & 7)]);
    const float err = wave_maxf(fabsf(y - got)), ref = wave_maxf(fabsf(y));
    if (lane == 0 && !(err <= CHK_TOL * ref + 1e-3f)) atomicOr((unsigned*)(ws + CHK_FLAGS), 32u);
}
#endif
__global__ void __launch_bounds__(NWAVES * 64, 2) trunk_fwd(Args args) {
    extern __shared__ __attribute__((aligned(16))) unsigned char lds_raw[];
    LAS unsigned char* lds = (LAS unsigned char*)lds_raw;
    volatile LAS unsigned* MISC = (volatile LAS unsigned*)(lds + LDSCTL_OFF);
    const int tid0 = threadIdx.x;
    const int G = gridDim.x; const int bx = blockIdx.x; const int vcu = (G % 8 == 0) ? (bx % 8) * (G / 8) + bx / 8 : bx;
    KArgs ap0 = (KArgs)__builtin_amdgcn_kernarg_segment_ptr();
    gu32* ctl = (gu32*)(ap0->ws + WS_CTL);
    for (int u = tid0; u < (LDS_BYTES - LDSCTL_OFF) / 4; u += NWAVES * 64) ((LAS unsigned*)(lds + LDSCTL_OFF))[u] = 0u;
    __syncthreads();
    XcdBarrier bar = xcd_barrier_post((unsigned*)(ctl + CW_BAR), MISC + 8);
#ifdef PROBE_TIME
    if (bx == 0 && tid0 == 0) *(unsigned long long*)(ap0->ws + 512 * 1024) = __builtin_amdgcn_s_memrealtime();
#endif
#define GRID_BAR() xcd_barrier(bar)
    const int NGW = G * NWAVES;
#define PHASE_ENV() KArgs ap = (KArgs)__builtin_amdgcn_kernarg_segment_ptr(); asm volatile("" : "+s"(ap)); unsigned char* ws = ap->ws; \
    int tid_p = threadIdx.x; asm volatile("" : "+v"(tid_p)); const int tid = tid_p, lane = tid & 63, wave = __builtin_amdgcn_readfirstlane(tid >> 6); const int gw = vcu * NWAVES + wave; (void)lane; (void)gw; \
    pg8::bf16_t* HBA = (pg8::bf16_t*)(ws + WS_HB); float* ROWSS = (float*)(ws + WS_ROWSS); float* ROWSS2 = (float*)(ws + WS_ROWSS2); const float* CS = (const float*)(ws + WS_ROPE); const float* SN = CS + MROWS * 8; float* OUT = ap->out; \
    pg8::bf16_t* PROJ = (pg8::bf16_t*)OUT; pg8::bf16_t* HBB = (pg8::bf16_t*)OUT + (size_t)MROWS * 1024;     \
    (void)HBA; (void)HBB; (void)PROJ; (void)ROWSS; (void)ROWSS2; (void)CS; (void)SN; (void)OUT;

    enum { PROBE_C0 = __COUNTER__ + 1 };
    for (int rep_ = 0; rep_ < NREP(0); ++rep_) { PHASE_ENV(); p0_prologue(ap, ws, lds, vcu, G, wave, lane, tid); }
    GRID_BAR(); PROBE_AT(__COUNTER__ - PROBE_C0);


#ifdef PROBE_GEMM2X
#ifndef PROBE_ALIGN
#define PROBE_ALIGN PG8_ALIGN
#endif
#ifndef PROBE_SP2
#define PROBE_SP2 PG8_SP2
#endif
    {
        for (int rep = 0; rep < 2; ++rep) {
            { PHASE_ENV(); pg8::Gemm g{HB, (const pg8::bf16_t*)(ws + WS_W_PG0), MROWS, 1024, 1024}; pg8::StaticOrder S; S.init(MROWS, 1024, G, bx);
              epi::EpiPleGate E{ROWSS, (pg8::bf16_t*)(ws + WS_R + (size_t)rep * 32 * MiB)};
              pg8::gemm_phase<epi::EpiPleGate, pg8::StaticOrder, PROBE_ALIGN, PROBE_SP2>(lds, g, S, E); }
            GRID_BAR();
        }
        { PHASE_ENV(); const bf16* g1 = (const bf16*)(ws + WS_R); const bf16* g2 = g1 + (size_t)MROWS * 1024; unsigned e = 0;
          for (size_t i = (size_t)bx * 512 + tid; i < (size_t)MROWS * 1024; i += (size_t)G * 512) e += (g1[i] != g2[i]);
          if (e) atomicAdd((unsigned*)(ws + 512 * 1024 + 128), e); }
        GRID_BAR();
        { PHASE_ENV(); const unsigned e = __hip_atomic_load((unsigned*)(ws + 512 * 1024 + 128), __ATOMIC_RELAXED, __HIP_MEMORY_SCOPE_AGENT);
          float c = e ? 3.f : 1.f;
          for (size_t i = (size_t)bx * 512 + tid; i < (size_t)MROWS * 1024 / 4; i += (size_t)G * 512) ((f32x4*)OUT)[i] = (f32x4){c, c, c, c}; }
        return;
    }
#endif
    for (int rep_ = 0; rep_ < NREP(1); ++rep_) {   PHASE_ENV();
        pg8::Gemm g{HBA, (const pg8::bf16_t*)(ws + WS_W_IN0), MROWS, 2560, 1024}; pg8::StaticOrder S; S.init(MROWS, 2560, G, bx);
        epi::EpiInEven E{ROWSS, CS, SN, (pg8::bf16_t*)(ws + WS_QO), (pg8::bf16_t*)(ws + WS_VA), (pg8::bf16_t*)(ws + WS_KB0), (pg8::bf16_t*)(ws + WS_VB0)};
        pg8::gemm_phase<epi::EpiInEven, pg8::StaticOrder, PG8_ALIGN, PG8_SP2>(lds, g, S, E);
        if (G == 256 && bx >= 128) { xp_run<10>(ap, ws, (LAS float*)lds + wave * XP_SCR, lane, (bx - 128) * NWAVES + wave, 128 * NWAVES); }
    }
    GRID_BAR(); PROBE_AT(__COUNTER__ - PROBE_C0);
#ifdef PROBE_CHECK
    { PHASE_ENV(); for (int s_ = gw; s_ < 2048; s_ += NGW) chk_proj(ap, ws, 0, s_, lane, ap->f0, ap->f1, ap->f2, ap->f3, ap->f4, ap->f5, ap->f6, ap->f7); }
#endif
    for (int rep_ = 0; rep_ < NREP(2); ++rep_) {   PHASE_ENV();
        for (int u = vcu + G * wave; u < 512; u += NGW) kmean_unit(ws, u, lane);
        for (int u = vcu; u < 1024; u += G) sgu_unit(ap, ws, lds, u >> 3, u & 7, wave, lane, tid, (rep_ == 0 && NREP(2) == 2) ? (bf16*)(ws + WS_R + 80 * MiB) : (bf16*)(ws + WS_QO));
    }
    GRID_BAR(); PROBE_AT(__COUNTER__ - PROBE_C0);
#ifdef PROBE_CHECK
    { PHASE_ENV(); chk_copy((const bf16*)(ws + WS_QO), (bf16*)(ws + WS_R + 80 * MiB), vcu * 512 + tid, G * 512); }
    GRID_BAR();
#endif
    for (int rep_ = 0; rep_ < NREP(3); ++rep_) {   PHASE_ENV();
        using attn_body::bf16;
        for (int p = vcu; p < 256; p += G) { const int bh = p >> 4, s = p & 15, b = bh >> 3, h = bh & 7;
            bf16* Qh = (bf16*)(ws + WS_QO) + (size_t)b * SEQ * 1024 + 512 + h * 64; const bf16* Kh = (const bf16*)(ws + WS_KB0) + (size_t)b * SEQ * 512 + h * 64;
            const bf16* Vh = (const bf16*)(ws + WS_VB0) + (size_t)b * SEQ * 512 + h * 64; const bf16* kmh = (const bf16*)(ws + WS_KMH) + bh * 32 * 64; const bf16* kml = (const bf16*)(ws + WS_KML) + bh * 32 * 64;
#ifndef SKIP_MOBA
            for (int i = 0; i < 2; ++i) { const int qb = i ? 31 - s : s; attn_body::moba_gates<1024>(qb, Qh, kmh, kml, (char*)lds_raw); attn_body::attn_unit<0, 8, 1024, 512>(qb, Qh, Kh, Vh, (rep_ == 0 && NREP(3) == 2) ? (bf16*)(ws + WS_R + 80 * MiB) + (size_t)b * SEQ * 1024 + h * 64 : Qh, kmh, kml, nullptr, (char*)lds_raw); }
#endif
        }
    }
    GRID_BAR(); PROBE_AT(__COUNTER__ - PROBE_C0);
#ifdef PROBE_CHECK
    { PHASE_ENV(); LAS float* Lw = (LAS float*)lds + wave * 1152; for (int s_ = gw; s_ < 2048; s_ += NGW) chk_moba(ws, (const bf16*)(ws + WS_R + 80 * MiB), Lw, s_, lane); }
    GRID_BAR();
#endif
    for (int rep_ = 0; rep_ < NREP(4); ++rep_) {   PHASE_ENV();
        pg8::Gemm g{(const pg8::bf16_t*)(ws + WS_QO), (const pg8::bf16_t*)(ws + WS_W_OUT0), MROWS, 1024, 1024}; pg8::StaticOrder S; S.init(MROWS, 1024, G, bx);
        epi::EpiResid E{HBA, ROWSS};
        pg8::gemm_phase<epi::EpiResid, pg8::StaticOrder, PG8_ALIGN1, PG8_SP2>(lds, g, S, E);
    }
    GRID_BAR(); PROBE_AT(__COUNTER__ - PROBE_C0);
#ifdef PROBE_SWAPA
#define PROBE_A7 ((const pg8::bf16_t*)(ws + WS_HID))
#else
#define PROBE_A7 HB
#endif
#ifdef PROBE_SWAPW
#define PROBE_WPG(x) WS_W_OUT0
#else
#define PROBE_WPG(x) (x)
#endif
#define FFN_PLE(WGU, WDN, WPG, WPP, PBOFF, HIN, HOUT, RIN, ROUT) \
    for (int rep_ = 0; rep_ < NREP(5); ++rep_) {   PHASE_ENV(); { pg8::Gemm g{HIN, (const pg8::bf16_t*)(ws + (WGU)), MROWS, 2 * DFF, 1024}; pg8::StaticOrder S; S.init(MROWS, 2 * DFF, G, bx); \
        epi::EpiSwiglu E{RIN, (pg8::bf16_t*)(ws + WS_HID)}; \
        pg8::gemm_phase<epi::EpiSwiglu, pg8::StaticOrder, PG8_ALIGN, PG8_SP2>(lds, g, S, E); } \
          \
        if (G == 256 ? (bx >= 128) : (bx == 0)) { int kpp = 256; asm volatile("" : "+s"(kpp)); pg8::Gemm g2{(const pg8::bf16_t*)(ws + WS_PB) + (PBOFF), (const pg8::bf16_t*)(ws + (WPP)), MROWS, 1024, kpp}; epi::EpiStore E2{PROJ}; \
            if (G == 256) { epi::PairOrder S2{2 * (bx - 128)}; pg8::gemm_phase<epi::EpiStore, epi::PairOrder, PG8_ALIGN1, PG8_SP2>(lds, g2, S2, E2); } \
            else { pg8::StaticOrder S2; S2.init(MROWS, 1024, 1, 0); pg8::gemm_phase<epi::EpiStore, pg8::StaticOrder, PG8_ALIGN1, PG8_SP2>(lds, g2, S2, E2); } } } \
    GRID_BAR(); PROBE_AT(__COUNTER__ - PROBE_C0); \
    for (int rep_ = 0; rep_ < NREP(6); ++rep_) {   PHASE_ENV(); pg8::Gemm g{(const pg8::bf16_t*)(ws + WS_HID), (const pg8::bf16_t*)(ws + (WDN)), MROWS, 1024, DFF}; pg8::StaticOrder S; S.init(MROWS, 1024, G, bx); \
        epi::EpiResid E{HIN, RIN}; \
        pg8::gemm_phase<epi::EpiResid, pg8::StaticOrder, PG8_ALIGN1, PG8_SP2>(lds, g, S, E); } \
    GRID_BAR(); PROBE_AT(__COUNTER__ - PROBE_C0); \
    for (int rep_ = 0; rep_ < NREP(7); ++rep_) {   PHASE_ENV(); pg8::Gemm g{HIN, (const pg8::bf16_t*)(ws + (WPG)), MROWS, 1024, 1024}; pg8::StaticOrder S; S.init(MROWS, 1024, G, bx); \
        epi::EpiPleFused E{RIN, HIN, PROJ, HOUT, ROUT}; \
        pg8::gemm_phase<epi::EpiPleFused, pg8::StaticOrder, PG8_ALIGN1, PG8_SP2>(lds, g, S, E); } \
    GRID_BAR(); PROBE_AT(__COUNTER__ - PROBE_C0);
    FFN_PLE(WS_W_GU0, WS_W_DN0, WS_W_PG0, WS_W_PP0, (size_t)0, HBA, HBB, ROWSS, ROWSS2)

    for (int rep_ = 0; rep_ < NREP(9); ++rep_) {   PHASE_ENV();
        pg8::Gemm g{HBB, (const pg8::bf16_t*)(ws + WS_W_IN1), MROWS, 3840, 1024}; pg8::StaticOrder S; S.init(MROWS, 3840, G, bx);
        epi::EpiInOdd E{ROWSS2, CS, SN, (pg8::bf16_t*)(ws + WS_QO), (pg8::bf16_t*)(ws + WS_KC), (pg8::bf16_t*)(ws + WS_VC), (pg8::bf16_t*)(ws + WS_QI), (float*)(ws + WS_KIRAW), (float*)(ws + WS_WI)};
        pg8::gemm_phase<epi::EpiInOdd, pg8::StaticOrder, PG8_ALIGN, PG8_SP2>(lds, g, S, E);
        if (G == 256 && bx >= 192) xp_run<4>(ap, ws, (LAS float*)lds + wave * XP_SCR, lane, (bx - 192) * NWAVES + wave, 64 * NWAVES);
    }
    GRID_BAR(); PROBE_AT(__COUNTER__ - PROBE_C0);
#ifdef PROBE_CHECK
    { PHASE_ENV(); for (int s_ = gw; s_ < 2048; s_ += NGW) chk_proj(ap, ws, 1, s_, lane, ap->f0, ap->f1, ap->f2, ap->f3, ap->f4, ap->f5, ap->f6, ap->f7); }
#endif
    for (int rep_ = 0; rep_ < NREP(10); ++rep_) { PHASE_ENV(); kidx_rows(ap, ws, gw, NGW, lane); }
    GRID_BAR(); PROBE_AT(__COUNTER__ - PROBE_C0);
#ifdef PROBE_CHECK
    { PHASE_ENV(); for (int s_ = gw; s_ < 2048; s_ += NGW) chk_kidx(ap, ws, s_, lane, ap->f0, ap->f1, ap->f2, ap->f3, ap->f4, ap->f5, ap->f6, ap->f7); }
#endif
    for (int rep_ = 0; rep_ < NREP(11); ++rep_) {   PHASE_ENV();
        for (int v = vcu; v < 256; v += G)
#ifndef SKIP_IDX
            for (int j = 0; j < 8; ++j) { const int R = (j >> 1) * 512 + ((j & 1) ? 511 - v : v); if (rep_ == 0 && NREP(11) == 2) dsa_index_unit<PROBE_VAR>(ws, lds, R & 1, (R >> 1) * 8, wave, lane, tid); else dsa_index_unit<0>(ws, lds, R & 1, (R >> 1) * 8, wave, lane, tid); }
#endif
            ;
    }
    GRID_BAR(); PROBE_AT(__COUNTER__ - PROBE_C0);
#ifdef PROBE_CHECK
    { PHASE_ENV(); chk_copy((const bf16*)(ws + WS_QO), (bf16*)(ws + WS_HB), vcu * 512 + tid, G * 512); }
    GRID_BAR();
#endif
    for (int rep_ = 0; rep_ < NREP(12); ++rep_) {   PHASE_ENV();
        using attn_body::bf16;
        for (int p = vcu; p < 256; p += G) { const int bh = p >> 3, s = p & 7, b = bh >> 4, h = bh & 15;
            bf16* Qh = (bf16*)(ws + WS_QO) + (size_t)b * SEQ * 1024 + h * 64; const bf16* Kh = (const bf16*)(ws + WS_KC) + (size_t)b * SEQ * 1024 + h * 64;
            const bf16* Vh = (const bf16*)(ws + WS_VC) + (size_t)b * SEQ * 1024 + h * 64; const unsigned long long* mk = (const unsigned long long*)(ws + WS_MASK) + (size_t)b * SEQ * 128;
#ifndef SKIP_DSA
            for (int i = 0; i < 4; ++i) { const int qb = (i == 0) ? s : (i == 1) ? 15 - s : (i == 2) ? 16 + s : 31 - s; attn_body::attn_unit<1, 8, 1024, 1024>(qb, Qh, Kh, Vh, (rep_ == 0 && NREP(12) == 2) ? (bf16*)(ws + WS_HB) + (size_t)b * SEQ * 1024 + h * 64 : Qh, nullptr, nullptr, mk, (char*)lds_raw); }
#endif
        }
    }
    GRID_BAR(); PROBE_AT(__COUNTER__ - PROBE_C0);
#ifdef PROBE_CHECK
    { PHASE_ENV(); LAS float* Lw = (LAS float*)lds + wave * 1152;
      for (int s_ = gw; s_ < 2048; s_ += NGW) { chk_mask(ws, Lw, s_, lane); chk_dsa(ws, (const bf16*)(ws + WS_HB), Lw, s_, lane); } }
    GRID_BAR();
#endif
    for (int rep_ = 0; rep_ < NREP(13); ++rep_) {   PHASE_ENV();
        pg8::Gemm g{(const pg8::bf16_t*)(ws + WS_QO), (const pg8::bf16_t*)(ws + WS_W_OUT1), MROWS, 1024, 1024}; pg8::StaticOrder S; S.init(MROWS, 1024, G, bx);
        epi::EpiResid E{HBB, ROWSS2};
        pg8::gemm_phase<epi::EpiResid, pg8::StaticOrder, PG8_ALIGN1, PG8_SP2>(lds, g, S, E);
    }
    GRID_BAR(); PROBE_AT(__COUNTER__ - PROBE_C0);
    FFN_PLE(WS_W_GU1, WS_W_DN1, WS_W_PG1, WS_W_PP1, (size_t)MROWS * 256, HBB, HBA, ROWSS2, ROWSS)
    for (int rep_ = 0; rep_ < NREP(14); ++rep_) { PHASE_ENV(); final_norm(ap, ws, gw, NGW, lane); }
#ifdef PROBE_CHECK
    GRID_BAR();
    { PHASE_ENV(); const unsigned fl = __hip_atomic_load((unsigned*)(ws + CHK_FLAGS), __ATOMIC_RELAXED, __HIP_MEMORY_SCOPE_AGENT); const float cf = 1.f + (float)fl;
      for (size_t i = (size_t)bx * 512 + tid; i < (size_t)MROWS * 1024 / 4; i += (size_t)G * 512) ((f32x4*)OUT)[i] = (f32x4){cf, cf, cf, cf}; }
#endif
#ifdef PROBE_TIME
    GRID_BAR();
    { PHASE_ENV();
      if (bx == 0 && tid == 0) { const unsigned long long t0 = *(unsigned long long*)(ws + 512 * 1024); const unsigned long long el = (__builtin_amdgcn_s_memrealtime() - t0) / 100ull;
          unsigned c = 1; unsigned long long e = el >> 7; while (e) { ++c; e >>= 1; }
          const unsigned tmo = __hip_atomic_load((unsigned*)(ctl + CW_BAR) + XB_TMO, __ATOMIC_RELAXED, __HIP_MEMORY_SCOPE_AGENT);
          if (tmo) c += 16;
          __hip_atomic_store((unsigned*)(ws + 512 * 1024 + 64), c, __ATOMIC_RELAXED, __HIP_MEMORY_SCOPE_AGENT); }
    }
    GRID_BAR();
    { PHASE_ENV(); const unsigned c = __hip_atomic_load((unsigned*)(ws + 512 * 1024 + 64), __ATOMIC_RELAXED, __HIP_MEMORY_SCOPE_AGENT); const float cf = (float)c;
      for (size_t i = (size_t)bx * 512 + tid; i < (size_t)MROWS * 1024 / 4; i += (size_t)G * 512) ((f32x4*)OUT)[i] = (f32x4){cf, cf, cf, cf}; }
#endif
#undef FFN_PLE
#undef GRID_BAR
#undef PHASE_ENV
}

extern "C" void kernel_launch(void* const* d_in, const int* in_sizes, int n_in, void* d_out, int out_size, void* d_ws, size_t ws_size, hipStream_t stream) {
    static int grid = 0;
    if (grid == 0) {
        if (n_in != 22 || out_size != MROWS * DMODEL || ws_size < WS_END) { fprintf(stderr, "kernel_launch: unexpected problem (n_in %d, out %d, ws %zu); nothing launched\n", n_in, out_size, ws_size); grid = -1; return; }
        int dev = 0, cus = 0, per_cu = 0;
        if (hipGetDevice(&dev) != hipSuccess || hipDeviceGetAttribute(&cus, hipDeviceAttributeMultiprocessorCount, dev) != hipSuccess) { grid = -1; return; }
        if (hipFuncSetAttribute((const void*)trunk_fwd, hipFuncAttributeMaxDynamicSharedMemorySize, LDS_BYTES) != hipSuccess) { fprintf(stderr, "kernel_launch: hipFuncSetAttribute failed\n"); grid = -1; return; }
        if (hipOccupancyMaxActiveBlocksPerMultiprocessor(&per_cu, (const void*)trunk_fwd, NWAVES * 64, LDS_BYTES) != hipSuccess || per_cu < 1) { fprintf(stderr, "kernel_launch: occupancy query says %d blocks per CU\n", per_cu); per_cu = 1; }
        (void)hipGetLastError();
        grid = cus;
    }
    if (grid < 0) return;
    if (hipMemsetAsync((char*)d_ws + WS_CTL, 0, CTL_ZERO_BYTES, stream) != hipSuccess) { fprintf(stderr, "kernel_launch: memset failed\n"); return; }
    Args a{};
    for (int i = 0; i < 22; ++i) a.in[i] = (const float*)d_in[i];
    a.out = (float*)d_out; a.ws = (unsigned char*)d_ws;
    float f[8]; for (int i = 0; i < 8; ++i) f[i] = powf(500000.0f, -(float)(2 * i) / 16.0f);
    a.f0 = f[0]; a.f1 = f[1]; a.f2 = f[2]; a.f3 = f[3]; a.f4 = f[4]; a.f5 = f[5]; a.f6 = f[6]; a.f7 = f[7];
    hipLaunchKernelGGL(trunk_fwd, dim3(grid), dim3(NWAVES * 64), LDS_BYTES, stream, a);
    const hipError_t le = hipPeekAtLastError();
    if (le != hipSuccess) fprintf(stderr, "kernel_launch: launch failed: %s\n", hipGetErrorName(le));
}
```
